# Optimizing an MI355X kernel written in HIP

```python
import jax, jax.numpy as jnp
from jax import lax
import numpy as np

D_MODEL = 1024
BATCH = 4
SEQ = 4096
DEPTH = 4

N_META = 16
N_MIXERS = 2
RMS_EPS = 1e-6
ROPE_THETA = 10000.0
ATT_HEADS = 16
ATT_KV_HEADS = 4
ATT_HEAD_DIM = D_MODEL // ATT_HEADS
ATT_GROUP = ATT_HEADS // ATT_KV_HEADS
IDX_HEADS = 8
IDX_DIM = 128
TOPK_MAX = 256
Q_BLOCK = 128
DSA_SPLITS = [ATT_HEADS * ATT_HEAD_DIM, ATT_KV_HEADS * ATT_HEAD_DIM, ATT_KV_HEADS * ATT_HEAD_DIM,
              IDX_HEADS * IDX_DIM, IDX_DIM, IDX_HEADS]
DSA_IN = sum(DSA_SPLITS)
M_HEADS = 4
M_QK_DIM = D_MODEL // (2 * M_HEADS)
M_V_DIM = D_MODEL // M_HEADS
M_CHUNK = 64
GATE_CAP = 15.0
MLSTM_SPLITS = [M_HEADS * M_QK_DIM, M_HEADS * M_QK_DIM, M_HEADS * M_V_DIM, M_HEADS * M_V_DIM,
                M_HEADS, M_HEADS]
MLSTM_IN = sum(MLSTM_SPLITS)
D_FF = 7 * D_MODEL // 2
N_EXPERTS = 8
TOP_K_EXPERTS = 2
N_A = (DEPTH + 1) // 2
N_B = DEPTH // 2

kernel_name = "hybrid_dsa_mlstm_moe_trunk"


def rms_norm(x, g):
    xf = x.astype(jnp.float32)
    y = xf * lax.rsqrt(jnp.mean(xf * xf, axis=-1, keepdims=True) + RMS_EPS)
    return (y * g.astype(jnp.float32)).astype(x.dtype)


def rope(x, pos):
    half = x.shape[-1] // 2
    inv = ROPE_THETA ** (-jnp.arange(half, dtype=jnp.float32) / half)
    ang = pos.astype(jnp.float32)[:, None] * inv[None, :]
    cos = jnp.cos(ang)[:, None, :]
    sin = jnp.sin(ang)[:, None, :]
    x1 = x[..., :half].astype(jnp.float32)
    x2 = x[..., half:].astype(jnp.float32)
    return jnp.concatenate([x1 * cos - x2 * sin, x2 * cos + x1 * sin], axis=-1).astype(x.dtype)


def split_cols(a, sizes):
    return jnp.split(a, list(np.cumsum(sizes)[:-1]), axis=-1)


def dsa_mixer(h, w_in, g_q, g_k, w_out, top_k):
    B, L, _ = h.shape
    q, k, v, iq, ik, iw = split_cols(h @ w_in, DSA_SPLITS)
    pos = jnp.arange(L)
    q = rope(rms_norm(q.reshape(B, L, ATT_HEADS, ATT_HEAD_DIM), g_q), pos)
    k = rope(rms_norm(k.reshape(B, L, ATT_KV_HEADS, ATT_HEAD_DIM), g_k), pos)
    v = v.reshape(B, L, ATT_KV_HEADS, ATT_HEAD_DIM)
    iq = rope(iq.reshape(B, L, IDX_HEADS, IDX_DIM), pos)
    ik = rope(ik[:, :, None, :], pos)[:, :, 0]
    iw = iw * (IDX_HEADS ** -0.5 * IDX_DIM ** -0.5)
    n_blocks = -(-L // Q_BLOCK)
    pad = n_blocks * Q_BLOCK - L
    padq = lambda a: jnp.pad(a, [(0, 0), (0, pad)] + [(0, 0)] * (a.ndim - 2))
    qp = padq(q).reshape(B, n_blocks * Q_BLOCK, ATT_KV_HEADS, ATT_GROUP, ATT_HEAD_DIM)
    iqp, iwp = padq(iq), padq(iw)
    key_pos = jnp.arange(L)
    scale = ATT_HEAD_DIM ** -0.5

    def block(bi):
        start = bi * Q_BLOCK
        qb = lax.dynamic_slice_in_dim(qp, start, Q_BLOCK, axis=1)
        iqb = lax.dynamic_slice_in_dim(iqp, start, Q_BLOCK, axis=1)
        iwb = lax.dynamic_slice_in_dim(iwp, start, Q_BLOCK, axis=1)
        qpos = start + jnp.arange(Q_BLOCK)
        causal = key_pos[None, :] <= qpos[:, None]
        s = jnp.einsum('bqhd,bsd->bqhs', iqb, ik, preferred_element_type=jnp.float32)
        score = jnp.einsum('bqhs,bqh->bqs', jax.nn.relu(s), iwb.astype(jnp.float32))
        score = jnp.where(causal[None], score, -jnp.inf)
        _, sel = lax.top_k(score, top_k)
        valid = sel <= qpos[None, :, None]
        k_sel = jax.vmap(lambda kk, ii: kk[ii])(k, sel)
        v_sel = jax.vmap(lambda vv, ii: vv[ii])(v, sel)
        logits = jnp.einsum('bqgrd,bqkgd->bqgrk', qb, k_sel, preferred_element_type=jnp.float32) * scale
        logits = jnp.where(valid[:, :, None, None, :], logits, -jnp.inf)
        p = jax.nn.softmax(logits, axis=-1)
        return jnp.einsum('bqgrk,bqkgd->bqgrd', p.astype(v.dtype), v_sel)

    out = lax.map(block, jnp.arange(n_blocks))
    out = out.transpose(1, 0, 2, 3, 4, 5).reshape(B, n_blocks * Q_BLOCK, D_MODEL)[:, :L]
    return out @ w_out


def mlstm_mixer(h, w_in, b_i, b_f, g_out, w_out):
    B, L, _ = h.shape
    q, k, v, o, ig, fg = split_cols(h @ w_in, MLSTM_SPLITS)
    f32 = jnp.float32
    q = q.reshape(B, L, M_HEADS, M_QK_DIM).astype(f32)
    k = k.reshape(B, L, M_HEADS, M_QK_DIM).astype(f32) * (M_QK_DIM ** -0.5)
    v = v.reshape(B, L, M_HEADS, M_V_DIM).astype(f32)
    log_i = GATE_CAP * jnp.tanh((ig.astype(f32) + b_i.astype(f32)) / GATE_CAP)
    log_f = jax.nn.log_sigmoid(GATE_CAP * jnp.tanh((fg.astype(f32) + b_f.astype(f32)) / GATE_CAP))
    pf = (-N_META) % M_CHUNK
    pb = (-(pf + L)) % M_CHUNK
    Lp = pf + L + pb
    nc = Lp // M_CHUNK
    padt = lambda a, c=0.0: jnp.pad(a, [(0, 0), (pf, pb)] + [(0, 0)] * (a.ndim - 2), constant_values=c)
    to_chunks = lambda a: a.reshape(B, nc, M_CHUNK, M_HEADS, -1).transpose(1, 0, 3, 2, 4)
    gchunks = lambda a: a.reshape(B, nc, M_CHUNK, M_HEADS).transpose(1, 0, 3, 2)
    qc, kc, vc = to_chunks(padt(q)), to_chunks(padt(k)), to_chunks(padt(v))
    lic = gchunks(padt(log_i, -jnp.inf))
    lfc = gchunks(padt(log_f, 0.0))
    tril = jnp.tril(jnp.ones((M_CHUNK, M_CHUNK), dtype=bool))

    def step(carry, xs):
        C_st, n_st, m_st = carry
        qx, kx, vx, li, lf = xs
        b = jnp.cumsum(lf, axis=-1)
        dmat = jnp.where(tril, b[..., :, None] - b[..., None, :] + li[..., None, :], -jnp.inf)
        inter = b + m_st[..., None]
        m_t = jnp.maximum(inter, jnp.max(dmat, axis=-1))
        w_inter = jnp.exp(inter - m_t)
        s = jnp.einsum('bhtd,bhsd->bhts', qx, kx) * jnp.exp(dmat - m_t[..., None])
        num = w_inter[..., None] * jnp.einsum('bhvd,bhtd->bhtv', C_st, qx) + jnp.einsum('bhts,bhsv->bhtv', s, vx)
        den = w_inter * jnp.einsum('bhd,bhtd->bht', n_st, qx) + jnp.sum(s, axis=-1)
        hout = num / jnp.maximum(jnp.abs(den), jnp.exp(-m_t))[..., None]
        b_last = b[..., -1]
        log_w = b_last[..., None] - b + li
        m_new = jnp.maximum(b_last + m_st, jnp.max(log_w, axis=-1))
        decay = jnp.exp(b_last + m_st - m_new)
        wk = jnp.exp(log_w - m_new[..., None])
        C_new = decay[..., None, None] * C_st + jnp.einsum('bhs,bhsv,bhsd->bhvd', wk, vx, kx)
        n_new = decay[..., None] * n_st + jnp.einsum('bhs,bhsd->bhd', wk, kx)
        return (C_new, n_new, m_new), hout

    init = (jnp.zeros((B, M_HEADS, M_V_DIM, M_QK_DIM), f32), jnp.zeros((B, M_HEADS, M_QK_DIM), f32),
            jnp.zeros((B, M_HEADS), f32))
    _, hs = lax.scan(step, init, (qc, kc, vc, lic, lfc))
    hs = hs.transpose(1, 0, 3, 2, 4).reshape(B, Lp, M_HEADS, M_V_DIM)[:, pf:pf + L]
    hs = rms_norm(hs, g_out.reshape(M_HEADS, M_V_DIM)).reshape(B, L, D_MODEL)
    y = (hs * jax.nn.sigmoid(o.astype(f32))).astype(h.dtype)
    return y @ w_out


def swiglu(h, w_gate, w_up, w_down):
    return (jax.nn.silu(h @ w_gate) * (h @ w_up)) @ w_down


def moe_ffn(h, w_router, w_gate, w_up, w_down):
    logits = (h @ w_router).astype(jnp.float32)
    top_val, top_idx = lax.top_k(logits, TOP_K_EXPERTS)
    gates = jax.nn.softmax(top_val, axis=-1)
    combine = jnp.sum(jax.nn.one_hot(top_idx, N_EXPERTS, dtype=jnp.float32) * gates[..., None], axis=-2)
    y = jnp.zeros_like(h)
    for e in range(N_EXPERTS):
        y = y + combine[..., e:e + 1].astype(h.dtype) * swiglu(h, w_gate[e], w_up[e], w_down[e])
    return y


def setup_inputs(seed: int = 0) -> dict:
    key = jax.random.key(seed)
    ks = jax.random.split(key, 24)
    nrm = lambda k, shape, fan_in: jax.random.normal(k, shape, jnp.float32) * (fan_in ** -0.5)
    gain = lambda k, shape: 1.0 + 0.02 * jax.random.normal(k, shape, jnp.float32)
    out_scale = (2.0 * DEPTH) ** -0.5
    b_f = jnp.linspace(3.0, 6.0, M_HEADS, dtype=jnp.float32)[None, :] + 0.1 * jax.random.normal(ks[9], (N_B, M_HEADS), jnp.float32)
    return {
        "x": jax.random.normal(ks[0], (BATCH, SEQ, D_MODEL), jnp.float32),
        "meta": jax.random.normal(ks[1], (N_META, D_MODEL), jnp.float32),
        "norm_mixer": gain(ks[2], (DEPTH, D_MODEL)),
        "norm_ffn": gain(ks[3], (DEPTH, D_MODEL)),
        "dsa_w_in": nrm(ks[4], (N_A, D_MODEL, DSA_IN), D_MODEL),
        "dsa_q_norm": gain(ks[5], (N_A, ATT_HEAD_DIM)),
        "dsa_k_norm": gain(ks[6], (N_A, ATT_HEAD_DIM)),
        "dsa_w_out": nrm(ks[7], (N_A, D_MODEL, D_MODEL), D_MODEL) * out_scale,
        "mlstm_w_in": nrm(ks[8], (N_B, D_MODEL, MLSTM_IN), D_MODEL),
        "mlstm_b_i": 0.1 * jax.random.normal(ks[10], (N_B, M_HEADS), jnp.float32),
        "mlstm_b_f": b_f,
        "mlstm_out_norm": gain(ks[11], (N_B, D_MODEL)),
        "mlstm_w_out": nrm(ks[12], (N_B, D_MODEL, D_MODEL), D_MODEL) * out_scale,
        "ffn_w_gate": nrm(ks[13], (N_A, D_MODEL, D_FF), D_MODEL),
        "ffn_w_up": nrm(ks[14], (N_A, D_MODEL, D_FF), D_MODEL),
        "ffn_w_down": nrm(ks[15], (N_A, D_FF, D_MODEL), D_FF) * out_scale,
        "moe_router": nrm(ks[16], (N_B, D_MODEL, N_EXPERTS), D_MODEL),
        "moe_w_gate": nrm(ks[17], (N_B, N_EXPERTS, D_MODEL, D_FF), D_MODEL),
        "moe_w_up": nrm(ks[18], (N_B, N_EXPERTS, D_MODEL, D_FF), D_MODEL),
        "moe_w_down": nrm(ks[19], (N_B, N_EXPERTS, D_FF, D_MODEL), D_FF) * out_scale,
    }


def reference(x, meta, norm_mixer, norm_ffn, dsa_w_in, dsa_q_norm, dsa_k_norm, dsa_w_out,
              mlstm_w_in, mlstm_b_i, mlstm_b_f, mlstm_out_norm, mlstm_w_out,
              ffn_w_gate, ffn_w_up, ffn_w_down, moe_router, moe_w_gate, moe_w_up, moe_w_down):
    B, S, D = x.shape
    top_k = min(TOPK_MAX, S // 4)
    h = jnp.concatenate([jnp.broadcast_to(meta[None].astype(x.dtype), (B, N_META, D)), x], axis=1)
    for i in range(DEPTH):
        j = i // N_MIXERS
        hn = rms_norm(h, norm_mixer[i])
        if i % N_MIXERS == 0:
            h = h + dsa_mixer(hn, dsa_w_in[j], dsa_q_norm[j], dsa_k_norm[j], dsa_w_out[j], top_k)
        else:
            h = h + mlstm_mixer(hn, mlstm_w_in[j], mlstm_b_i[j], mlstm_b_f[j], mlstm_out_norm[j], mlstm_w_out[j])
        hn = rms_norm(h, norm_ffn[i])
        if i % 2 == 0:
            h = h + swiglu(hn, ffn_w_gate[j], ffn_w_up[j], ffn_w_down[j])
        else:
            h = h + moe_ffn(hn, moe_router[j], moe_w_gate[j], moe_w_up[j], moe_w_down[j])
    return h[:, N_META:]
```

```cpp
#include <hip/hip_runtime.h>
#include <cstdio>
#include <cstdint>
#ifndef N_LAUNCH_SPLIT
#define N_LAUNCH_SPLIT 0
#endif
namespace pg8 {
#define PG8_LAS __attribute__((address_space(3)))
typedef unsigned short bf16_t;
typedef short bf16x8 __attribute__((ext_vector_type(8)));
typedef float f32x4 __attribute__((ext_vector_type(4)));
typedef unsigned u32x4 __attribute__((ext_vector_type(4)));
constexpr int BM = 256, BK = 64, HALF = 128, HTB = HALF * BK * 2  , STAGE_BYTES = 8 * HTB, NXCD = 8, WGM = 8;

__host__ __device__ __forceinline__ int lds_byte(int r, int c) { const int st = (r >> 4) * 2 + (c >> 5), rr = r & 15, cc = c & 31, ob = rr * 64 + cc * 2; return st * 1024 + (ob ^ (((ob >> 9) & 1) << 5)); }
__host__ __device__ __forceinline__ void stage_rc(int b, int& R, int& C) { const int st = b / 1024, sb = b % 1024, swz = sb ^ (((sb >> 9) & 1) << 5); R = (st >> 1) * 16 + swz / 64; C = (st & 1) * 32 + (swz % 64) / 2; }
__host__ __device__ __forceinline__ int perm32(int rho) { const int n = rho >> 4, i = rho & 15; return 8 * (i >> 2) + 4 * n + (i & 3); }

struct Unit { int pm, pn, r0; };
struct Gemm { const bf16_t* A; const bf16_t* Bt; int M, N, K; };

struct StaticOrder {
    int nM, nN, nwg, G, c, tokmap;
    __host__ __device__ void init(int M, int N, int G_, int c_, int tokmap_ = 0) { nM = M / BM; nN = N / BM; nwg = nM * nN; G = G_; c = c_; tokmap = tokmap_; }
    __host__ __device__ bool next(int i, Unit& u) const {
        const long L = (long)i * G + c; if (L >= nwg) return false;
        int wgid = (int)L; { const int q = nwg / NXCD, r = nwg % NXCD, xcd = wgid % NXCD, off = wgid / NXCD; wgid = (xcd < r ? xcd * (q + 1) : r * (q + 1) + (xcd - r) * q) + off; }
        const int nig = WGM * nN, gid = wgid / nig, fm = gid * WGM, gsz = (nM - fm) < WGM ? (nM - fm) : WGM;
        u.pm = fm + ((wgid % nig) % gsz); u.pn = (wgid % nig) / gsz; u.r0 = tokmap ? 4112 * (u.pm >> 4) + 16 + 256 * (u.pm & 15) : 256 * u.pm; return true;
    }
    __device__ __forceinline__ const char* b_base(const Gemm& g, const Unit& u, size_t tstep) const { return (const char*)g.Bt + (size_t)u.pn * tstep; }
    __device__ __forceinline__ void a_ready(const Unit&) const {}
    __device__ __forceinline__ void done(const Unit&) const {}
};
__device__ __forceinline__ unsigned cvt_pk_bf16(float lo, float hi) { unsigned r; asm volatile("v_cvt_pk_bf16_f32 %0, %1, %2" : "=v"(r) : "v"(lo), "v"(hi)); return r; }
typedef int i32x8 __attribute__((ext_vector_type(8)));
typedef int i32x4v __attribute__((ext_vector_type(4)));
__device__ __forceinline__ i32x8 cat8(bf16x8 a, bf16x8 b) { const i32x4v x = __builtin_bit_cast(i32x4v, a), y = __builtin_bit_cast(i32x4v, b); return __builtin_shufflevector(x, y, 0, 1, 2, 3, 4, 5, 6, 7); }
__device__ __forceinline__ float clamp448(float x) { return __builtin_amdgcn_fmed3f(x, -448.0f, 448.0f); }
__device__ __forceinline__ unsigned cvt4_fp8(float a, float b, float c, float d) { int w = 0; w = __builtin_amdgcn_cvt_pk_fp8_f32(clamp448(a), clamp448(b), w, false); w = __builtin_amdgcn_cvt_pk_fp8_f32(clamp448(c), clamp448(d), w, true); return (unsigned)w; }
typedef unsigned u32x2v __attribute__((ext_vector_type(2)));
struct EpiStoreBf16 {
    static constexpr bool PERM = true, AFTER_DRAIN = false;
    bf16_t* O; int ldc; float s;
    __device__ __forceinline__ void operator()(const f32x4 (&acc)[2][2][4][2], const Unit& u, int wr, int wc, int fr, int fq) const {
        const int row0 = u.r0 + wr * 64 + fr, col0 = u.pn * BM + wc * 32 + 8 * fq;
#pragma unroll
        for (int ai = 0; ai < 2; ++ai)
#pragma unroll
            for (int m = 0; m < 4; ++m) { bf16_t* rowp = O + (size_t)(row0 + ai * HALF + m * 16) * ldc + col0;
#pragma unroll
                for (int bj = 0; bj < 2; ++bj) { const f32x4 v0 = acc[ai][bj][m][0] * s, v1 = acc[ai][bj][m][1] * s;
                    u32x4 w; w.x = cvt_pk_bf16(v0[0], v0[1]); w.y = cvt_pk_bf16(v0[2], v0[3]); w.z = cvt_pk_bf16(v1[0], v1[1]); w.w = cvt_pk_bf16(v1[2], v1[3]);
                    *(u32x4*)(rowp + bj * HALF) = w; } }
    }
};
struct EpiResAdd {
    static constexpr bool PERM = false, AFTER_DRAIN = false;
    float* H; int ldc; float s;
    __device__ __forceinline__ void operator()(const f32x4 (&acc)[2][2][4][2], const Unit& u, int wr, int wc, int fr, int fq) const {
        const int row0 = u.r0 + wr * 64 + fr, col0 = u.pn * BM + wc * 32 + 4 * fq;
#pragma unroll
        for (int ai = 0; ai < 2; ++ai)
#pragma unroll
            for (int m = 0; m < 4; ++m) { float* rowp = H + (size_t)(row0 + ai * HALF + m * 16) * ldc + col0;
                f32x4 h[2][2];
#pragma unroll
                for (int bj = 0; bj < 2; ++bj)
#pragma unroll
                    for (int n = 0; n < 2; ++n) h[bj][n] = *(const f32x4*)(rowp + bj * HALF + n * 16);
#pragma unroll
                for (int bj = 0; bj < 2; ++bj)
#pragma unroll
                    for (int n = 0; n < 2; ++n) *(f32x4*)(rowp + bj * HALF + n * 16) = h[bj][n] + acc[ai][bj][m][n] * s;
                if (m & 1) asm volatile("" ::: "memory"); }
    }
};
struct EpiResAddB {
    static constexpr bool PERM = true, AFTER_DRAIN = false;
    bf16_t* H; int ldc; float s;
    __device__ __forceinline__ void operator()(const f32x4 (&acc)[2][2][4][2], const Unit& u, int wr, int wc, int fr, int fq) const {
        const int row0 = u.r0 + wr * 64 + fr, col0 = u.pn * BM + wc * 32 + 8 * fq;
#pragma unroll
        for (int ai = 0; ai < 2; ++ai)
#pragma unroll
            for (int m = 0; m < 4; ++m) { bf16_t* rowp = H + (size_t)(row0 + ai * HALF + m * 16) * ldc + col0;
                u32x4 h[2];
#pragma unroll
                for (int bj = 0; bj < 2; ++bj) h[bj] = *(const u32x4*)(rowp + bj * HALF);
#pragma unroll
                for (int bj = 0; bj < 2; ++bj) { const f32x4 v0 = acc[ai][bj][m][0] * s, v1 = acc[ai][bj][m][1] * s; const u32x4 q = h[bj];
                    u32x4 w; w.x = cvt_pk_bf16(__uint_as_float(q.x << 16) + v0[0], __uint_as_float(q.x & 0xffff0000u) + v0[1]); w.y = cvt_pk_bf16(__uint_as_float(q.y << 16) + v0[2], __uint_as_float(q.y & 0xffff0000u) + v0[3]);
                    w.z = cvt_pk_bf16(__uint_as_float(q.z << 16) + v1[0], __uint_as_float(q.z & 0xffff0000u) + v1[1]); w.w = cvt_pk_bf16(__uint_as_float(q.w << 16) + v1[2], __uint_as_float(q.w & 0xffff0000u) + v1[3]);
                    *(u32x4*)(rowp + bj * HALF) = w; }
                if (m & 1) asm volatile("" ::: "memory"); }
    }
};
__device__ __forceinline__ float silu_mul(float g, float u) { return g * __builtin_amdgcn_rcpf(1.0f + __expf(-g)) * u; }
struct EpiSwiGLU {
    static constexpr bool PERM = true, AFTER_DRAIN = false;
    bf16_t* O; int ldc;
    __device__ __forceinline__ void operator()(const f32x4 (&acc)[2][2][4][2], const Unit& u, int wr, int wc, int fr, int fq) const {
        const int row0 = u.r0 + wr * 64 + fr, col0 = u.pn * HALF + wc * 32 + 8 * fq;
#pragma unroll
        for (int ai = 0; ai < 2; ++ai)
#pragma unroll
            for (int m = 0; m < 4; ++m) { bf16_t* rowp = O + (size_t)(row0 + ai * HALF + m * 16) * ldc + col0;
                const f32x4 g0 = acc[ai][0][m][0], g1 = acc[ai][0][m][1], u0 = acc[ai][1][m][0], u1 = acc[ai][1][m][1];
                u32x4 w; w.x = cvt_pk_bf16(silu_mul(g0[0], u0[0]), silu_mul(g0[1], u0[1])); w.y = cvt_pk_bf16(silu_mul(g0[2], u0[2]), silu_mul(g0[3], u0[3]));
                w.z = cvt_pk_bf16(silu_mul(g1[0], u1[0]), silu_mul(g1[1], u1[1])); w.w = cvt_pk_bf16(silu_mul(g1[2], u1[2]), silu_mul(g1[3], u1[3]));
                *(u32x4*)rowp = w; }
    }
};
struct EpiSwiGLU8 {
    static constexpr bool PERM = true, AFTER_DRAIN = false;
    unsigned char* O; int ldc; float sg, so;
    __device__ __forceinline__ void operator()(const f32x4 (&acc)[2][2][4][2], const Unit& u, int wr, int wc, int fr, int fq) const {
        const int row0 = u.r0 + wr * 64 + fr, col0 = u.pn * HALF + wc * 32 + 8 * fq;
        const float ss = sg * sg * so;
#pragma unroll
        for (int ai = 0; ai < 2; ++ai)
#pragma unroll
            for (int m = 0; m < 4; ++m) { unsigned char* rowp = O + (size_t)(row0 + ai * HALF + m * 16) * ldc + col0;
                const f32x4 g0 = acc[ai][0][m][0], g1 = acc[ai][0][m][1], u0 = acc[ai][1][m][0], u1 = acc[ai][1][m][1];
                float a[8];
#pragma unroll
                for (int i = 0; i < 4; ++i) { a[i] = g0[i] * __builtin_amdgcn_rcpf(1.0f + __expf(-sg * g0[i])) * u0[i] * ss; a[4 + i] = g1[i] * __builtin_amdgcn_rcpf(1.0f + __expf(-sg * g1[i])) * u1[i] * ss; }
                u32x2v w; w.x = cvt4_fp8(a[0], a[1], a[2], a[3]); w.y = cvt4_fp8(a[4], a[5], a[6], a[7]);
                *(u32x2v*)rowp = w; }
    }
};
struct EpiMoeDown {
    static constexpr bool PERM = true, AFTER_DRAIN = false;
    bf16_t* Y0; bf16_t* Y1; const int* slot_tok; const float* slot_g; int ldc; float s;
    __device__ __forceinline__ void operator()(const f32x4 (&acc)[2][2][4][2], const Unit& u, int wr, int wc, int fr, int fq) const {
        const int row0 = u.r0 + wr * 64 + fr, col0 = u.pn * BM + wc * 32 + 8 * fq;
#pragma unroll
        for (int ai = 0; ai < 2; ++ai)
#pragma unroll
            for (int m = 0; m < 4; ++m) { const int slot = row0 + ai * HALF + m * 16; const int ti = slot_tok[slot]; const float g = slot_g[slot] * s;
                if (ti >= 0) { bf16_t* rowp = ((ti >> 16) ? Y1 : Y0) + (size_t)(ti & 0xffff) * ldc + col0;
#pragma unroll
                    for (int bj = 0; bj < 2; ++bj) { const f32x4 v0 = acc[ai][bj][m][0] * g, v1 = acc[ai][bj][m][1] * g;
                        u32x4 w; w.x = cvt_pk_bf16(v0[0], v0[1]); w.y = cvt_pk_bf16(v0[2], v0[3]); w.z = cvt_pk_bf16(v1[0], v1[1]); w.w = cvt_pk_bf16(v1[2], v1[3]);
                        *(u32x4*)(rowp + bj * HALF) = w; } } }
    }
};
struct GroupedOrder {
    int nM, nN, nwg, G, c; int p1, p2, p3, p4, p5, p6, p7; size_t estride; int bmajor;
    __device__ __forceinline__ bool next(int i, Unit& u) const {
        const long L = (long)i * G + c; if (L >= nwg) return false;
        int wgid = (int)L; { const int q = nwg / NXCD, r = nwg % NXCD, xcd = wgid % NXCD, off = wgid / NXCD; wgid = (xcd < r ? xcd * (q + 1) : r * (q + 1) + (xcd - r) * q) + off; }
        if (bmajor) {
            const int e = (wgid >= nN * p1) + (wgid >= nN * p2) + (wgid >= nN * p3) + (wgid >= nN * p4) + (wgid >= nN * p5) + (wgid >= nN * p6) + (wgid >= nN * p7);
            const int pe = e == 0 ? 0 : e == 1 ? p1 : e == 2 ? p2 : e == 3 ? p3 : e == 4 ? p4 : e == 5 ? p5 : e == 6 ? p6 : p7;
            const int pe1 = e == 0 ? p1 : e == 1 ? p2 : e == 2 ? p3 : e == 3 ? p4 : e == 4 ? p5 : e == 5 ? p6 : e == 6 ? p7 : nM;
            const int np = pe1 - pe, local = wgid - nN * pe, gsz = np * 7, pg = local / gsz, rem = local - pg * gsz, pmo = rem / 7;
            u.pm = pe + pmo; u.pn = pg * 7 + (rem - pmo * 7); u.r0 = 256 * u.pm; return true;
        }
        const int nig = WGM * nN, gid = wgid / nig, fm = gid * WGM, gsz = (nM - fm) < WGM ? (nM - fm) : WGM;
        u.pm = fm + ((wgid % nig) % gsz); u.pn = (wgid % nig) / gsz; u.r0 = 256 * u.pm; return true;
    }
    __device__ __forceinline__ const char* b_base(const Gemm& g, const Unit& u, size_t tstep) const {
        const int e = (u.pm >= p1) + (u.pm >= p2) + (u.pm >= p3) + (u.pm >= p4) + (u.pm >= p5) + (u.pm >= p6) + (u.pm >= p7);
        return (const char*)g.Bt + (size_t)e * estride + (size_t)u.pn * tstep; }
    __device__ __forceinline__ void a_ready(const Unit&) const {}
    __device__ __forceinline__ void done(const Unit&) const {}
};
template <class Epi, class Sched, bool ALIGN_EPI = false, bool SP2 = false, bool FP8 = false>
__device__ __forceinline__ void gemm_phase(PG8_LAS unsigned char* lds, const Gemm g, const Sched& S, const Epi& E, int tid_in) {
    int tid_ = tid_in; asm volatile("" : "+v"(tid_));
    const int tid = tid_, wid = __builtin_amdgcn_readfirstlane(tid >> 6), lane = tid & 63, wr = wid >> 2, wc = wid & 3, fr = lane & 15, fq = lane >> 4;
    const int K = g.K, nt = K / BK;
    unsigned voffA[2], voffB[2];
#pragma unroll
    for (int i = 0; i < 2; ++i) { int R, C; stage_rc(tid * 16 + i * 8192, R, C); const int Rb = Epi::PERM ? ((R & ~31) + perm32(R & 31)) : R;
        voffA[i] = (unsigned)(R * K + C) * 2u; voffB[i] = (unsigned)(Rb * K + C) * 2u; }
    const size_t kstep = (size_t)(BK * 2);
    const size_t hstep = (size_t)HALF * K * 2;
    const size_t tstep = 2 * hstep;
    const unsigned ldsw = (unsigned)wid * 1024u;
    const int aoff = lds_byte(wr * 64 + fr, fq * 8), boff = lds_byte(wc * 32 + fr, fq * 8);
#define PG8_SA(b, h) (((b) * 2 + (h)) * HTB)
#define PG8_SB(b, h) ((4 + (b) * 2 + (h)) * HTB)
#define PG8_STAGE(bufoff, gbase, voff) do { _Pragma("unroll") for (int _i = 0; _i < 2; ++_i) \
        __builtin_amdgcn_global_load_lds((const unsigned*)((const char*)(gbase) + (voff)[_i]), (PG8_LAS unsigned*)(lds + (bufoff) + ldsw + _i * 8192), 16, 0, 0); } while (0)
#define PG8_LDA(dst, b, h) do { _Pragma("unroll") for (int m = 0; m < 4; ++m) _Pragma("unroll") for (int k = 0; k < 2; ++k) { \
        if constexpr (FP8) { const i32x4v v_ = *(const PG8_LAS i32x4v*)(lds + PG8_SA(b, h) + aoff + m * 2048 + k * 1024); if (k == 0) dst##8[m].lo = v_; else dst##8[m].hi = v_; } \
        else dst[m][k] = *(const PG8_LAS bf16x8*)(lds + PG8_SA(b, h) + aoff + m * 2048 + k * 1024); } } while (0)
#define PG8_LDB(dst, b, h) do { _Pragma("unroll") for (int n = 0; n < 2; ++n) _Pragma("unroll") for (int k = 0; k < 2; ++k) { \
        if constexpr (FP8) { const i32x4v v_ = *(const PG8_LAS i32x4v*)(lds + PG8_SB(b, h) + boff + n * 2048 + k * 1024); if (k == 0) dst##8[n].lo = v_; else dst##8[n].hi = v_; } \
        else dst[n][k] = *(const PG8_LAS bf16x8*)(lds + PG8_SB(b, h) + boff + n * 2048 + k * 1024); } } while (0)
#define PG8_MMA(ai, bj, At, Bt) do { __builtin_amdgcn_s_setprio(1); _Pragma("unroll") for (int m = 0; m < 4; ++m) _Pragma("unroll") for (int n = 0; n < 2; ++n) { \
        if constexpr (FP8) asm volatile("v_mfma_scale_f32_16x16x128_f8f6f4 %0, %1, %2, %0, %3, %3 op_sel_hi:[0,0,0]" : "+v"(acc[ai][bj][m][n]) : "v"(Bt##8[n]), "v"(At##8[m]), "v"(sc7f));   \
        else { _Pragma("unroll") for (int k = 0; k < 2; ++k) acc[ai][bj][m][n] = __builtin_amdgcn_mfma_f32_16x16x32_bf16(Bt[n][k], At[m][k], acc[ai][bj][m][n], 0, 0, 0); } } \
        __builtin_amdgcn_s_setprio(0); } while (0)
#define PG8_WAIT_V(n) asm volatile("s_waitcnt vmcnt(" #n ")" ::: "memory")
#define PG8_WAIT_L(n) asm volatile("s_waitcnt lgkmcnt(" #n ")" ::: "memory")
#define PG8_BAR __builtin_amdgcn_s_barrier()
#define PG8_SCHED __builtin_amdgcn_sched_barrier(0)
    Unit cur, nxt; int ui = 0;
    if (!S.next(0, cur)) return;
    f32x4 acc[2][2][4][2];
#pragma unroll
    for (int a = 0; a < 2; ++a)
#pragma unroll
        for (int b = 0; b < 2; ++b)
#pragma unroll
            for (int m = 0; m < 4; ++m)
#pragma unroll
                for (int n = 0; n < 2; ++n) acc[a][b][m][n] = (f32x4){0.f, 0.f, 0.f, 0.f};
    int sc7f = 0x7f; asm volatile("" : "+v"(sc7f));
    bf16x8 At[4][2], B0[2][2], B1[2][2]; i32x8 At8[4], B08[2], B18[2];
    const char* cA = (const char*)g.A + (size_t)cur.r0 * K * 2; const char* cB = S.b_base(g, cur, tstep);
    S.a_ready(cur);
    if constexpr (SP2) {
        PG8_STAGE(PG8_SB(0, 0), cB, voffB); PG8_STAGE(PG8_SB(0, 1), cB + hstep, voffB); PG8_STAGE(PG8_SA(0, 0), cA, voffA); PG8_STAGE(PG8_SA(0, 1), cA + hstep, voffA);
        if (wr == 1) PG8_BAR;
        PG8_WAIT_V(2); PG8_BAR;
        PG8_STAGE(PG8_SB(1, 0), cB + kstep, voffB); PG8_STAGE(PG8_SA(1, 0), cA + kstep, voffA); PG8_STAGE(PG8_SB(1, 1), cB + hstep + kstep, voffB);
        PG8_WAIT_V(6); PG8_BAR;
    } else {
        PG8_STAGE(PG8_SB(0, 0), cB, voffB); PG8_STAGE(PG8_SA(0, 0), cA, voffA); PG8_STAGE(PG8_SB(0, 1), cB + hstep, voffB); PG8_STAGE(PG8_SA(0, 1), cA + hstep, voffA);
        if (wr == 1) PG8_BAR;
        PG8_WAIT_V(4); PG8_BAR;
        PG8_STAGE(PG8_SB(1, 0), cB + kstep, voffB); PG8_STAGE(PG8_SA(1, 0), cA + kstep, voffA); PG8_STAGE(PG8_SB(1, 1), cB + hstep + kstep, voffB);
        PG8_WAIT_V(6); PG8_BAR;
    }
    for (;;) {
        const bool has_next = S.next(ui + 1, nxt);
        const char* nA = has_next ? (const char*)g.A + (size_t)nxt.r0 * K * 2 : cA; const char* nB = has_next ? S.b_base(g, nxt, tstep) : cB;
        for (int t = 0; t < nt; t += 2) {
            const bool last = (t == nt - 2);
            const char* a1 = cA + (size_t)(t + 1) * kstep;
            const char* a2 = last ? nA : cA + (size_t)(t + 2) * kstep; const char* b2 = last ? nB : cB + (size_t)(t + 2) * kstep;
            const char* a3 = a2 + kstep; const char* b3 = b2 + kstep;
            if (last && has_next) S.a_ready(nxt);
            if constexpr (SP2) {
            PG8_LDB(B0, 0, 0); PG8_LDB(B1, 0, 1); PG8_SCHED; PG8_LDA(At, 0, 0); PG8_STAGE(PG8_SA(1, 1), a1 + hstep, voffA);
            PG8_WAIT_V(8); PG8_WAIT_L(0); PG8_BAR; PG8_MMA(0, 0, At, B0); PG8_MMA(0, 1, At, B1); PG8_BAR; PG8_SCHED;
            PG8_LDA(At, 0, 1); PG8_STAGE(PG8_SB(0, 0), b2, voffB); PG8_STAGE(PG8_SB(0, 1), b2 + hstep, voffB); PG8_STAGE(PG8_SA(0, 0), a2, voffA);
            PG8_WAIT_V(8); PG8_WAIT_L(0); PG8_BAR; PG8_MMA(1, 0, At, B0); PG8_MMA(1, 1, At, B1); PG8_BAR; PG8_SCHED;
            PG8_LDB(B0, 1, 0); PG8_LDB(B1, 1, 1); PG8_SCHED; PG8_LDA(At, 1, 0); PG8_STAGE(PG8_SA(0, 1), a2 + hstep, voffA);
            PG8_WAIT_V(8); PG8_WAIT_L(0); PG8_BAR; PG8_MMA(0, 0, At, B0); PG8_MMA(0, 1, At, B1); PG8_BAR; PG8_SCHED;
            PG8_LDA(At, 1, 1); PG8_STAGE(PG8_SB(1, 0), b3, voffB); PG8_STAGE(PG8_SB(1, 1), b3 + hstep, voffB); PG8_STAGE(PG8_SA(1, 0), a3, voffA);
            PG8_WAIT_V(8); PG8_WAIT_L(0); PG8_BAR; PG8_MMA(1, 0, At, B0); PG8_MMA(1, 1, At, B1); PG8_BAR; PG8_SCHED;
            } else {
            PG8_LDB(B0, 0, 0); PG8_SCHED; PG8_LDA(At, 0, 0); PG8_STAGE(PG8_SA(1, 1), a1 + hstep, voffA);
            PG8_WAIT_L(8); PG8_BAR; PG8_WAIT_L(0); PG8_MMA(0, 0, At, B0); PG8_BAR; PG8_SCHED;
            PG8_LDB(B1, 0, 1); PG8_STAGE(PG8_SB(0, 0), b2, voffB);
            PG8_BAR; PG8_WAIT_L(0); PG8_MMA(0, 1, At, B1); PG8_BAR;
            PG8_LDA(At, 0, 1); PG8_STAGE(PG8_SA(0, 0), a2, voffA);
            PG8_BAR; PG8_WAIT_L(0); PG8_MMA(1, 0, At, B0); PG8_BAR; PG8_SCHED;
            PG8_STAGE(PG8_SB(0, 1), b2 + hstep, voffB);
            PG8_WAIT_V(6); PG8_BAR; PG8_MMA(1, 1, At, B1); PG8_BAR;
            PG8_LDB(B0, 1, 0); PG8_SCHED; PG8_LDA(At, 1, 0); PG8_STAGE(PG8_SA(0, 1), a2 + hstep, voffA);
            PG8_WAIT_L(8); PG8_BAR; PG8_WAIT_L(0); PG8_MMA(0, 0, At, B0); PG8_BAR; PG8_SCHED;
            PG8_LDB(B1, 1, 1); PG8_STAGE(PG8_SB(1, 0), b3, voffB);
            PG8_BAR; PG8_WAIT_L(0); PG8_MMA(0, 1, At, B1); PG8_BAR;
            PG8_LDA(At, 1, 1); PG8_STAGE(PG8_SA(1, 0), a3, voffA);
            PG8_BAR; PG8_WAIT_L(0); PG8_MMA(1, 0, At, B0); PG8_BAR; PG8_SCHED;
            PG8_STAGE(PG8_SB(1, 1), b3 + hstep, voffB);
            PG8_WAIT_V(6); PG8_BAR; PG8_MMA(1, 1, At, B1); PG8_BAR;
            }
        }
        if constexpr (FP8) asm volatile("s_nop 15\n\ts_nop 15" ::: "memory");
        if constexpr (ALIGN_EPI) { if (wr == 0) PG8_BAR; }
        if constexpr (!Epi::AFTER_DRAIN) { E(acc, cur, wr, wc, fr, fq); S.done(cur); }
        if (!has_next) break;
#pragma unroll
        for (int a = 0; a < 2; ++a)
#pragma unroll
            for (int b = 0; b < 2; ++b)
#pragma unroll
                for (int m = 0; m < 4; ++m)
#pragma unroll
                    for (int n = 0; n < 2; ++n) acc[a][b][m][n] = (f32x4){0.f, 0.f, 0.f, 0.f};
        cur = nxt; cA = nA; cB = nB; ++ui;
        if constexpr (ALIGN_EPI) { if (wr == 1) PG8_BAR; }
    }
    PG8_WAIT_V(0);
    if constexpr (!ALIGN_EPI) { if (wr == 0) PG8_BAR; }
    PG8_BAR;
    if constexpr (Epi::AFTER_DRAIN) { E.fused(acc, cur, wr, wc, fr, fq, lds, wid, lane); S.done(cur); }
#undef PG8_SA
#undef PG8_SB
#undef PG8_STAGE
#undef PG8_LDA
#undef PG8_LDB
#undef PG8_MMA
#undef PG8_WAIT_V
#undef PG8_WAIT_L
#undef PG8_BAR
#undef PG8_SCHED
}
}
constexpr int BATCH = 4, SEQ = 4096, NMETA = 16, SL = SEQ + NMETA  , NT = BATCH * SL  , MP = 16640  , D = 1024;
constexpr int DSA_LDW = 2696, DSA_NP = 2816, DQ0 = 0, DK0 = 1024, DV0 = 1280, DIQ0 = 1536, DIK0 = 2560, DIW0 = 2688;
constexpr int ML_LDW = 3080, ML_NP = 3072, MQ0 = 0, MK0 = 512, MV0 = 1024, MO0 = 2048, MG0 = 3072;
constexpr int FF = 3584, GU = 7168, NE = 8;
constexpr int MOE_ROWS = 35072;
constexpr int NWAVES = 8, NTHREADS = 512;
#ifndef FP8_DENSE
#define FP8_DENSE 1
#endif
#ifndef FP8_MOE
#define FP8_MOE 1
#endif
constexpr float SW_GU = 32.0f, SW_DN = 128.0f, SA_ACT = 4.0f;
#ifndef CONV_IN_PROLOGUE
#define CONV_IN_PROLOGUE 0
#endif
#ifndef H_BF16
#define H_BF16 1
#endif
#ifndef MOE_GU_BMAJOR
#define MOE_GU_BMAJOR 0
#endif
#ifndef FP8_DSA
#define FP8_DSA 0
#endif
#ifndef FP8_DSA_IN
#define FP8_DSA_IN 0
#endif
constexpr float SW_DIN = 32.0f, SW_DOUT = 64.0f, SA_ATT = 16.0f;
constexpr int SCLD = 4128;
constexpr float RMS_EPS = 1e-6f;
constexpr size_t MiB = 1u << 20;
constexpr size_t WS_CTL = 0, CTL_ZERO_BYTES = 1 * MiB;
constexpr size_t WS_ROPE = 1 * MiB;
constexpr size_t WS_SM8 = 4 * MiB;
constexpr size_t WS_ROUTE = 5 * MiB;
constexpr size_t WS_MLG = 6 * MiB;
constexpr size_t WS_MLI = 17 * MiB + 256 * 1024;
constexpr size_t WS_NH = 7 * MiB;
constexpr size_t WS_SLOT = 8 * MiB;
constexpr size_t WS_SEL = 9 * MiB;
constexpr size_t WS_WDSA_IN = 18 * MiB, WS_WDSA_OUT = 29 * MiB, WS_WML_IN = 33 * MiB, WS_WML_OUT = 45 * MiB, WS_WFFN_GU = 49 * MiB, WS_WFFN_DN = 77 * MiB;
constexpr size_t WS_WMOE_GU = 91 * MiB, WS_WMOE_DN = 315 * MiB;
constexpr size_t WS_H = 427 * MiB;
constexpr size_t WS_XN = 492 * MiB;
constexpr size_t WS_R = 525 * MiB, WS_K8 = 875 * MiB, WS_XN8 = 875 * MiB, WS_END = 892 * MiB;
constexpr size_t R_PROJ = 0, R_SC = 90 * MiB, R_ACT = 0, R_DC = 98 * MiB, R_CH = 130 * MiB, R_AS = 240 * MiB, R_Y0 = 240 * MiB, R_Y1 = 274 * MiB;
static_assert(R_SC + (size_t)NT * SCLD * 4 + 16384 <= WS_K8 - WS_R, "score matrix (+ 8 KiB of never-read store slots behind it) fits");
static_assert((size_t)MOE_ROWS * FF * 2 <= R_AS && R_AS + (size_t)MOE_ROWS * D * 2 <= WS_K8 - WS_R, "moe buffers fit");
static_assert((size_t)MP * DSA_NP * 2 <= R_SC && (size_t)MP * ML_NP * 2 <= R_DC, "proj fits");
constexpr int CW_BAR = 4096;
constexpr int CW_CNT = 8192;
constexpr int LDS_BYTES = 151552;
constexpr int MISC_OFF = LDS_BYTES - 256;

#define GAS __attribute__((address_space(1)))
#define LAS __attribute__((address_space(3)))
typedef unsigned short bf16;
#if H_BF16
typedef unsigned short HT;
#else
typedef float HT;
#endif
typedef float f32x4 __attribute__((ext_vector_type(4)));
typedef float f32x2 __attribute__((ext_vector_type(2)));
typedef float f32x16 __attribute__((ext_vector_type(16)));
typedef short bf16x8 __attribute__((ext_vector_type(8)));
typedef short s16x4 __attribute__((ext_vector_type(4)));
typedef unsigned u32x4 __attribute__((ext_vector_type(4)));
typedef unsigned u32x2 __attribute__((ext_vector_type(2)));
#define MFMA32(a, b, c) __builtin_amdgcn_mfma_f32_32x32x16_bf16((a), (b), (c), 0, 0, 0)
#define MFMA16(a, b, c) __builtin_amdgcn_mfma_f32_16x16x32_bf16((a), (b), (c), 0, 0, 0)
__device__ __forceinline__ float bf2f(unsigned short b) { return __uint_as_float(((unsigned)b) << 16); }
__device__ __forceinline__ float bflo(unsigned w) { return __uint_as_float(w << 16); }
__device__ __forceinline__ float bfhi(unsigned w) { return __uint_as_float(w & 0xffff0000u); }
__device__ __forceinline__ unsigned pk2(float lo, float hi) { return pg8::cvt_pk_bf16(lo, hi); }
__device__ __forceinline__ float wave_sum(float v) {
#pragma unroll
    for (int o = 1; o < 64; o <<= 1) v += __shfl_xor(v, o);
    return v; }
__device__ __forceinline__ int crow(int r, int hi) { return (r & 3) + 8 * (r >> 2) + 4 * hi; }

#define XB_TMO      128
#define XB_XCNT(j)  (256  + 64 * (j))
#define XB_XSUB(j)  (1280 + 64 * (j))
#define XB_XGEN(j)  (2304 + 64 * (j))
#define XB_TOP      3328
#define XB_TOPGEN   3392
#define XCD_BAR_WORDS 3456
#define XB_SPIN_CAP (1u << 18)
__device__ __forceinline__ unsigned xb_ld(unsigned* p)              { return __hip_atomic_load(p, __ATOMIC_RELAXED, __HIP_MEMORY_SCOPE_AGENT); }
__device__ __forceinline__ unsigned xb_add(unsigned* p, unsigned v) { return __hip_atomic_fetch_add(p, v, __ATOMIC_RELAXED, __HIP_MEMORY_SCOPE_AGENT); }
__device__ __forceinline__ unsigned xb_xcc_id() { return (unsigned)__builtin_amdgcn_s_getreg((3 << 11) | 20) & 0xFu; }
#define XB_SPIN(cond, bar) do { unsigned _sp = 0; while (cond) { __builtin_amdgcn_s_sleep(1); \
    if ((++_sp & 255u) == 0u) { if (xb_ld(&(bar)[XB_TMO])) break; if (_sp > XB_SPIN_CAP) { atomicAdd(&(bar)[XB_TMO], 1u); break; } } } } while (0)
__device__ __forceinline__ int hw_lane() { int l; asm volatile("v_mbcnt_lo_u32_b32 %0, -1, 0\n\tv_mbcnt_hi_u32_b32 %0, -1, %0" : "=v"(l)); return l; }
struct XcdBarrier { unsigned* bar; unsigned x; volatile LAS unsigned* st; int wave; };
__device__ __forceinline__ XcdBarrier xcd_barrier_post(unsigned* bar, volatile LAS unsigned* st, int wave) {
    XcdBarrier b; b.bar = bar; b.x = xb_xcc_id(); b.st = st; b.wave = wave;
    if (wave == 0 && hw_lane() == 0) (void)xb_add(&bar[XB_XCNT(b.x)], 1u);
    return b;
}
__device__ __forceinline__ void xcd_barrier_complete(unsigned* bar, unsigned x, unsigned& nloc, unsigned& nx) {
    const unsigned G = gridDim.x * gridDim.y * gridDim.z;
    unsigned sum, cnt, mine, sp = 0u;
    for (;;) {
        sum = 0u; cnt = 0u; mine = 0u;
#pragma unroll
        for (unsigned j = 0; j < 16; ++j) { const unsigned c = xb_ld(&bar[XB_XCNT(j)]); sum += c; cnt += (c > 0u) ? 1u : 0u; mine = (j == x) ? c : mine; }
        if (sum == G) break;
        __builtin_amdgcn_s_sleep(1);
        if ((++sp & 255u) == 0u) { if (xb_ld(&bar[XB_TMO])) break; if (sp > XB_SPIN_CAP) { atomicAdd(&bar[XB_TMO], 1u); break; } }
    }
    nloc = mine > 0u ? mine : 1u; nx = cnt > 0u ? cnt : 1u;
}
__device__ __forceinline__ void xcd_barrier(const XcdBarrier& b) {
    asm volatile("s_waitcnt vmcnt(0)" ::: "memory");
    __syncthreads();
    if (b.wave == 0 && hw_lane() == 0) {
        unsigned* bar = b.bar;
        __builtin_amdgcn_s_waitcnt(0);
        unsigned nloc = b.st[0], nx = b.st[1];
        if (nloc == 0u) { xcd_barrier_complete(bar, b.x, nloc, nx); b.st[0] = nloc; b.st[1] = nx; }
        const unsigned old = xb_add(&bar[XB_XSUB(b.x)], 1u);
        const unsigned gen = old / nloc;
        if (old + 1u == (gen + 1u) * nloc) {
            __builtin_amdgcn_fence(__ATOMIC_RELEASE, "agent");
            asm volatile("s_waitcnt vmcnt(0)" ::: "memory");
            (void)xb_add(&bar[XB_TOP], 1u);
        }
        const unsigned target = (gen + 1u) * nx;
        XB_SPIN(xb_ld(&bar[XB_TOP]) < target, bar);
        __builtin_amdgcn_fence(__ATOMIC_ACQUIRE, "agent");
        asm volatile("s_waitcnt vmcnt(0)" ::: "memory");
    }
    __syncthreads();
}

struct Params { const float* in[20]; float* out; unsigned char* ws; int ph_lo, ph_hi; };
struct Ctx {
    LAS unsigned char* lds; int tid, lane, wave, G, bid, gw, ngw;
    unsigned* ctl;
    float2* rope; float* sm8; int* route_e; int* route_r1; int* route_r2; float* route_g1;
    float* mlf; float* mlc; float* mlp; float* mli; float* mlg; float* dn; float* nh; int* slot_tok; float* slot_g; unsigned short* sel;
    bf16 *wdsa_in, *wdsa_out, *wml_in, *wml_out, *wffn_gu, *wffn_dn, *wmoe_gu, *wmoe_dn;
    HT* H; bf16* XN; unsigned char* R; unsigned char* xn8;
};
__device__ __forceinline__ void conv_item(const float* W, int K, int ld, int n0, int k0, bf16* WT, int drow0, LAS float* scr, int lane) {
#pragma unroll 8
    for (int i = 0; i < 32; ++i) { const int kk = 2 * i + (lane >> 5); scr[kk * 33 + (lane & 31)] = W[(size_t)(k0 + kk) * ld + n0 + (lane & 31)]; }
    asm volatile("s_waitcnt lgkmcnt(0)" ::: "memory");
    const int c = lane & 7;
#pragma unroll
    for (int j = 0; j < 4; ++j) { const int n = (lane >> 3) + 8 * j; const LAS float* s = scr + (8 * c) * 33 + n;
        u32x4 o; o.x = pk2(s[0 * 33], s[1 * 33]); o.y = pk2(s[2 * 33], s[3 * 33]); o.z = pk2(s[4 * 33], s[5 * 33]); o.w = pk2(s[6 * 33], s[7 * 33]);
        *(u32x4*)(WT + (size_t)(drow0 + n) * K + k0 + 8 * c) = o; }
    asm volatile("s_waitcnt lgkmcnt(0)" ::: "memory");
}
__device__ __forceinline__ void conv_item8(const float* W, int K, int ld, int n0, int k0, unsigned char* WT, int drow0, LAS float* scr, int lane, float scale) {
#pragma unroll 8
    for (int i = 0; i < 32; ++i) { const int kk = 2 * i + (lane >> 5); scr[kk * 33 + (lane & 31)] = W[(size_t)(k0 + kk) * ld + n0 + (lane & 31)]; }
    asm volatile("s_waitcnt lgkmcnt(0)" ::: "memory");
    const int c = lane & 7;
#pragma unroll
    for (int j = 0; j < 4; ++j) { const int n = (lane >> 3) + 8 * j; const LAS float* s = scr + (8 * c) * 33 + n;
        u32x2 o; o.x = pg8::cvt4_fp8(s[0 * 33] * scale, s[1 * 33] * scale, s[2 * 33] * scale, s[3 * 33] * scale); o.y = pg8::cvt4_fp8(s[4 * 33] * scale, s[5 * 33] * scale, s[6 * 33] * scale, s[7 * 33] * scale);
        *(u32x2*)(WT + (size_t)(drow0 + n) * K + k0 + 8 * c) = o; }
    asm volatile("s_waitcnt lgkmcnt(0)" ::: "memory");
}
__device__ __forceinline__ void conv_plain8(const float* W, int K, int N, int ld, unsigned char* WT, int item, LAS float* scr, int lane, float scale) {
    const int nblk = N / 32, kb = item / nblk, nb = item % nblk;
    conv_item8(W, K, ld, 32 * nb, 64 * kb, WT, 32 * nb, scr, lane, scale);
}
__device__ __forceinline__ void conv_gu8(const float* W, int isup, unsigned char* WT, int item, LAS float* scr, int lane, float scale) {
    const int nblk = FF / 32, kb = item / nblk, nb = item % nblk, n0 = 32 * nb;
    conv_item8(W, D, FF, n0, 64 * kb, WT, 256 * (n0 >> 7) + 128 * isup + (n0 & 127), scr, lane, scale);
}
__device__ __forceinline__ void conv_plain(const float* W, int K, int N, int ld, bf16* WT, int item, LAS float* scr, int lane) {
    const int nblk = N / 32, kb = item / nblk, nb = item % nblk;
    conv_item(W, K, ld, 32 * nb, 64 * kb, WT, 32 * nb, scr, lane);
}
__device__ __forceinline__ void conv_gu(const float* W, int isup, bf16* WT, int item, LAS float* scr, int lane) {
    const int nblk = FF / 32, kb = item / nblk, nb = item % nblk, n0 = 32 * nb;
    conv_item(W, D, FF, n0, 64 * kb, WT, 256 * (n0 >> 7) + 128 * isup + (n0 & 127), scr, lane);
}
typedef const __attribute__((address_space(4))) Params* KArgP;
__device__ __forceinline__ void conv_big(const Ctx& C, KArgP P, int m, int r, LAS float* scr) {
    unsigned char* gu8d = (unsigned char*)C.wffn_gu; unsigned char* dn8d = (unsigned char*)C.wffn_dn; unsigned char* gu8m = (unsigned char*)C.wmoe_gu; unsigned char* dn8m = (unsigned char*)C.wmoe_dn;
    if (m < 2) { if (FP8_DENSE) conv_gu8(P->in[13] + (size_t)m * D * FF, 0, gu8d + (size_t)m * GU * D, r, scr, C.lane, SW_GU); else conv_gu(P->in[13] + (size_t)m * D * FF, 0, C.wffn_gu + (size_t)m * GU * D, r, scr, C.lane); }
    else if (m < 4) { if (FP8_DENSE) conv_gu8(P->in[14] + (size_t)(m - 2) * D * FF, 1, gu8d + (size_t)(m - 2) * GU * D, r, scr, C.lane, SW_GU); else conv_gu(P->in[14] + (size_t)(m - 2) * D * FF, 1, C.wffn_gu + (size_t)(m - 2) * GU * D, r, scr, C.lane); }
    else if (m < 6) { if (FP8_DENSE) conv_plain8(P->in[15] + (size_t)(m - 4) * FF * D, FF, D, D, dn8d + (size_t)(m - 4) * D * FF, r, scr, C.lane, SW_DN); else conv_plain(P->in[15] + (size_t)(m - 4) * FF * D, FF, D, D, C.wffn_dn + (size_t)(m - 4) * D * FF, r, scr, C.lane); }
    else if (m < 22) { if (FP8_MOE) conv_gu8(P->in[17] + (size_t)(m - 6) * D * FF, 0, gu8m + (size_t)(m - 6) * GU * D, r, scr, C.lane, SW_GU); else conv_gu(P->in[17] + (size_t)(m - 6) * D * FF, 0, C.wmoe_gu + (size_t)(m - 6) * GU * D, r, scr, C.lane); }
    else if (m < 38) { if (FP8_MOE) conv_gu8(P->in[18] + (size_t)(m - 22) * D * FF, 1, gu8m + (size_t)(m - 22) * GU * D, r, scr, C.lane, SW_GU); else conv_gu(P->in[18] + (size_t)(m - 22) * D * FF, 1, C.wmoe_gu + (size_t)(m - 22) * GU * D, r, scr, C.lane); }
    else { if (FP8_MOE) conv_plain8(P->in[19] + (size_t)(m - 38) * FF * D, FF, D, D, dn8m + (size_t)(m - 38) * D * FF, r, scr, C.lane, SW_DN); else conv_plain(P->in[19] + (size_t)(m - 38) * FF * D, FF, D, D, C.wmoe_dn + (size_t)(m - 38) * D * FF, r, scr, C.lane); }
}
struct ConvD { const float* src; unsigned char* dst; int K; float scale; };
template <int LD>
__device__ __forceinline__ void conv_ld32(const float* src, int lane, float (&v)[32]) {
    const float* p = src + (size_t)(lane >> 5) * LD + (lane & 31);
#pragma unroll
    for (int i = 0; i < 32; ++i) v[i] = p[(size_t)(2 * i) * LD];
}
__device__ __forceinline__ void conv_st8(const ConvD& d, const float (&v)[32], LAS float* scr, int lane) {
#pragma unroll
    for (int i = 0; i < 32; ++i) scr[(2 * i + (lane >> 5)) * 33 + (lane & 31)] = v[i];
    asm volatile("s_waitcnt lgkmcnt(0)" ::: "memory");
    const int c = lane & 7; const float scale = d.scale;
#pragma unroll
    for (int j = 0; j < 4; ++j) { const int n = (lane >> 3) + 8 * j; const LAS float* s = scr + (8 * c) * 33 + n;
        u32x2 o; o.x = pg8::cvt4_fp8(s[0 * 33] * scale, s[1 * 33] * scale, s[2 * 33] * scale, s[3 * 33] * scale); o.y = pg8::cvt4_fp8(s[4 * 33] * scale, s[5 * 33] * scale, s[6 * 33] * scale, s[7 * 33] * scale);
        *(u32x2*)(d.dst + (size_t)n * d.K + 8 * c) = o; }
    asm volatile("s_waitcnt lgkmcnt(0)" ::: "memory");
}
__device__ __forceinline__ bool conv_desc(const Ctx& C, KArgP P, int m, int r, ConvD& d) {
    unsigned char* gu8d = (unsigned char*)C.wffn_gu; unsigned char* dn8d = (unsigned char*)C.wffn_dn; unsigned char* gu8m = (unsigned char*)C.wmoe_gu; unsigned char* dn8m = (unsigned char*)C.wmoe_dn;
    const bool isdn = (m >= 4 && m < 6) || m >= 38;
    if (!isdn) {
        const int isup = (m >= 2 && m < 4) || (m >= 22); const int mm = m < 2 ? m : m < 4 ? m - 2 : m < 22 ? m - 6 : m - 22;
        const float* W = (m < 2 ? P->in[13] : m < 4 ? P->in[14] : m < 22 ? P->in[17] : P->in[18]) + (size_t)mm * D * FF;
        unsigned char* WT = (m < 4 ? gu8d : gu8m) + (size_t)mm * GU * D;
        const int nblk = FF / 32, kb = r / nblk, nb = r % nblk, n0 = 32 * nb, drow0 = 256 * (n0 >> 7) + 128 * isup + (n0 & 127);
        d.src = W + (size_t)(64 * kb) * FF + n0; d.dst = WT + (size_t)drow0 * D + 64 * kb; d.K = D; d.scale = SW_GU; return true;
    } else {
        const int mm = m < 6 ? m - 4 : m - 38;
        const float* W = (m < 6 ? P->in[15] : P->in[19]) + (size_t)mm * FF * D; unsigned char* WT = (m < 6 ? dn8d : dn8m) + (size_t)mm * D * FF;
        const int nblk = D / 32, kb = r / nblk, nb = r % nblk, n0 = 32 * nb;
        d.src = W + (size_t)(64 * kb) * D + n0; d.dst = WT + (size_t)n0 * FF + 64 * kb; d.K = FF; d.scale = SW_DN; return false;
    }
}
constexpr int CONV_TILE = 8 * (256 + 8) * 4;
__device__ __forceinline__ void conv_dma_issue(const ConvD& d, bool pitch_ff, int lane, LAS unsigned char* tile) {
    const unsigned ld = pitch_ff ? FF : D;
    const unsigned voff = ((unsigned)(lane >> 3) * ld + (unsigned)(lane & 7) * 4u) * 4u;
    const char* sb = (const char*)d.src;
#pragma unroll
    for (int t = 0; t < 8; ++t) { __builtin_amdgcn_global_load_lds((const unsigned*)(sb + voff), (LAS unsigned*)(tile + t * 1056), 16, 0, 0); sb += (size_t)ld * 32; }
}
__device__ __forceinline__ void conv_dma_finish(const ConvD& d, const LAS unsigned char* tile, int lane) {
    const int c = lane & 7; const float scale = d.scale;
#pragma unroll
    for (int j = 0; j < 4; ++j) { const int n = (lane >> 3) + 8 * j; const LAS float* s = (const LAS float*)tile + c * 264 + n;
        u32x2 o; o.x = pg8::cvt4_fp8(s[0 * 32] * scale, s[1 * 32] * scale, s[2 * 32] * scale, s[3 * 32] * scale); o.y = pg8::cvt4_fp8(s[4 * 32] * scale, s[5 * 32] * scale, s[6 * 32] * scale, s[7 * 32] * scale);
        *(u32x2*)(d.dst + (size_t)n * d.K + 8 * c) = o; }
    asm volatile("s_waitcnt lgkmcnt(0)" ::: "memory");
}
template <class MOf>
__device__ __forceinline__ void conv_stream(const Ctx& C, KArgP P, int first, int stride, int count, MOf m_of, int scr_pitch = 8448) {
    LAS float* scr = (LAS float*)(C.lds + C.wave * scr_pitch);
    int it = first; if (it >= count) return;
    ConvD da, db; float va[32], vb[32];
#define CONV_LOAD(d, v, i_) do { const bool g_ = conv_desc(C, P, m_of((i_) / 1792), (i_) % 1792, d); if (g_) conv_ld32<FF>(d.src, C.lane, v); else conv_ld32<D>(d.src, C.lane, v); } while (0)
    CONV_LOAD(da, va, it);
    for (;;) {
        const bool hb = it + stride < count;
        if (hb) CONV_LOAD(db, vb, it + stride);
        conv_st8(da, va, scr, C.lane);
        if (!hb) break;
        it += 2 * stride; const bool ha = it < count;
        if (ha) CONV_LOAD(da, va, it);
        conv_st8(db, vb, scr, C.lane);
        if (!ha) break;
    }
#undef CONV_LOAD
}
constexpr int CONV_IB = 1792;
__device__ __forceinline__ void conv_pair(const Ctx& C, KArgP P, int j) {
    conv_stream(C, P, C.gw, C.ngw, 27 * CONV_IB, [j](int q) { return q < 3 ? 2 * q + j : q < 11 ? 6 + 8 * j + (q - 3) : q < 19 ? 22 + 8 * j + (q - 11) : 38 + 8 * j + (q - 19); });
}
__device__ __forceinline__ void prologue_phase(const Ctx& C, KArgP P) {
    LAS float* scr = (LAS float*)(C.lds + C.wave * 8448);
    constexpr int IB = CONV_IB;
    constexpr int N_BIG = CONV_IN_PROLOGUE ? 54 * IB : 0;
    constexpr int I_DIN = 16 * 84, I_SQ = 16 * 32, I_MIN = 16 * 96;
    constexpr int N_SMALL = 2 * (I_DIN + I_SQ + I_MIN + I_SQ);
    if (N_BIG) conv_stream(C, P, C.gw, C.ngw, N_BIG, [](int q) { return q; });
    for (int it = C.gw; it < N_SMALL; it += C.ngw) {
        {
            int r = it;
            const int j = r / (N_SMALL / 2); r -= j * (N_SMALL / 2);
            if (r < I_DIN) { if (FP8_DSA_IN) conv_plain8(P->in[4] + (size_t)j * D * DSA_LDW, D, 2688, DSA_LDW, (unsigned char*)C.wdsa_in + (size_t)j * DSA_NP * D, r, scr, C.lane, SW_DIN);
                             else conv_plain(P->in[4] + (size_t)j * D * DSA_LDW, D, 2688, DSA_LDW, C.wdsa_in + (size_t)j * DSA_NP * D, r, scr, C.lane); continue; } r -= I_DIN;
            if (r < I_SQ) { if (FP8_DSA) conv_plain8(P->in[7] + (size_t)j * D * D, D, D, D, (unsigned char*)C.wdsa_out + (size_t)j * D * D, r, scr, C.lane, SW_DOUT);
                            else conv_plain(P->in[7] + (size_t)j * D * D, D, D, D, C.wdsa_out + (size_t)j * D * D, r, scr, C.lane); continue; } r -= I_SQ;
            if (r < I_MIN) { conv_plain(P->in[8] + (size_t)j * D * ML_LDW, D, ML_NP, ML_LDW, C.wml_in + (size_t)j * ML_NP * D, r, scr, C.lane); continue; } r -= I_MIN;
            conv_plain(P->in[12] + (size_t)j * D * D, D, D, D, C.wml_out + (size_t)j * D * D, r, scr, C.lane);
        }
    }
    const int gt = C.bid * NTHREADS + C.tid, ngt = C.G * NTHREADS;
    for (int i = gt; i < 2 * 128 * D / 8; i += ngt) { const int j = i / (128 * D / 8), o = i % (128 * D / 8);
        if (FP8_DSA_IN) { if (o < 128 * D / 16) *(u32x4*)((unsigned char*)C.wdsa_in + (size_t)j * DSA_NP * D + (size_t)2688 * D + (size_t)o * 16) = (u32x4){0u, 0u, 0u, 0u}; }
        else *(u32x4*)(C.wdsa_in + (size_t)j * DSA_NP * D + (size_t)2688 * D + (size_t)o * 8) = (u32x4){0u, 0u, 0u, 0u}; }
    for (int i = gt; i < (MP - NT) * D / 8; i += ngt) *(u32x4*)(C.XN + (size_t)NT * D + (size_t)i * 8) = (u32x4){0u, 0u, 0u, 0u};
    const float* x = P->in[0]; const float* meta = P->in[1];
    for (int i = gt; i < MP * (D / 4); i += ngt) { const int row = i / (D / 4), c4 = i % (D / 4); f32x4 v = (f32x4){0.f, 0.f, 0.f, 0.f};
        if (row < NT) { const int b = row / SL, p = row % SL;
            v = (p < NMETA) ? *(const f32x4*)(meta + (size_t)p * D + c4 * 4) : *(const f32x4*)(x + ((size_t)b * SEQ + (p - NMETA)) * D + c4 * 4); }
#if H_BF16
        u32x2 hv; hv.x = pk2(v[0], v[1]); hv.y = pk2(v[2], v[3]); *(u32x2*)(C.H + (size_t)row * D + c4 * 4) = hv; }
#else
        *(f32x4*)(C.H + (size_t)row * D + c4 * 4) = v; }
#endif
    for (int i = gt; i < SL * 64; i += ngt) { const int pos = i >> 6, k = i & 63; double inv = 1.0;
        for (int q = 0; q < k; ++q) inv *= 0.86596432336006535;
        const double a = (double)pos * inv; C.rope[i] = make_float2((float)cos(a), (float)sin(a)); }
}

template <int MODE, bool ADDY, bool OUT8 = false>
__device__ __forceinline__ void norm_phase(const Ctx& C, const float* gain, const float* W8, int ldw, int moe_layer, const float* aux0 = nullptr, const float* aux1 = nullptr) {
    const bf16* Y0 = (const bf16*)(C.R + R_Y0); const bf16* Y1 = (const bf16*)(C.R + R_Y1);
    const int lane = C.lane;
    float w8r[4][4][8];
    if (MODE != 3) {
#pragma unroll
        for (int j = 0; j < 4; ++j)
#pragma unroll
            for (int i = 0; i < 4; ++i) { const float* wp = W8 + (size_t)(256 * j + 4 * lane + i) * ldw; const f32x4 w0 = *(const f32x4*)wp, w1 = *(const f32x4*)(wp + 4);
                w8r[j][i][0] = w0[0]; w8r[j][i][1] = w0[1]; w8r[j][i][2] = w0[2]; w8r[j][i][3] = w0[3]; w8r[j][i][4] = w1[0]; w8r[j][i][5] = w1[1]; w8r[j][i][6] = w1[2]; w8r[j][i][7] = w1[3]; }
    }
    f32x4 gv[4];
#pragma unroll
    for (int j = 0; j < 4; ++j) gv[j] = ((const f32x4*)gain)[64 * j + C.lane];
    int prow = -1, pe = 0, pr1 = 0, pr2 = 0; float pg1 = 0.f;
#if H_BF16
    u32x2 hq[4], ya[4], yb[4];
#define NORM_ISSUE(row_) do { const HT* hr_ = C.H + (size_t)(row_) * D; _Pragma("unroll") for (int j = 0; j < 4; ++j) hq[j] = ((const u32x2*)hr_)[64 * j + C.lane]; \
        if (ADDY) { _Pragma("unroll") for (int j = 0; j < 4; ++j) { ya[j] = *(const u32x2*)(Y0 + (size_t)(row_) * D + 256 * j + 4 * C.lane); yb[j] = *(const u32x2*)(Y1 + (size_t)(row_) * D + 256 * j + 4 * C.lane); } } } while (0)
    if (C.gw < NT) NORM_ISSUE(C.gw);
#endif
    for (int row = C.gw; row < NT; row += C.ngw) {
        HT* hrow = C.H + (size_t)row * D;
        f32x4 v[4]; float ss = 0.f;
#if H_BF16
#pragma unroll
        for (int j = 0; j < 4; ++j) { v[j][0] = bflo(hq[j].x); v[j][1] = bfhi(hq[j].x); v[j][2] = bflo(hq[j].y); v[j][3] = bfhi(hq[j].y); }
        if (ADDY) {
#pragma unroll
            for (int j = 0; j < 4; ++j) { const u32x2 a = ya[j], b = yb[j];
                v[j][0] += bflo(a.x) + bflo(b.x); v[j][1] += bfhi(a.x) + bfhi(b.x); v[j][2] += bflo(a.y) + bflo(b.y); v[j][3] += bfhi(a.y) + bfhi(b.y);
                { u32x2 hv; hv.x = pk2(v[j][0], v[j][1]); hv.y = pk2(v[j][2], v[j][3]); ((u32x2*)hrow)[64 * j + C.lane] = hv; } }
        }
        if (row + C.ngw < NT) NORM_ISSUE(row + C.ngw);
#else
#pragma unroll
        for (int j = 0; j < 4; ++j) v[j] = ((const f32x4*)hrow)[64 * j + C.lane];
        if (ADDY) {
#pragma unroll
            for (int j = 0; j < 4; ++j) { const u32x2 a = *(const u32x2*)(Y0 + (size_t)row * D + 256 * j + 4 * C.lane), b = *(const u32x2*)(Y1 + (size_t)row * D + 256 * j + 4 * C.lane);
                v[j][0] += bflo(a.x) + bflo(b.x); v[j][1] += bfhi(a.x) + bfhi(b.x); v[j][2] += bflo(a.y) + bflo(b.y); v[j][3] += bfhi(a.y) + bfhi(b.y);
                ((f32x4*)hrow)[64 * j + C.lane] = v[j]; }
        }
#endif
#pragma unroll
        for (int j = 0; j < 4; ++j) ss += (v[j][0] * v[j][0] + v[j][1] * v[j][1]) + (v[j][2] * v[j][2] + v[j][3] * v[j][3]);
        const float rstd = 1.0f / sqrtf(wave_sum(ss) * (1.0f / D) + RMS_EPS);
#pragma unroll
        for (int j = 0; j < 4; ++j) { const f32x4 g = gv[j]; v[j] = v[j] * rstd * g;
            if (OUT8) *(unsigned*)(C.xn8 + (size_t)row * D + 256 * j + 4 * C.lane) = pg8::cvt4_fp8(v[j][0], v[j][1], v[j][2], v[j][3]);
            else { u32x2 o; o.x = pk2(v[j][0], v[j][1]); o.y = pk2(v[j][2], v[j][3]); *(u32x2*)(C.XN + (size_t)row * D + 256 * j + 4 * C.lane) = o; } }
        if (MODE != 3) {
            float dot[8];
#pragma unroll
            for (int e = 0; e < 8; ++e) dot[e] = 0.f;
#pragma unroll
            for (int j = 0; j < 4; ++j)
#pragma unroll
                for (int i = 0; i < 4; ++i) { const float y = v[j][i];
#pragma unroll
                    for (int e = 0; e < 8; ++e) dot[e] = fmaf(y, w8r[j][i][e], dot[e]); }
            float r4[4], r2[2], r1;
#pragma unroll
            for (int k = 0; k < 4; ++k) { const float send = (lane & 1) ? dot[k] : dot[4 + k], keep = (lane & 1) ? dot[4 + k] : dot[k]; r4[k] = keep + __shfl_xor(send, 1); }
#pragma unroll
            for (int k = 0; k < 2; ++k) { const float send = (lane & 2) ? r4[k] : r4[2 + k], keep = (lane & 2) ? r4[2 + k] : r4[k]; r2[k] = keep + __shfl_xor(send, 2); }
            { const float send = (lane & 4) ? r2[0] : r2[1], keep = (lane & 4) ? r2[1] : r2[0]; r1 = keep + __shfl_xor(send, 4); }
            r1 += __shfl_xor(r1, 8); r1 += __shfl_xor(r1, 16); r1 += __shfl_xor(r1, 32);
            const int ev = 4 * (lane & 1) + 2 * ((lane >> 1) & 1) + ((lane >> 2) & 1);
            if (MODE == 0) { if (lane < 8) C.sm8[(size_t)row * 8 + ev] = r1 * 0.03125f; }
            if (MODE == 1) {
                if (lane < 8) { const int b = row / SL, pos = row % SL, sl_ = pos / 65, si = pos % 65, h = ev & 3;
                    const float z = (r1 + (ev < 4 ? aux0[h] : aux1[h])) * (2.0f / 15.0f);
                    const float x = 15.0f * (1.0f - 2.0f / (1.0f + __expf(z)));
                    float* dst = (ev < 4 ? C.mli : C.mlg) + ((b * 4 + h) * 65 + si) * 64 + sl_;
                    *dst = (ev < 4) ? x : fminf(x, 0.f) - __logf(1.0f + __expf(-fabsf(x))); } }
            if (MODE == 2) {
#pragma unroll
                for (int e = 0; e < 8; ++e) dot[e] = __shfl(r1, (e >> 2) + 2 * ((e >> 1) & 1) + 4 * (e & 1));
                if (lane == 0) {
                    float v1 = dot[0]; int e1 = 0;
#pragma unroll
                    for (int e = 1; e < 8; ++e) if (dot[e] > v1) { v1 = dot[e]; e1 = e; }
                    float v2 = -INFINITY; int e2 = 0;
#pragma unroll
                    for (int e = 0; e < 8; ++e) if (e != e1 && dot[e] > v2) { v2 = dot[e]; e2 = e; }
                    const float g1 = 1.0f / (1.0f + expf(v2 - v1));
                    const int r1i = (int)atomicAdd(C.ctl + CW_CNT + (moe_layer * 8 + e1) * 64, 1u), r2i = (int)atomicAdd(C.ctl + CW_CNT + (moe_layer * 8 + e2) * 64, 1u);
                    if (prow >= 0) { C.route_e[prow] = pe; C.route_r1[prow] = pr1; C.route_r2[prow] = pr2; C.route_g1[prow] = pg1; }
                    prow = row; pe = e1 | (e2 << 8); pr1 = r1i; pr2 = r2i; pg1 = g1;
                }
            }
        }
    }
    if (MODE == 2) { if (lane == 0 && prow >= 0) { C.route_e[prow] = pe; C.route_r1[prow] = pr1; C.route_r2[prow] = pr2; C.route_g1[prow] = pg1; } }
#if H_BF16
#undef NORM_ISSUE
#endif
}

__device__ __forceinline__ void unpack8(const u32x4 w, float (&x)[8]) { x[0] = bflo(w.x); x[1] = bfhi(w.x); x[2] = bflo(w.y); x[3] = bfhi(w.y); x[4] = bflo(w.z); x[5] = bfhi(w.z); x[6] = bflo(w.w); x[7] = bfhi(w.w); }
__device__ __forceinline__ u32x4 pack8(const float (&x)[8]) { u32x4 w; w.x = pk2(x[0], x[1]); w.y = pk2(x[2], x[3]); w.z = pk2(x[4], x[5]); w.w = pk2(x[6], x[7]); return w; }
__device__ __forceinline__ void dsa_post_phase(const Ctx& C, const float* gq, const float* gk) {
    bf16* PROJ = (bf16*)(C.R + R_PROJ);
    for (int row = C.gw; row < NT; row += C.ngw) {
        const int pos = row % SL; bf16* pr = PROJ + (size_t)row * DSA_NP; const float2* rp = C.rope + (size_t)pos * 64;
        const int lane = C.lane;
#pragma unroll
        for (int pass = 0; pass < 2; ++pass) {
            if (pass == 1 && lane >= 16) break;
            const int head = lane >> 2, part = lane & 3; bf16* hp = pr + (pass == 0 ? DQ0 : DK0) + head * 64 + 8 * part; const float* gg = pass == 0 ? gq : gk;
            float x1[8], x2[8]; unpack8(*(const u32x4*)hp, x1); unpack8(*(const u32x4*)(hp + 32), x2);
            float ss = 0.f;
#pragma unroll
            for (int e = 0; e < 8; ++e) ss += x1[e] * x1[e] + x2[e] * x2[e];
            ss += __shfl_xor(ss, 1); ss += __shfl_xor(ss, 2);
            const float rstd = 1.0f / sqrtf(ss * (1.0f / 64.0f) + RMS_EPS), osc = pass == 0 ? 0.125f : 1.0f;
#pragma unroll
            for (int e = 0; e < 8; ++e) { const int i = 8 * part + e; const float2 cs = rp[2 * i];
                const float y1 = x1[e] * rstd * gg[i], y2 = x2[e] * rstd * gg[i + 32];
                x1[e] = (y1 * cs.x - y2 * cs.y) * osc; x2[e] = (y2 * cs.x + y1 * cs.y) * osc; }
            *(u32x4*)hp = pack8(x1); *(u32x4*)(hp + 32) = pack8(x2);
        }
#pragma unroll
        for (int pass = 0; pass < 2; ++pass) {
            if (pass == 1 && lane >= 8) break;
            const int head = lane >> 3, part = lane & 7; bf16* hp = pr + (pass == 0 ? DIQ0 + head * 128 : DIK0) + 8 * part;
            float x1[8], x2[8]; unpack8(*(const u32x4*)hp, x1); unpack8(*(const u32x4*)(hp + 64), x2);
#pragma unroll
            for (int e = 0; e < 8; ++e) { const float2 cs = rp[8 * part + e]; const float y1 = x1[e], y2 = x2[e];
                x1[e] = y1 * cs.x - y2 * cs.y; x2[e] = y2 * cs.x + y1 * cs.y; }
            *(u32x4*)hp = pack8(x1); *(u32x4*)(hp + 64) = pack8(x2);
        }
    }
}
__device__ __forceinline__ void score_phase(const Ctx& C) {
    const bf16* PROJ = (const bf16*)(C.R + R_PROJ); float* SC = (float*)(C.R + R_SC);
    const int lane = C.lane, m31 = lane & 31, hi = lane >> 5, w = C.wave;
    const int aq = 2 * (m31 >> 4) + ((m31 >> 2) & 1), ah = 4 * ((m31 >> 3) & 1) + (m31 & 3);
    constexpr int SCP = 1088, SCB = 8 * SCP;
    LAS unsigned char* ring = C.lds;
    const LAS unsigned char* bfp = ring + (m31 >> 2) * SCP + 64 * hi + 16 * (m31 & 3);
    constexpr int TPB = 65 + 57 + 49 + 41 + 33 + 25 + 17 + 9 + 1;
    for (int t = C.bid; t < BATCH * TPB; t += C.G) {
        const int b = t / TPB, tt = t % TPB;
        const int kc = (tt >= 65) + (tt >= 122) + (tt >= 171) + (tt >= 212) + (tt >= 245) + (tt >= 270) + (tt >= 287) + (tt >= 296);
        const int toff = 65 * kc - 4 * kc * (kc - 1);
        const int qg = 64 * kc + 8 * (tt - toff) + w; const bool act = qg < 514;
        const int qgc = act ? qg : 513, q0 = 8 * qgc, k0 = 512 * kc;
        const int qlast = 64 * kc + 8 * (tt - toff) + 7, qmax = (qlast < 514 ? qlast : 513) * 8 + 8;
        const int kendw = (k0 + 512 < q0 + 8) ? k0 + 512 : q0 + 8;
        const int kendg = (k0 + 512 < qmax) ? k0 + 512 : qmax;
        const int nkt = (kendg - k0 + 31) >> 5, nktw = act ? (kendw - k0 + 31) >> 5 : 0;
        bf16x8 a[2][8]; f32x4 wv[2][4];
#pragma unroll
        for (int rb = 0; rb < 2; ++rb) {
            const bf16* ap = PROJ + (size_t)(b * SL + q0 + 4 * rb + aq) * DSA_NP + DIQ0 + ah * 128 + 8 * hi;
#pragma unroll
            for (int ks = 0; ks < 8; ++ks) a[rb][ks] = *(const bf16x8*)(ap + 16 * ks);
            const float* w0 = C.sm8 + (size_t)(b * SL + q0 + 4 * rb + hi) * 8; const float* w1 = w0 + 16;
            wv[rb][0] = *(const f32x4*)w0; wv[rb][1] = *(const f32x4*)(w0 + 4); wv[rb][2] = *(const f32x4*)w1; wv[rb][3] = *(const f32x4*)(w1 + 4);
        }
        float* sc0 = SC + (size_t)(b * SL + q0 + hi) * SCLD;
        const bf16* ikb = PROJ + (size_t)b * SL * DSA_NP + DIK0 + (lane >> 2) * 8;
        const int kr0 = k0 + 4 * w + (lane & 3);
#define SC_ISSUE(kt_) do { if ((kt_) < nkt) { const int key_ = kr0 + 32 * (kt_), kc_ = key_ < SL ? key_ : SL - 1; \
            __builtin_amdgcn_global_load_lds((const unsigned*)(ikb + (size_t)kc_ * DSA_NP), (LAS unsigned*)(ring + ((kt_) & 3) * SCB + w * SCP), 16, 0, 0); } } while (0)
        asm volatile("s_waitcnt vmcnt(0)" ::: "memory");
#pragma unroll
        for (int rb = 0; rb < 2; ++rb) {
#pragma unroll
            for (int ks = 0; ks < 8; ++ks) asm volatile("" : "+v"(a[rb][ks]));
#pragma unroll
            for (int q = 0; q < 4; ++q) asm volatile("" : "+v"(wv[rb][q])); }
        __builtin_amdgcn_s_barrier();
        SC_ISSUE(0); SC_ISSUE(1); SC_ISSUE(2);
        float* dum = SC + (size_t)NT * SCLD + 4 * C.tid;
        for (int kt = 0; kt < nkt; ++kt) {
            { const int cnt = 4 * (kt < 3 ? kt : 3) + (kt + 1 < nkt) + (kt + 2 < nkt);
              switch (cnt) { case 0: asm volatile("s_waitcnt vmcnt(0)" ::: "memory"); break; case 1: asm volatile("s_waitcnt vmcnt(1)" ::: "memory"); break; case 2: asm volatile("s_waitcnt vmcnt(2)" ::: "memory"); break;
                case 4: asm volatile("s_waitcnt vmcnt(4)" ::: "memory"); break; case 5: asm volatile("s_waitcnt vmcnt(5)" ::: "memory"); break; case 6: asm volatile("s_waitcnt vmcnt(6)" ::: "memory"); break;
                case 8: asm volatile("s_waitcnt vmcnt(8)" ::: "memory"); break; case 9: asm volatile("s_waitcnt vmcnt(9)" ::: "memory"); break; case 10: asm volatile("s_waitcnt vmcnt(10)" ::: "memory"); break;
                case 12: asm volatile("s_waitcnt vmcnt(12)" ::: "memory"); break; case 13: asm volatile("s_waitcnt vmcnt(13)" ::: "memory"); break; default: asm volatile("s_waitcnt vmcnt(14)" ::: "memory"); break; } }
            __builtin_amdgcn_s_barrier();
            asm volatile("" ::: "memory");
            SC_ISSUE(kt + 3);
            asm volatile("" ::: "memory");
            const int key = k0 + 32 * kt + m31;
            float v00 = 0.f, v01 = 0.f, v10 = 0.f, v11 = 0.f;
            if (kt < nktw) {
                const LAS unsigned char* bp = bfp + (kt & 3) * SCB;
                bf16x8 bf_[8];
#pragma unroll
                for (int ks = 0; ks < 8; ++ks) bf_[ks] = *(const LAS bf16x8*)(bp + 128 * ks);
                asm volatile("s_waitcnt lgkmcnt(0)" ::: "memory");
                f32x16 acc0, acc1;
#pragma unroll
                for (int r = 0; r < 16; ++r) { acc0[r] = 0.f; acc1[r] = 0.f; }
#pragma unroll
                for (int ks = 0; ks < 8; ++ks) { acc0 = MFMA32(a[0][ks], bf_[ks], acc0); acc1 = MFMA32(a[1][ks], bf_[ks], acc1); }
#pragma unroll
                for (int e = 0; e < 8; ++e) { v00 = fmaf(fmaxf(acc0[e], 0.f), wv[0][e >> 2][e & 3], v00); v01 = fmaf(fmaxf(acc0[8 + e], 0.f), wv[0][2 + (e >> 2)][e & 3], v01);
                    v10 = fmaf(fmaxf(acc1[e], 0.f), wv[1][e >> 2][e & 3], v10); v11 = fmaf(fmaxf(acc1[8 + e], 0.f), wv[1][2 + (e >> 2)][e & 3], v11); }
            }
            const bool okst = kt < nktw && key < kendw;
            float* p0 = okst ? sc0 + key : dum; float* p1 = okst ? sc0 + (size_t)2 * SCLD + key : dum + 1; float* p2 = okst ? sc0 + (size_t)4 * SCLD + key : dum + 2; float* p3 = okst ? sc0 + (size_t)6 * SCLD + key : dum + 3;
            asm volatile("" ::: "memory");
            __builtin_nontemporal_store(v00, p0); __builtin_nontemporal_store(v01, p1); __builtin_nontemporal_store(v10, p2); __builtin_nontemporal_store(v11, p3);
            asm volatile("" ::: "memory");
        }
#undef SC_ISSUE
    }
}

template <int NR>
__device__ __forceinline__ void topk_keys(const float* sr, unsigned (&k)[NR], int n, int lane) {
    float v[NR];
#pragma unroll
    for (int j = 0; j < NR; ++j) { const int idx = 64 * j + lane; v[j] = __builtin_nontemporal_load(sr + (idx < n ? idx : n - 1)); }
#pragma unroll
    for (int j = 0; j < NR; ++j) { const int idx = 64 * j + lane; const unsigned u = __float_as_uint(v[j] + 0.0f); const unsigned key = (u & 0x80000000u) ? ~u : (u | 0x80000000u);
        k[j] = idx < n ? key : 0u; }
}
constexpr int TOPK_MID_BIT = -1, TOPK_MID_NR = 40;
template <int NR, class Mid>
__device__ __forceinline__ void topk_select(const unsigned (&k)[NR], unsigned short* sel, int lane, Mid mid) {
    unsigned T = 0u; bool exact = false;
    for (int bit = 31; bit >= 0; --bit) {
        if (bit == TOPK_MID_BIT) mid();
        const unsigned cand = T | (1u << bit); int cl = 0;
#define TK_CA(n_) "v_cmp_ge_u32 vcc, %" #n_ ", %1\n\tv_addc_co_u32 %0, vcc, 0, %0, vcc\n\t"
#pragma unroll
        for (int j = 0; j + 8 <= NR; j += 8)
            asm(TK_CA(2) TK_CA(3) TK_CA(4) TK_CA(5) TK_CA(6) TK_CA(7) TK_CA(8) TK_CA(9) : "+v"(cl) : "v"(cand), "v"(k[j]), "v"(k[j + 1]), "v"(k[j + 2]), "v"(k[j + 3]), "v"(k[j + 4]), "v"(k[j + 5]), "v"(k[j + 6]), "v"(k[j + 7]) : "vcc");
#pragma unroll
        for (int j = NR & ~7; j < NR; ++j) asm("v_cmp_ge_u32 vcc, %1, %2\n\tv_addc_co_u32 %0, vcc, 0, %0, vcc" : "+v"(cl) : "v"(k[j]), "v"(cand) : "vcc");
#undef TK_CA
        int cnt = 0;
#pragma unroll
        for (int bb = 0; bb < 7; ++bb) cnt += __popcll(__ballot((cl >> bb) & 1)) << bb;
        if (cnt >= 256) { T = cand; if (cnt == 256) { exact = true; break; } }
    }
    int base = 0;
#pragma unroll
    for (int j = 0; j < NR; ++j) { const bool f = exact ? (k[j] >= T) : (k[j] > T); const unsigned long long mk = __ballot(f);
        if (f) sel[base + __builtin_amdgcn_mbcnt_hi((unsigned)(mk >> 32), __builtin_amdgcn_mbcnt_lo((unsigned)mk, 0u))] = (unsigned short)(64 * j + lane);
        base += __popcll(mk); }
    if (!exact) {
#pragma unroll
        for (int j = 0; j < NR; ++j) { const bool f = (k[j] == T); const unsigned long long mk = __ballot(f);
            const int p = base + (int)__builtin_amdgcn_mbcnt_hi((unsigned)(mk >> 32), __builtin_amdgcn_mbcnt_lo((unsigned)mk, 0u));
            if (f && p < 256) sel[p] = (unsigned short)(64 * j + lane);
            base += __popcll(mk); }
    }
}
__device__ __forceinline__ int conv_m_of(int q, int j) { return q < 3 ? 2 * q + j : q < 11 ? 6 + 8 * j + (q - 3) : q < 19 ? 22 + 8 * j + (q - 11) : 38 + 8 * j + (q - 19); }
template <bool CONV>
__device__ __forceinline__ void topk_phase_t(const Ctx& C, KArgP P, int j) {
    const float* SC = (const float*)(C.R + R_SC);
    LAS unsigned char* tile0 = C.lds + C.wave * (2 * CONV_TILE); LAS unsigned char* tile1 = tile0 + CONV_TILE;
    constexpr int pcount = CONV ? 27 * (CONV_IB / 2) : 0;
    int cit = C.gw; const int cs = C.ngw; bool pend = false;
    auto pair_desc = [&](int p, ConvD& d0, ConvD& d1) -> bool { const int m = conv_m_of(p / (CONV_IB / 2), j), rp = p % (CONV_IB / 2); const bool isdn = (m >= 4 && m < 6) || m >= 38;
        const int nblk = isdn ? D / 32 : FF / 32, kb2 = rp / nblk, nb = rp - kb2 * nblk, r0 = 2 * kb2 * nblk + nb;
        const bool g = conv_desc(C, P, m, r0, d0); conv_desc(C, P, m, r0 + nblk, d1); return g; };
    auto issue = [&](int lane) { if (CONV && cit < pcount) { ConvD d0, d1; const bool g = pair_desc(cit, d0, d1); conv_dma_issue(d0, g, lane, tile0); conv_dma_issue(d1, g, lane, tile1); pend = true; } };
    auto finish = [&](int lane) { if (CONV && pend) { ConvD d0, d1; pair_desc(cit, d0, d1);
                                      asm volatile("s_waitcnt vmcnt(0)" ::: "memory"); conv_dma_finish(d0, tile0, lane); conv_dma_finish(d1, tile1, lane); cit += cs; pend = false; } };
    for (int rr = C.gw; rr < NT; rr += C.ngw) { const int row = NT - 1 - rr;
        int lane = C.lane; asm volatile("" : "+v"(lane));
        const int pos = row % SL, n = pos + 1;
        unsigned short* sel = C.sel + (size_t)row * 256;
        if (n <= 256) {
            u32x2 o; o.x = (unsigned)(4 * lane) | ((unsigned)(4 * lane + 1) << 16); o.y = (unsigned)(4 * lane + 2) | ((unsigned)(4 * lane + 3) << 16);
            *(u32x2*)(sel + 4 * lane) = o;
            continue;
        }
        const float* sr = SC + (size_t)row * SCLD;
        const int nr8 = (n + 511) >> 9;
#define TOPK_CASE(NR) { unsigned k[NR]; topk_keys<NR>(sr, k, n, lane); _Pragma("unroll") for (int q_ = 0; q_ < NR; ++q_) asm volatile("" : "+v"(k[q_]) :: "memory");   \
            issue(lane); topk_select<NR>(k, sel, lane, [&]() { if (NR >= TOPK_MID_NR) { finish(lane); issue(lane); } }); }
        switch (nr8) {
            case 1: TOPK_CASE(8) break;   case 2: TOPK_CASE(16) break; case 3: TOPK_CASE(24) break;
            case 4: TOPK_CASE(32) break;  case 5: TOPK_CASE(40) break; case 6: TOPK_CASE(48) break;
            case 7: TOPK_CASE(56) break;  case 8: TOPK_CASE(64) break; default: TOPK_CASE(65) break;
        }
#undef TOPK_CASE
        finish(lane);
    }
    while (CONV && cit < pcount) { int lane = C.lane; asm volatile("" : "+v"(lane)); issue(lane); finish(lane); }
}
__device__ __forceinline__ void topk_phase(const Ctx& C, KArgP P, int j) {
    if (CONV_IN_PROLOGUE) topk_phase_t<false>(C, P, j); else topk_phase_t<true>(C, P, j);
}

constexpr int ATT_VROW = 544, ATT_WAVE_LDS = 32 * ATT_VROW + 512;
__device__ __forceinline__ s16x4 tr16(const LAS unsigned char* p) { return __builtin_bit_cast(s16x4, __builtin_amdgcn_ds_read_tr16_b64_v4i16((LAS s16x4*)p)); }
constexpr int AT_PITCH = 1088, AT_BUF = 8 * AT_PITCH;
template <bool OUT8>
__device__ __forceinline__ void attn2b_phase(const Ctx& C, bf16* OUT) {
    const bf16* PROJ = (const bf16*)(C.R + R_PROJ);
    const int lane = C.lane, n15 = lane & 15, kq = lane >> 4, g = n15 >> 2, oo = lane & 1, chh = lane >> 1;
    LAS unsigned char* wb = C.lds + C.wave * ATT_WAVE_LDS;
    LAS unsigned short* selE = (LAS unsigned short*)(wb + 2 * AT_BUF); LAS unsigned short* selO = selE + 128;
    static_assert(2 * AT_BUF + 512 <= ATT_WAVE_LDS, "attention LDS");
    int b0, nbat, wv, nwv;
    if ((C.G & 7) == 0) { b0 = (C.bid & 7) >> 1; nbat = 1; wv = ((C.bid >> 3) * 2 + (C.bid & 1)) * NWAVES + C.wave; nwv = (C.G >> 2) * NWAVES; }
    else { b0 = 0; nbat = BATCH; wv = C.gw; nwv = C.ngw; }
    for (int bi = 0; bi < nbat; ++bi) { const int b = b0 + bi;
    for (int pos = wv; pos < SL; pos += nwv) {
        const int row = b * SL + pos, nk = pos + 1 < 256 ? pos + 1 : 256, ng = (nk + 15) >> 4, ntile = 2 * ng;
        const bf16* kvb = PROJ + (size_t)b * SL * DSA_NP;
        { const u32x2 sv = *(const u32x2*)(C.sel + (size_t)row * 256 + 4 * lane);
          const unsigned s0 = (4 * lane < nk) ? (sv.x & 0xffffu) : 0u, s1 = (4 * lane + 1 < nk) ? (sv.x >> 16) : 0u, s2 = (4 * lane + 2 < nk) ? (sv.y & 0xffffu) : 0u, s3 = (4 * lane + 3 < nk) ? (sv.y >> 16) : 0u;
          asm volatile("" ::: "memory");
          selE[2 * lane] = (unsigned short)s0; selE[2 * lane + 1] = (unsigned short)s2; selO[2 * lane] = (unsigned short)s1; selO[2 * lane + 1] = (unsigned short)s3; }
        bf16x8 qf[8];
        { const bf16* qp = PROJ + (size_t)row * DSA_NP + DQ0 + n15 * 64 + 8 * kq; const bf16x8 q0 = *(const bf16x8*)qp, q1 = *(const bf16x8*)(qp + 32);
          const bf16x8 z = (bf16x8){0, 0, 0, 0, 0, 0, 0, 0};
#pragma unroll
          for (int ks = 0; ks < 8; ++ks) qf[ks] = ((ks >> 1) == g) ? ((ks & 1) ? q1 : q0) : z; }
        asm volatile("s_waitcnt vmcnt(0) lgkmcnt(0)" ::: "memory");
#pragma unroll
        for (int ks = 0; ks < 8; ++ks) asm volatile("" : "+v"(qf[ks]));
#define AT_ISSUE(i_, bo_) do { const int ii_ = (i_); const int gi_ = ii_ < ng ? ii_ : ii_ - ng; const int c0_ = ii_ < ng ? DK0 : DV0; \
            const u32x4 k8_ = *(const LAS u32x4*)((oo ? selO : selE) + 8 * gi_); const bf16* gb_ = kvb + c0_ + chh * 8; LAS unsigned char* db_ = wb + (bo_); \
            __builtin_amdgcn_global_load_lds((const unsigned*)(gb_ + (size_t)(k8_.x & 0xffffu) * DSA_NP), (LAS unsigned*)(db_ + 0 * AT_PITCH), 16, 0, 0); \
            __builtin_amdgcn_global_load_lds((const unsigned*)(gb_ + (size_t)(k8_.x >> 16) * DSA_NP), (LAS unsigned*)(db_ + 1 * AT_PITCH), 16, 0, 0); \
            __builtin_amdgcn_global_load_lds((const unsigned*)(gb_ + (size_t)(k8_.y & 0xffffu) * DSA_NP), (LAS unsigned*)(db_ + 2 * AT_PITCH), 16, 0, 0); \
            __builtin_amdgcn_global_load_lds((const unsigned*)(gb_ + (size_t)(k8_.y >> 16) * DSA_NP), (LAS unsigned*)(db_ + 3 * AT_PITCH), 16, 0, 0); \
            __builtin_amdgcn_global_load_lds((const unsigned*)(gb_ + (size_t)(k8_.z & 0xffffu) * DSA_NP), (LAS unsigned*)(db_ + 4 * AT_PITCH), 16, 0, 0); \
            __builtin_amdgcn_global_load_lds((const unsigned*)(gb_ + (size_t)(k8_.z >> 16) * DSA_NP), (LAS unsigned*)(db_ + 5 * AT_PITCH), 16, 0, 0); \
            __builtin_amdgcn_global_load_lds((const unsigned*)(gb_ + (size_t)(k8_.w & 0xffffu) * DSA_NP), (LAS unsigned*)(db_ + 6 * AT_PITCH), 16, 0, 0); \
            __builtin_amdgcn_global_load_lds((const unsigned*)(gb_ + (size_t)(k8_.w >> 16) * DSA_NP), (LAS unsigned*)(db_ + 7 * AT_PITCH), 16, 0, 0); } while (0)
#define AT_WAIT(i_) do { if ((i_) + 1 < ntile) asm volatile("s_waitcnt vmcnt(8)" ::: "memory"); else asm volatile("s_waitcnt vmcnt(0)" ::: "memory"); } while (0)
        AT_ISSUE(0, 0); AT_ISSUE(1, AT_BUF);
        f32x4 lg[16];
        const LAS unsigned char* kfp = wb + (n15 >> 1) * AT_PITCH + 32 * kq + 16 * (n15 & 1);
#pragma unroll
        for (int G = 0; G < 16; ++G) {
            f32x4 acc = (f32x4){0.f, 0.f, 0.f, 0.f};
            if (G < ng) {
                AT_WAIT(G);
                bf16x8 af[8];
#pragma unroll
                for (int ks = 0; ks < 8; ++ks) af[ks] = *(const LAS bf16x8*)(kfp + (G & 1) * AT_BUF + 128 * ks);
                asm volatile("s_waitcnt lgkmcnt(0)" ::: "memory");
                if (G + 2 < ntile) AT_ISSUE(G + 2, (G & 1) * AT_BUF);
#pragma unroll
                for (int ks = 0; ks < 8; ++ks) acc = MFMA16(af[ks], qf[ks], acc);
            }
#pragma unroll
            for (int i = 0; i < 4; ++i) lg[G][i] = (16 * G + 4 * kq + i < nk) ? acc[i] : -INFINITY;
        }
        float mx = -INFINITY;
#pragma unroll
        for (int G = 0; G < 16; ++G) mx = fmaxf(fmaxf(fmaxf(lg[G][0], lg[G][1]), fmaxf(lg[G][2], lg[G][3])), mx);
        mx = fmaxf(mx, __shfl_xor(mx, 16)); mx = fmaxf(mx, __shfl_xor(mx, 32));
        float sum = 0.f;
#pragma unroll
        for (int G = 0; G < 16; ++G)
#pragma unroll
            for (int i = 0; i < 4; ++i) { const float p = __expf(lg[G][i] - mx); lg[G][i] = p; sum += p; }
        sum += __shfl_xor(sum, 16); sum += __shfl_xor(sum, 32);
        f32x4 O[16];
#pragma unroll
        for (int nb = 0; nb < 16; ++nb) O[nb] = (f32x4){0.f, 0.f, 0.f, 0.f};
        const int vr = 4 * kq + (n15 >> 2);
        const LAS unsigned char* vfp = wb + (vr >> 1) * AT_PITCH + 16 * (vr & 1) + 32 * ((lane & 3) >> 1) + 8 * (lane & 1);
#pragma unroll
        for (int G = 0; G < 16; ++G) {
            if (G < ng) {
                const int ti = ng + G, bo = (ti & 1) * AT_BUF;
                AT_WAIT(ti);
                u32x2 pw; pw.x = pk2(lg[G][0], lg[G][1]); pw.y = pk2(lg[G][2], lg[G][3]);
                const s16x4 pa = __builtin_bit_cast(s16x4, pw);
                s16x4 vf[16];
#pragma unroll
                for (int nb = 0; nb < 16; ++nb) vf[nb] = tr16(vfp + bo + 64 * nb);
                asm volatile("s_waitcnt lgkmcnt(0)" ::: "memory");
                if (ti + 2 < ntile) AT_ISSUE(ti + 2, bo);
#pragma unroll
                for (int nb = 0; nb < 16; ++nb) O[nb] = __builtin_amdgcn_mfma_f32_16x16x16bf16_1k(pa, vf[nb], O[nb], 0, 0, 0);
            }
        }
#undef AT_ISSUE
#undef AT_WAIT
        bf16* orow = OUT + (size_t)row * D; unsigned char* orow8 = (unsigned char*)OUT + (size_t)row * D;
        float inv[4];
#pragma unroll
        for (int i = 0; i < 4; ++i) inv[i] = 1.0f / __shfl(sum, 4 * kq + i);
#pragma unroll
        for (int x = 0; x < 4; ++x) {
            const f32x4 o = (kq == 0) ? O[x] : (kq == 1) ? O[4 + x] : (kq == 2) ? O[8 + x] : O[12 + x];
#pragma unroll
            for (int i = 0; i < 4; ++i) { if (OUT8) orow8[(4 * kq + i) * 64 + 16 * x + n15] = (unsigned char)(pg8::cvt4_fp8(o[i] * inv[i] * SA_ATT, 0.f, 0.f, 0.f) & 0xffu);
                                          else orow[(4 * kq + i) * 64 + 16 * x + n15] = (bf16)(pk2(o[i] * inv[i], 0.f) & 0xffffu); }
        }
    } }
}
__device__ __forceinline__ int ml_start(int c) { return c == 0 ? 0 : 16 + 256 * (c - 1); }
__device__ __forceinline__ int ml_len(int c) { return c == 0 ? 16 : 256; }
template <bool ISMAX> __device__ __forceinline__ float wave_scan_incl(float v, int lane) {
#pragma unroll
    for (int d = 1; d < 64; d <<= 1) { const float t = __shfl_up(v, d); if (lane >= d) v = ISMAX ? fmaxf(v, t) : v + t; }
    return v; }
__device__ __forceinline__ void ml_scan_phase(const Ctx& C) {
    if (C.gw >= 16) return;
    const int bh = C.gw, lane = C.lane, p0 = 65 * lane;
    float* F = C.mlf + bh * SL; float* Cc = C.mlc + bh * SL; float* Pp = C.mlp + bh * SL;
    float li[65], lf[65];
#pragma unroll
    for (int i = 0; i < 65; ++i) { const bool ok = p0 + i < SL; li[i] = ok ? C.mli[(bh * 65 + i) * 64 + lane] : -INFINITY; lf[i] = ok ? C.mlg[(bh * 65 + i) * 64 + lane] : 0.f; }
    float s = 0.f;
#pragma unroll
    for (int i = 0; i < 65; ++i) s += lf[i];
    float run = wave_scan_incl<false>(s, lane) - s, mx = -INFINITY;
#pragma unroll
    for (int i = 0; i < 65; ++i) { run += lf[i]; lf[i] = run; li[i] = li[i] - run; mx = fmaxf(mx, li[i]); }
    const float inc = wave_scan_incl<true>(mx, lane); float pm = __shfl_up(inc, 1); if (lane == 0) pm = -INFINITY;
#pragma unroll
    for (int i = 0; i < 65; ++i) { pm = fmaxf(pm, li[i]); if (p0 + i < SL) { F[p0 + i] = lf[i]; Cc[p0 + i] = li[i]; Pp[p0 + i] = pm; } }
}
constexpr int TP = 40;
__device__ __forceinline__ void stage_T(const Ctx& C, LAS bf16* T, const bf16* src, int ld, int ncol, int row0tok, int s0, int nvalid, const float* cvals, float pend, float kscale) {
    const int nchunk = 32 * (ncol / 8);
    for (int id = C.tid; id < nchunk; id += NTHREADS) {
        const int s = id & 31, dc = id >> 5; const int sl_ = s0 + s; const bool ok = sl_ < nvalid; const int sc = ok ? sl_ : nvalid - 1;
        float x[8]; unpack8(*(const u32x4*)(src + (size_t)(row0tok + sc) * ld + 8 * dc), x);
        float w = ok ? 1.0f : 0.0f; if (cvals) w = ok ? __expf(cvals[sc] - pend) * kscale : 0.0f;
#pragma unroll
        for (int e = 0; e < 8; ++e) T[(8 * dc + e) * TP + s] = (bf16)(pk2(x[e] * w, 0.f) & 0xffffu);
    }
}
__device__ __forceinline__ void ml_dc_phase(const Ctx& C) {
    const bf16* PROJ = (const bf16*)(C.R + R_PROJ); float* DC = (float*)(C.R + R_DC);
    LAS bf16* KT = (LAS bf16*)C.lds; LAS bf16* VT = KT + 128 * TP;
    const int lane = C.lane, m31 = lane & 31, hi = lane >> 5, w = C.wave;
    for (int task = C.bid; task < 256; task += C.G) {
        const int bh = task >> 4, c = task & 15, b = bh >> 2, h = bh & 3, start = ml_start(c), n = ml_len(c), tok0 = b * SL + start;
        const float pend = C.mlp[bh * SL + start + n - 1];
        f32x16 acc[4];
#pragma unroll
        for (int nb = 0; nb < 4; ++nb)
#pragma unroll
            for (int r = 0; r < 16; ++r) acc[nb][r] = 0.f;
        float dn = 0.f;
        for (int s0 = 0; s0 < n; s0 += 32) {
            stage_T(C, KT, PROJ + MK0 + h * 128, ML_NP, 128, tok0, s0, n, C.mlc + bh * SL + start, pend, 0.08838834764831845f);
            stage_T(C, VT, PROJ + MV0 + h * 256, ML_NP, 256, tok0, s0, n, nullptr, 0.f, 1.f);
            __syncthreads();
#pragma unroll
            for (int ks = 0; ks < 2; ++ks) { const bf16x8 a = *(const LAS bf16x8*)(VT + (32 * w + m31) * TP + 16 * ks + 8 * hi);
#pragma unroll
                for (int nb = 0; nb < 4; ++nb) acc[nb] = MFMA32(a, *(const LAS bf16x8*)(KT + (32 * nb + m31) * TP + 16 * ks + 8 * hi), acc[nb]); }
            if (C.tid < 128) {
#pragma unroll
                for (int q = 0; q < 4; ++q) { float x[8]; unpack8(*(const LAS u32x4*)(KT + C.tid * TP + 8 * q), x);
#pragma unroll
                    for (int e = 0; e < 8; ++e) dn += x[e]; } }
            __syncthreads();
        }
        float* dc = DC + (size_t)(bh * 16 + c) * 256 * 128;
#pragma unroll
        for (int nb = 0; nb < 4; ++nb)
#pragma unroll
            for (int r = 0; r < 16; ++r) dc[(size_t)(32 * w + crow(r, hi)) * 128 + 32 * nb + m31] = acc[nb][r];
        if (C.tid < 128) C.dn[(bh * 16 + c) * 128 + C.tid] = dn;
    }
}
__device__ __forceinline__ void ml_state_phase(const Ctx& C) {
    const float* DC = (const float*)(C.R + R_DC); bf16* CH = (bf16*)(C.R + R_CH);
    const int gt = C.bid * NTHREADS + C.tid, ngt = C.G * NTHREADS;
    for (int i = gt; i < 16 * 8192 + 16 * 128; i += ngt) {
        const bool isn = i >= 16 * 8192; const int ii = isn ? i - 16 * 8192 : i; const int bh = isn ? ii >> 7 : ii >> 13, off = isn ? (ii & 127) : 4 * (ii & 8191);
        f32x4 st = (f32x4){0.f, 0.f, 0.f, 0.f}; float pprev = 0.f;
        for (int c = 0; c < 16; ++c) {
            const float pend = C.mlp[bh * SL + ml_start(c) + ml_len(c) - 1];
            const float decay = (c == 0) ? 0.f : __expf(pprev - pend); pprev = pend;
            if (isn) { st[0] = decay * st[0] + C.dn[(bh * 16 + c) * 128 + off]; C.nh[(bh * 16 + c) * 128 + off] = st[0]; }
            else { st = decay * st + *(const f32x4*)(DC + (size_t)(bh * 16 + c) * 32768 + off);
                   u32x2 o; o.x = pk2(st[0], st[1]); o.y = pk2(st[2], st[3]); *(u32x2*)(CH + (size_t)(bh * 16 + c) * 32768 + off) = o; }
        }
    }
}
constexpr int MLP_ = 136;
__device__ __forceinline__ void ml_out_phase(const Ctx& C, const float* gout) {
    const bf16* PROJ = (const bf16*)(C.R + R_PROJ); const bf16* CH = (const bf16*)(C.R + R_CH);
    LAS bf16* VT = (LAS bf16*)C.lds; LAS bf16* KL = VT + 256 * TP; LAS float* CV = (LAS float*)(KL + 32 * MLP_); LAS bf16* CHL = (LAS bf16*)(CV + 32);
    const int w = C.wave;
    for (int task = C.bid; task < 272; task += C.G) {
        int lane = C.lane, tid = C.tid; asm volatile("" : "+v"(lane), "+v"(tid));
        const int m31 = lane & 31, hi = lane >> 5;
        const int bh = task < 256 ? task >> 4 : task - 256, c = task < 256 ? 1 + (task & 15) : 0;
        const int b = bh >> 2, h = bh & 3, start = ml_start(c), n = ml_len(c), tok0 = b * SL + start;
        const int tl = 32 * w + m31, tlc = tl < n ? tl : n - 1; const bool wact = 32 * w < n;
        const float Pt = C.mlp[bh * SL + start + tlc];
        const bf16* qp = PROJ + (size_t)(tok0 + tlc) * ML_NP + MQ0 + h * 128 + 8 * hi;
        const int nst = (n + 31) >> 5;
        const int vs = tid & 31, vd0 = tid >> 5, ks_ = tid >> 4, kc_ = tid & 15;
        u32x4 rv0, rv1, rk; float rc = 0.f;
#define ML_LOAD(st_) do { const int s0_ = 32 * (st_); const int a_ = s0_ + vs < n ? s0_ + vs : n - 1, k_ = s0_ + ks_ < n ? s0_ + ks_ : n - 1; \
            const bf16* vp_ = PROJ + (size_t)(tok0 + a_) * ML_NP + MV0 + h * 256 + 8 * vd0; rv0 = *(const u32x4*)vp_; rv1 = *(const u32x4*)(vp_ + 128); \
            rk = *(const u32x4*)(PROJ + (size_t)(tok0 + k_) * ML_NP + MK0 + h * 128 + 8 * kc_); \
            if (tid < 32) rc = C.mlc[bh * SL + start + (s0_ + tid < n ? s0_ + tid : n - 1)]; } while (0)
#define ML_WRITE(st_) do { const int s0_ = 32 * (st_); const bool ok_ = s0_ + vs < n; float x_[8]; unpack8(rv0, x_); \
            _Pragma("unroll") for (int e = 0; e < 8; ++e) VT[(8 * vd0 + e) * TP + vs] = ok_ ? (bf16)(pk2(x_[e], 0.f) & 0xffffu) : (bf16)0; \
            unpack8(rv1, x_); _Pragma("unroll") for (int e = 0; e < 8; ++e) VT[(8 * (vd0 + 16) + e) * TP + vs] = ok_ ? (bf16)(pk2(x_[e], 0.f) & 0xffffu) : (bf16)0; \
            *(LAS u32x4*)(KL + ks_ * MLP_ + 8 * kc_) = rk; if (tid < 32) CV[tid] = rc; } while (0)
        float den = 0.f;
        f32x16 acc[8];
#pragma unroll
        for (int mb = 0; mb < 8; ++mb)
#pragma unroll
            for (int r = 0; r < 16; ++r) acc[mb][r] = 0.f;
        if (c >= 1 && wact) {
            const bf16* ch = CH + (size_t)(bh * 16 + c - 1) * 32768;
            bf16x8 qf[8];
#pragma unroll
            for (int ks = 0; ks < 8; ++ks) qf[ks] = *(const bf16x8*)(qp + 16 * ks);
#pragma unroll
            for (int mb = 0; mb < 8; ++mb)
#pragma unroll
                for (int ks = 0; ks < 8; ++ks) acc[mb] = MFMA32(*(const bf16x8*)(ch + (size_t)(32 * mb + m31) * 128 + 16 * ks + 8 * hi), qf[ks], acc[mb]);
            const float sc = __expf(C.mlp[bh * SL + start - 1] - Pt);
#pragma unroll
            for (int mb = 0; mb < 8; ++mb)
#pragma unroll
                for (int r = 0; r < 16; ++r) acc[mb][r] *= sc;
            const float* nh = C.nh + (bh * 16 + c - 1) * 128 + 8 * hi; float d = 0.f;
#pragma unroll
            for (int ks = 0; ks < 8; ++ks) { const f32x4 n0 = *(const f32x4*)(nh + 16 * ks), n1 = *(const f32x4*)(nh + 16 * ks + 4); float q[8]; unpack8(__builtin_bit_cast(u32x4, qf[ks]), q);
                d += (n0[0] * q[0] + n0[1] * q[1]) + (n0[2] * q[2] + n0[3] * q[3]) + (n1[0] * q[4] + n1[1] * q[5]) + (n1[2] * q[6] + n1[3] * q[7]); }
            d += __shfl_xor(d, 32); den = sc * d;
        }
        float den_in = 0.f;
        ML_LOAD(0);
        for (int st = 0; st < nst; ++st) {
            ML_WRITE(st);
            __syncthreads();
            const bool act = st <= w && wact;
            if (!act && st + 1 < nst) ML_LOAD(st + 1);
            if (act) {
                f32x16 X;
#pragma unroll
                for (int r = 0; r < 16; ++r) X[r] = 0.f;
                bf16x8 qf[8];
#pragma unroll
                for (int ks = 0; ks < 8; ++ks) qf[ks] = *(const bf16x8*)(qp + 16 * ks);
#pragma unroll
                for (int ks = 0; ks < 8; ++ks) X = MFMA32(*(const LAS bf16x8*)(KL + m31 * MLP_ + 16 * ks + 8 * hi), qf[ks], X);
                asm volatile("" ::: "memory");
                if (st + 1 < nst) ML_LOAD(st + 1);
                float Wt[16];
#pragma unroll
                for (int q4 = 0; q4 < 4; ++q4) { const int sb = 32 * st + 8 * q4 + 4 * hi;
                    const f32x4 cv = *(const LAS f32x4*)(CV + 8 * q4 + 4 * hi);
#pragma unroll
                    for (int e = 0; e < 4; ++e) { const int sl_ = sb + e; const bool ok = sl_ < n && sl_ <= tl;
                        const float wgt = ok ? X[4 * q4 + e] * 0.08838834764831845f * __expf(cv[e] - Pt) : 0.f; Wt[4 * q4 + e] = wgt; den_in += wgt; } }
#pragma unroll
                for (int s2 = 0; s2 < 2; ++s2) {
                    u32x4 pw; pw.x = pk2(Wt[8 * s2], Wt[8 * s2 + 1]); pw.y = pk2(Wt[8 * s2 + 2], Wt[8 * s2 + 3]); pw.z = pk2(Wt[8 * s2 + 4], Wt[8 * s2 + 5]); pw.w = pk2(Wt[8 * s2 + 6], Wt[8 * s2 + 7]);
                    const bf16x8 wf = __builtin_bit_cast(bf16x8, pw);
#pragma unroll
                    for (int mb = 0; mb < 8; ++mb) { const LAS bf16* vp = VT + (32 * mb + m31) * TP + 16 * s2 + 4 * hi;
                        const u32x2 lo = *(const LAS u32x2*)vp, hi2 = *(const LAS u32x2*)(vp + 8);
                        const u32x4 av = (u32x4){lo.x, lo.y, hi2.x, hi2.y};
                        acc[mb] = MFMA32(__builtin_bit_cast(bf16x8, av), wf, acc[mb]); }
                }
            }
            __syncthreads();
        }
#undef ML_LOAD
#undef ML_WRITE
        if (wact) {
            den += den_in + __shfl_xor(den_in, 32);
            const float Ft = C.mlf[bh * SL + start + tlc];
            const float dnm = fmaxf(fabsf(den), __expf(-(Ft + Pt))), invd = 1.0f / dnm;
            float ss = 0.f;
#pragma unroll
            for (int mb = 0; mb < 8; ++mb)
#pragma unroll
                for (int r = 0; r < 16; ++r) { const float hv = acc[mb][r] * invd; acc[mb][r] = hv; ss += hv * hv; }
            ss += __shfl_xor(ss, 32);
            const float rstd = 1.0f / sqrtf(ss * (1.0f / 256.0f) + RMS_EPS);
            if (tl < n) {
                const bf16* orow = PROJ + (size_t)(tok0 + tl) * ML_NP + MO0 + h * 256; bf16* yrow = C.XN + (size_t)(tok0 + tl) * D + h * 256; const float* gr = gout + h * 256;
#pragma unroll
                for (int mb = 0; mb < 8; ++mb)
#pragma unroll
                    for (int q4 = 0; q4 < 4; ++q4) { const int dv0 = 32 * mb + 8 * q4 + 4 * hi; const f32x4 gg = *(const f32x4*)(gr + dv0); const u32x2 ow = *(const u32x2*)(orow + dv0);
                        const float o0 = bflo(ow.x), o1 = bfhi(ow.x), o2 = bflo(ow.y), o3 = bfhi(ow.y);
                        const float y0 = acc[mb][4 * q4] * rstd * gg[0] / (1.0f + __expf(-o0)), y1 = acc[mb][4 * q4 + 1] * rstd * gg[1] / (1.0f + __expf(-o1));
                        const float y2 = acc[mb][4 * q4 + 2] * rstd * gg[2] / (1.0f + __expf(-o2)), y3 = acc[mb][4 * q4 + 3] * rstd * gg[3] / (1.0f + __expf(-o3));
                        u32x2 o; o.x = pk2(y0, y1); o.y = pk2(y2, y3); *(u32x2*)(yrow + dv0) = o; }
            }
        }
    }
}

__device__ __forceinline__ void moe_bases(const Ctx& C, int layer, int (&pb)[9]) {
    pb[0] = 0;
#pragma unroll
    for (int e = 0; e < 8; ++e) { const int ne = (int)__hip_atomic_load(C.ctl + CW_CNT + (layer * 8 + e) * 64, __ATOMIC_RELAXED, __HIP_MEMORY_SCOPE_AGENT); pb[e + 1] = pb[e] + ((ne + 255) >> 8); }
}
__device__ __forceinline__ void moe_gather_phase(const Ctx& C, int layer) {
    bf16* AS = (bf16*)(C.R + R_AS);
    LAS int* lb = (LAS int*)C.lds;
    if (C.tid == 0) { int pb[9]; moe_bases(C, layer, pb);
#pragma unroll
        for (int e = 0; e < 8; ++e) { lb[e] = pb[e] * 256; lb[8 + e] = (int)__hip_atomic_load(C.ctl + CW_CNT + (layer * 8 + e) * 64, __ATOMIC_RELAXED, __HIP_MEMORY_SCOPE_AGENT); } }
    __syncthreads();
    for (int row = C.gw; row < NT; row += C.ngw) {
        const int ee = C.route_e[row]; const float g1 = C.route_g1[row];
        u32x4 x0, x1 = (u32x4){0u, 0u, 0u, 0u};
        if (FP8_MOE) x0 = *(const u32x4*)(C.xn8 + (size_t)row * D + 16 * C.lane);
        else { x0 = *(const u32x4*)(C.XN + (size_t)row * D + 8 * C.lane); x1 = *(const u32x4*)(C.XN + (size_t)row * D + 512 + 8 * C.lane); }
#pragma unroll
        for (int wh = 0; wh < 2; ++wh) { const int e = wh ? (ee >> 8) : (ee & 0xff), r = wh ? C.route_r2[row] : C.route_r1[row]; const int slot = lb[e] + r;
            if (FP8_MOE) *(u32x4*)((unsigned char*)AS + (size_t)slot * D + 16 * C.lane) = x0;
            else { *(u32x4*)(AS + (size_t)slot * D + 8 * C.lane) = x0; *(u32x4*)(AS + (size_t)slot * D + 512 + 8 * C.lane) = x1; }
            if (C.lane == 0) { C.slot_tok[slot] = row | (wh << 16); C.slot_g[slot] = wh ? 1.0f - g1 : g1; } }
    }
    u32x4 zero4 = (u32x4){0u, 0u, 0u, 0u}; asm volatile("" : "+v"(zero4));
    for (int e = 0; e < 8; ++e) { const int ne = lb[8 + e], first = lb[e] + ne, last = lb[e] + ((ne + 255) & ~255);
        for (int slot = first + C.gw; slot < last; slot += C.ngw) {
            if (FP8_MOE) *(u32x4*)((unsigned char*)AS + (size_t)slot * D + 16 * C.lane) = zero4;
            else { *(u32x4*)(AS + (size_t)slot * D + 8 * C.lane) = zero4; *(u32x4*)(AS + (size_t)slot * D + 512 + 8 * C.lane) = zero4; }
            if (C.lane == 0) { C.slot_tok[slot] = -1; C.slot_g[slot] = 0.f; } } }
    __syncthreads();
}
__device__ __forceinline__ void final_phase(const Ctx& C, float* out) {
    const bf16* Y0 = (const bf16*)(C.R + R_Y0); const bf16* Y1 = (const bf16*)(C.R + R_Y1);
    const int gt = C.bid * NTHREADS + C.tid, ngt = C.G * NTHREADS;
    for (int i = gt; i < BATCH * SEQ * (D / 4); i += ngt) { const int orow = i >> 8, c4 = i & 255, b = orow >> 12, s = orow & 4095; const size_t row = (size_t)b * SL + NMETA + s;
#if H_BF16
        f32x4 v; { const u32x2 hq = *(const u32x2*)(C.H + row * D + 4 * c4); v[0] = bflo(hq.x); v[1] = bfhi(hq.x); v[2] = bflo(hq.y); v[3] = bfhi(hq.y); }
#else
        f32x4 v = *(const f32x4*)(C.H + row * D + 4 * c4);
#endif
        const u32x2 a = *(const u32x2*)(Y0 + row * D + 4 * c4), bb = *(const u32x2*)(Y1 + row * D + 4 * c4);
        v[0] += bflo(a.x) + bflo(bb.x); v[1] += bfhi(a.x) + bfhi(bb.x); v[2] += bflo(a.y) + bflo(bb.y); v[3] += bfhi(a.y) + bfhi(bb.y);
        *(f32x4*)(out + (size_t)orow * D + 4 * c4) = v; }
}
template <int MODE, int KSW  , bool FP8 = false>
__device__ __forceinline__ void skinny_phase(const Ctx& C, const bf16* A16, const bf16* Bt, int N, int K, bf16* O, int ldo, HT* H, float sa = 1.0f, float so = 1.0f) {
    const int lane = C.lane, n15 = lane & 15, kq = lane >> 4, w = C.wave;
    LAS f32x4* red = (LAS f32x4*)C.lds;
    const int nblk = (MODE == 2) ? N / 32 : N / 16;
    for (int cb = C.bid; cb < nblk; cb += C.G) {
        int rowB0 = 16 * cb, rowB1 = 0;
        if (MODE == 2) { const int c0 = 16 * cb; rowB0 = 256 * (c0 >> 7) + (c0 & 127); rowB1 = rowB0 + 128; }
        f32x4 acc0 = (f32x4){0.f, 0.f, 0.f, 0.f}, acc1 = (f32x4){0.f, 0.f, 0.f, 0.f};
        const bf16* ap = A16 + (size_t)n15 * K + 8 * kq; const bf16* bp0 = Bt + (size_t)(rowB0 + n15) * K + 8 * kq; const bf16* bp1 = Bt + (size_t)(rowB1 + n15) * K + 8 * kq;
        if constexpr (FP8) {
            const unsigned char* ap8 = (const unsigned char*)A16 + (size_t)n15 * K + 8 * kq; const unsigned char* bq0 = (const unsigned char*)Bt + (size_t)(rowB0 + n15) * K + 8 * kq; const unsigned char* bq1 = (const unsigned char*)Bt + (size_t)(rowB1 + n15) * K + 8 * kq;
            long af[KSW], b0f[KSW], b1f[MODE == 2 ? KSW : 1];
#pragma unroll
            for (int i = 0; i < KSW; ++i) { const int ks = w + NWAVES * i; af[i] = *(const long*)(ap8 + 32 * ks); b0f[i] = *(const long*)(bq0 + 32 * ks); if (MODE == 2) b1f[i] = *(const long*)(bq1 + 32 * ks); }
#pragma unroll
            for (int i = 0; i < KSW; ++i) { acc0 = __builtin_amdgcn_mfma_f32_16x16x32_fp8_fp8(af[i], b0f[i], acc0, 0, 0, 0); if (MODE == 2) acc1 = __builtin_amdgcn_mfma_f32_16x16x32_fp8_fp8(af[i], b1f[i], acc1, 0, 0, 0); }
        } else {
            bf16x8 af[KSW], b0f[KSW], b1f[MODE == 2 ? KSW : 1];
#pragma unroll
            for (int i = 0; i < KSW; ++i) { const int ks = w + NWAVES * i; af[i] = *(const bf16x8*)(ap + 32 * ks); b0f[i] = *(const bf16x8*)(bp0 + 32 * ks); if (MODE == 2) b1f[i] = *(const bf16x8*)(bp1 + 32 * ks); }
#pragma unroll
            for (int i = 0; i < KSW; ++i) { acc0 = MFMA16(af[i], b0f[i], acc0); if (MODE == 2) acc1 = MFMA16(af[i], b1f[i], acc1); }
        }
        red[w * 64 + lane] = acc0; if (MODE == 2) red[512 + w * 64 + lane] = acc1;
        __syncthreads();
        if (w == 0) {
            f32x4 s0 = red[lane], s1 = (f32x4){0.f, 0.f, 0.f, 0.f};
#pragma unroll
            for (int ww = 1; ww < NWAVES; ++ww) s0 += red[ww * 64 + lane];
            if (MODE == 2) { s1 = red[512 + lane];
#pragma unroll
                for (int ww = 1; ww < NWAVES; ++ww) s1 += red[512 + ww * 64 + lane]; }
            const int col = 16 * cb + n15;
#pragma unroll
            for (int i = 0; i < 4; ++i) { const int m = 4 * kq + i;
                if (MODE == 0) { const bf16 v = (bf16)(pk2(s0[i] * sa, 0.f) & 0xffffu);
#pragma unroll
                    for (int b = 0; b < BATCH; ++b) O[(size_t)(b * SL + m) * ldo + col] = v; }
                if (MODE == 1) {
#pragma unroll
#if H_BF16
                    for (int b = 0; b < BATCH; ++b) { HT* hp = H + (size_t)(b * SL + m) * D + col; *hp = (HT)(pk2(bf2f(*hp) + s0[i] * sa, 0.f) & 0xffffu); } }
#else
                    for (int b = 0; b < BATCH; ++b) H[(size_t)(b * SL + m) * D + col] += s0[i] * sa; }
#endif
                if (MODE == 2) { if (FP8) ((unsigned char*)O)[(size_t)m * ldo + col] = (unsigned char)(pg8::cvt4_fp8(pg8::silu_mul(s0[i] * sa, s1[i] * sa) * so, 0.f, 0.f, 0.f) & 0xffu);
                                 else O[(size_t)m * ldo + col] = (bf16)(pk2(pg8::silu_mul(s0[i], s1[i]), 0.f) & 0xffffu); }
            }
        }
        __syncthreads();
    }
}
typedef const __attribute__((address_space(4))) Params* KArg;
__device__ __forceinline__ KArg karg() { KArg p = (KArg)__builtin_amdgcn_kernarg_segment_ptr(); asm volatile("" : "+s"(p)); return p; }
__device__ __forceinline__ void ctx_init(Ctx& C, KArg P, LAS unsigned char* lds_, int wv0) {
    C.lds = lds_;
    { int t_ = wv0 * 64 + hw_lane(); asm volatile("" : "+v"(t_)); C.tid = t_; } C.lane = C.tid & 63; C.wave = __builtin_amdgcn_readfirstlane(C.tid >> 6); C.G = gridDim.x; C.bid = blockIdx.x;
    C.gw = C.bid * NWAVES + C.wave; C.ngw = C.G * NWAVES;
    unsigned char* ws = P->ws;
    C.ctl = (unsigned*)(ws + WS_CTL);
    C.rope = (float2*)(ws + WS_ROPE); C.sm8 = (float*)(ws + WS_SM8);
    C.route_e = (int*)(ws + WS_ROUTE); C.route_r1 = C.route_e + NT; C.route_r2 = C.route_r1 + NT; C.route_g1 = (float*)(C.route_r2 + NT);
    C.mlf = (float*)(ws + WS_MLG); C.mlc = C.mlf + 16 * SL; C.mlp = C.mlc + 16 * SL; C.mli = (float*)(ws + WS_MLI); C.mlg = C.mli + 16 * 65 * 64;
    C.dn = (float*)(ws + WS_NH); C.nh = C.dn + 16 * 16 * 128;
    C.slot_tok = (int*)(ws + WS_SLOT); C.slot_g = (float*)(C.slot_tok + MOE_ROWS); C.sel = (unsigned short*)(ws + WS_SEL);
    C.wdsa_in = (bf16*)(ws + WS_WDSA_IN); C.wdsa_out = (bf16*)(ws + WS_WDSA_OUT); C.wml_in = (bf16*)(ws + WS_WML_IN); C.wml_out = (bf16*)(ws + WS_WML_OUT);
    C.wffn_gu = (bf16*)(ws + WS_WFFN_GU); C.wffn_dn = (bf16*)(ws + WS_WFFN_DN); C.wmoe_gu = (bf16*)(ws + WS_WMOE_GU); C.wmoe_dn = (bf16*)(ws + WS_WMOE_DN);
    C.H = (HT*)(ws + WS_H); C.XN = (bf16*)(ws + WS_XN); C.R = ws + WS_R; C.xn8 = ws + WS_XN8;
}
constexpr int N_PHASES = 44;
#if H_BF16
typedef pg8::EpiResAddB EpiResAddH;
#else
typedef pg8::EpiResAdd EpiResAddH;
#endif
template <int SITE> __global__ void __launch_bounds__(NTHREADS, 2) fwd(Params Pval) {
    extern __shared__ __attribute__((aligned(16))) unsigned char lds_raw[];
    LAS unsigned char* const lds_base = (LAS unsigned char*)lds_raw;
    unsigned* ctl0; int lo, hi; { KArg P0 = karg(); ctl0 = (unsigned*)(P0->ws + WS_CTL); lo = P0->ph_lo; hi = P0->ph_hi; }
    volatile LAS unsigned* MISC = (volatile LAS unsigned*)(lds_base + MISC_OFF);
    int wv0 = __builtin_amdgcn_readfirstlane((int)threadIdx.x >> 6); asm volatile("" : "+s"(wv0));
    if (threadIdx.x < 64) MISC[threadIdx.x] = 0u;
    __syncthreads();
    XcdBarrier bar; bar.bar = ctl0 + CW_BAR; bar.x = 0; bar.st = MISC + 8;
    if (hi - lo > 1) bar = xcd_barrier_post(ctl0 + CW_BAR, MISC + 8, wv0);
    int ph = 0;
#ifndef SKIP_SITE
#define SKIP_SITE -5
#endif
#ifndef REPEAT_MASK
#define REPEAT_MASK 0u
#endif
#define PH_BEGIN_(id) if ((SITE < 0 || SITE == (id)) && SKIP_SITE != (id) && ph >= lo && ph < hi) { for (int rep = 0; rep < (((REPEAT_MASK >> (id)) & 1u) ? 2 : 1); ++rep) { KArg P = karg(); Ctx C; ctx_init(C, P, lds_base, wv0); HT* Hres = rep ? (HT*)(C.R + 160 * MiB) : C.H; (void)Hres; bf16* PROJ = (bf16*)(C.R + R_PROJ); bf16* ACT = (bf16*)(C.R + R_ACT); bf16* AS = (bf16*)(C.R + R_AS); (void)PROJ; (void)ACT; (void)AS;
#define PH_END } if (ph + 1 < hi) xcd_barrier(bar); } ++ph;
    using namespace pg8;

    PH_BEGIN_(0) prologue_phase(C, P); PH_END

    for (int j = 0; j < 2; ++j) {
        PH_BEGIN_(1)
            const float* gain = P->in[2] + (size_t)(2 * j) * D; const float* w8 = P->in[4] + (size_t)j * D * DSA_LDW + DIW0;
            if (j == 0) norm_phase<0, false, FP8_DSA_IN != 0>(C, gain, w8, DSA_LDW, 0); else norm_phase<0, true, FP8_DSA_IN != 0>(C, gain, w8, DSA_LDW, 0);
        PH_END
        PH_BEGIN_(2) {
#if FP8_DSA_IN
                   const bf16* w8 = (const bf16*)((const unsigned char*)C.wdsa_in + (size_t)j * DSA_NP * D);
                   Gemm g{(const bf16*)C.xn8, w8, 16384, DSA_NP, D / 2}; StaticOrder S; S.init(16384, DSA_NP, C.G, C.bid, 1); EpiStoreBf16 E{PROJ, DSA_NP, 1.0f / SW_DIN};
                   gemm_phase<EpiStoreBf16, StaticOrder, true, true, true>(C.lds, g, S, E, C.tid); skinny_phase<0, 4, true>(C, (const bf16*)C.xn8, w8, DSA_NP, D, PROJ, DSA_NP, nullptr, 1.0f / SW_DIN);
#else
                   Gemm g{C.XN, C.wdsa_in + (size_t)j * DSA_NP * D, 16384, DSA_NP, D}; StaticOrder S; S.init(16384, DSA_NP, C.G, C.bid, 1); EpiStoreBf16 E{PROJ, DSA_NP, 1.0f};
                   gemm_phase<EpiStoreBf16, StaticOrder, true, true>(C.lds, g, S, E, C.tid); skinny_phase<0, 4>(C, C.XN, C.wdsa_in + (size_t)j * DSA_NP * D, DSA_NP, D, PROJ, DSA_NP, nullptr);
#endif
                   } PH_END
        PH_BEGIN_(3) dsa_post_phase(C, P->in[5] + j * 64, P->in[6] + j * 64); PH_END
        PH_BEGIN_(4) score_phase(C); PH_END
        PH_BEGIN_(5) topk_phase(C, P, j); PH_END
        PH_BEGIN_(6) if (FP8_DSA) attn2b_phase<true>(C, (bf16*)C.xn8); else attn2b_phase<false>(C, C.XN); PH_END
        PH_BEGIN_(7) {
#if FP8_DSA
                   const bf16* w8 = (const bf16*)((const unsigned char*)C.wdsa_out + (size_t)j * D * D);
                   Gemm g{(const bf16*)C.xn8, w8, 16384, D, D / 2}; StaticOrder S; S.init(16384, D, C.G, C.bid, 1); EpiResAddH E{Hres, D, 1.0f / (SW_DOUT * SA_ATT)};
                   gemm_phase<EpiResAddH, StaticOrder, true, true, true>(C.lds, g, S, E, C.tid); skinny_phase<1, 4, true>(C, (const bf16*)C.xn8, w8, D, D, nullptr, 0, Hres, 1.0f / (SW_DOUT * SA_ATT));
#else
                   Gemm g{C.XN, C.wdsa_out + (size_t)j * D * D, 16384, D, D}; StaticOrder S; S.init(16384, D, C.G, C.bid, 1); EpiResAddH E{Hres, D, 1.0f};
                   gemm_phase<EpiResAddH, StaticOrder, true, true>(C.lds, g, S, E, C.tid); skinny_phase<1, 4>(C, C.XN, C.wdsa_out + (size_t)j * D * D, D, D, nullptr, 0, Hres);
#endif
                   } PH_END
        PH_BEGIN_(8) norm_phase<3, false, FP8_DENSE != 0>(C, P->in[3] + (size_t)(2 * j) * D, nullptr, 0, 0); PH_END
        PH_BEGIN_(9) {
#if FP8_DENSE
                   const bf16* w8 = (const bf16*)((const unsigned char*)C.wffn_gu + (size_t)j * GU * D);
                   Gemm g{(const bf16*)C.xn8, w8, 16384, GU, D / 2}; StaticOrder S; S.init(16384, GU, C.G, C.bid, 1); EpiSwiGLU8 E{(unsigned char*)ACT, FF, 1.0f / SW_GU, SA_ACT};
                   gemm_phase<EpiSwiGLU8, StaticOrder, true, true, true>(C.lds, g, S, E, C.tid); skinny_phase<2, 4, true>(C, (const bf16*)C.xn8, w8, GU, D, ACT, FF, nullptr, 1.0f / SW_GU, SA_ACT);
#else
                   Gemm g{C.XN, C.wffn_gu + (size_t)j * GU * D, 16384, GU, D}; StaticOrder S; S.init(16384, GU, C.G, C.bid, 1); EpiSwiGLU E{ACT, FF};
                   gemm_phase<EpiSwiGLU, StaticOrder, true, true>(C.lds, g, S, E, C.tid); skinny_phase<2, 4>(C, C.XN, C.wffn_gu + (size_t)j * GU * D, GU, D, ACT, FF, nullptr);
#endif
                   } PH_END
        PH_BEGIN_(10) {
#if FP8_DENSE
                   const bf16* w8 = (const bf16*)((const unsigned char*)C.wffn_dn + (size_t)j * D * FF);
                   Gemm g{ACT, w8, 16384, D, FF / 2}; StaticOrder S; S.init(16384, D, C.G, C.bid, 1); EpiResAddH E{Hres, D, 1.0f / (SW_DN * SA_ACT)};
                   gemm_phase<EpiResAddH, StaticOrder, true, true, true>(C.lds, g, S, E, C.tid); skinny_phase<1, 14, true>(C, ACT, w8, D, FF, nullptr, 0, Hres, 1.0f / (SW_DN * SA_ACT));
#else
                   Gemm g{ACT, C.wffn_dn + (size_t)j * D * FF, 16384, D, FF}; StaticOrder S; S.init(16384, D, C.G, C.bid, 1); EpiResAddH E{Hres, D, 1.0f};
                   gemm_phase<EpiResAddH, StaticOrder, true, true>(C.lds, g, S, E, C.tid); skinny_phase<1, 14>(C, ACT, C.wffn_dn + (size_t)j * D * FF, D, FF, nullptr, 0, Hres);
#endif
                   } PH_END
        PH_BEGIN_(11) norm_phase<1, false>(C, P->in[2] + (size_t)(2 * j + 1) * D, P->in[8] + (size_t)j * D * ML_LDW + MG0, ML_LDW, 0, P->in[9] + j * 4, P->in[10] + j * 4); PH_END
        PH_BEGIN_(12) { Gemm g{C.XN, C.wml_in + (size_t)j * ML_NP * D, 16384, ML_NP, D}; StaticOrder S; S.init(16384, ML_NP, C.G, C.bid, 1); EpiStoreBf16 E{PROJ, ML_NP, 1.0f};
                   gemm_phase<EpiStoreBf16, StaticOrder, true, true>(C.lds, g, S, E, C.tid); skinny_phase<0, 4>(C, C.XN, C.wml_in + (size_t)j * ML_NP * D, ML_NP, D, PROJ, ML_NP, nullptr); } PH_END
        PH_BEGIN_(13) ml_scan_phase(C); PH_END
        PH_BEGIN_(14) ml_dc_phase(C); PH_END
        PH_BEGIN_(15) ml_state_phase(C); PH_END
        PH_BEGIN_(16) ml_out_phase(C, P->in[11] + (size_t)j * D); PH_END
        PH_BEGIN_(17) { Gemm g{C.XN, C.wml_out + (size_t)j * D * D, 16384, D, D}; StaticOrder S; S.init(16384, D, C.G, C.bid, 1); EpiResAddH E{Hres, D, 1.0f};
                   gemm_phase<EpiResAddH, StaticOrder, true, true>(C.lds, g, S, E, C.tid); skinny_phase<1, 4>(C, C.XN, C.wml_out + (size_t)j * D * D, D, D, nullptr, 0, Hres); } PH_END
        PH_BEGIN_(18) norm_phase<2, false, FP8_MOE != 0>(C, P->in[3] + (size_t)(2 * j + 1) * D, P->in[16] + (size_t)j * D * 8, 8, j); PH_END
        PH_BEGIN_(19) moe_gather_phase(C, j); PH_END
        PH_BEGIN_(20) { int pb[9]; moe_bases(C, j, pb);
                   GroupedOrder S; S.nM = pb[8]; S.nN = GU / 256; S.nwg = S.nM * S.nN; S.G = C.G; S.c = C.bid; S.p1 = pb[1]; S.p2 = pb[2]; S.p3 = pb[3]; S.p4 = pb[4]; S.p5 = pb[5]; S.p6 = pb[6]; S.p7 = pb[7]; S.bmajor = MOE_GU_BMAJOR;
#if FP8_MOE
                   Gemm g{AS, (const bf16*)((const unsigned char*)C.wmoe_gu + (size_t)j * NE * GU * D), pb[8] * 256, GU, D / 2}; S.estride = (size_t)GU * D;
                   EpiSwiGLU8 E{(unsigned char*)ACT, FF, 1.0f / SW_GU, SA_ACT};
                   gemm_phase<EpiSwiGLU8, GroupedOrder, true, true, true>(C.lds, g, S, E, C.tid);
#else
                   Gemm g{AS, C.wmoe_gu + (size_t)j * NE * GU * D, pb[8] * 256, GU, D}; S.estride = (size_t)GU * D * 2;
                   EpiSwiGLU E{ACT, FF};
                   gemm_phase<EpiSwiGLU, GroupedOrder, true, true>(C.lds, g, S, E, C.tid);
#endif
                   } PH_END
        PH_BEGIN_(21) { int pb[9]; moe_bases(C, j, pb);
                   GroupedOrder S; S.nM = pb[8]; S.nN = D / 256; S.nwg = S.nM * S.nN; S.G = C.G; S.c = C.bid; S.p1 = pb[1]; S.p2 = pb[2]; S.p3 = pb[3]; S.p4 = pb[4]; S.p5 = pb[5]; S.p6 = pb[6]; S.p7 = pb[7]; S.bmajor = 0;
#if FP8_MOE
                   Gemm g{ACT, (const bf16*)((const unsigned char*)C.wmoe_dn + (size_t)j * NE * D * FF), pb[8] * 256, D, FF / 2}; S.estride = (size_t)D * FF;
                   EpiMoeDown E{(bf16*)(C.R + R_Y0), (bf16*)(C.R + R_Y1), C.slot_tok, C.slot_g, D, 1.0f / (SW_DN * SA_ACT)};
                   gemm_phase<EpiMoeDown, GroupedOrder, true, true, true>(C.lds, g, S, E, C.tid);
#else
                   Gemm g{ACT, C.wmoe_dn + (size_t)j * NE * D * FF, pb[8] * 256, D, FF}; S.estride = (size_t)D * FF * 2;
                   EpiMoeDown E{(bf16*)(C.R + R_Y0), (bf16*)(C.R + R_Y1), C.slot_tok, C.slot_g, D, 1.0f};
                   gemm_phase<EpiMoeDown, GroupedOrder, true, true>(C.lds, g, S, E, C.tid);
#endif
                   } PH_END
    }
#ifdef PROBE_BAR
    for (int q_ = 0; q_ < PROBE_BAR; ++q_) xcd_barrier(bar);
#endif
    PH_BEGIN_(22) final_phase(C, P->out); PH_END
#undef PH_BEGIN_
#undef PH_END
}

constexpr int NSITES = 24;
template <int S> struct SiteTab { static const void* get(int s) { return s == S ? (const void*)fwd<S> : SiteTab<S - 1>::get(s); } };
template <> struct SiteTab<-1> { static const void* get(int) { return nullptr; } };
#if N_LAUNCH_SPLIT
static const void* site_fn(int s) { return s >= 23 ? (const void*)fwd<22> : SiteTab<22>::get(s); }
#else
static const void* site_fn(int) { return (const void*)fwd<-1>; }
#endif
extern "C" void kernel_launch(void* const* d_in, const int* in_sizes, int n_in, void* d_out, int out_size, void* d_ws, size_t ws_size, hipStream_t stream) {
    static int grid = 0;
    if (grid == 0) {
        if (n_in != 20 || ws_size < WS_END) { fprintf(stderr, "kernel_launch: need 20 inputs and %zu bytes of workspace; got %d, %zu\n", (size_t)WS_END, n_in, ws_size); grid = -1; return; }
        int dev = 0, cus = 0, per_cu = 0;
        if (hipGetDevice(&dev) != hipSuccess || hipDeviceGetAttribute(&cus, hipDeviceAttributeMultiprocessorCount, dev) != hipSuccess) { grid = -1; return; }
        for (int s = 0; s < NSITES; ++s) if (hipFuncSetAttribute(site_fn(s), hipFuncAttributeMaxDynamicSharedMemorySize, LDS_BYTES) != hipSuccess) { fprintf(stderr, "kernel_launch: hipFuncSetAttribute failed\n"); grid = -1; return; }
        if (hipOccupancyMaxActiveBlocksPerMultiprocessor(&per_cu, site_fn(N_LAUNCH_SPLIT ? 1 : NSITES - 1), NTHREADS, LDS_BYTES) != hipSuccess || per_cu < 1) fprintf(stderr, "kernel_launch: occupancy query says %d\n", per_cu);
        (void)hipGetLastError();
        grid = cus;
    }
    if (grid < 0) return;
    (void)hipMemsetAsync((char*)d_ws + WS_CTL, 0, CTL_ZERO_BYTES, stream);
    Params p{};
    for (int i = 0; i < 20; ++i) p.in[i] = (const float*)d_in[i];
    p.out = (float*)d_out; p.ws = (unsigned char*)d_ws;
#if N_LAUNCH_SPLIT
    for (int ph = 0; ph < N_PHASES; ++ph) { p.ph_lo = ph; p.ph_hi = ph + 1; const int site = ph == 0 ? 0 : ph == N_PHASES - 1 ? 22 : 1 + (ph - 1) % 21; void* args[] = {&p};
        (void)hipLaunchKernel(site_fn(site), dim3(grid), dim3(NTHREADS), args, LDS_BYTES, stream); }
#else
    p.ph_lo = 0; p.ph_hi = N_PHASES; { void* args[] = {&p}; (void)hipLaunchKernel(site_fn(NSITES - 1), dim3(grid), dim3(NTHREADS), args, LDS_BYTES, stream); }
#endif
}
```

```cpp
#include <hip/hip_runtime.h>
#include <cstdio>
#include <cstdint>
#ifndef N_LAUNCH_SPLIT
#define N_LAUNCH_SPLIT 0
#endif
namespace pg8 {
#define PG8_LAS __attribute__((address_space(3)))
typedef unsigned short bf16_t;
typedef short bf16x8 __attribute__((ext_vector_type(8)));
typedef float f32x4 __attribute__((ext_vector_type(4)));
typedef unsigned u32x4 __attribute__((ext_vector_type(4)));
constexpr int BM = 256, BK = 64, HALF = 128, HTB = HALF * BK * 2  , STAGE_BYTES = 8 * HTB, NXCD = 8, WGM = 8;

__host__ __device__ __forceinline__ int lds_byte(int r, int c) { const int st = (r >> 4) * 2 + (c >> 5), rr = r & 15, cc = c & 31, ob = rr * 64 + cc * 2; return st * 1024 + (ob ^ (((ob >> 9) & 1) << 5)); }
__host__ __device__ __forceinline__ void stage_rc(int b, int& R, int& C) { const int st = b / 1024, sb = b % 1024, swz = sb ^ (((sb >> 9) & 1) << 5); R = (st >> 1) * 16 + swz / 64; C = (st & 1) * 32 + (swz % 64) / 2; }
__host__ __device__ __forceinline__ int perm32(int rho) { const int n = rho >> 4, i = rho & 15; return 8 * (i >> 2) + 4 * n + (i & 3); }

struct Unit { int pm, pn, r0; };
struct Gemm { const bf16_t* A; const bf16_t* Bt; int M, N, K; };

struct StaticOrder {
    int nM, nN, nwg, G, c, tokmap;
    __host__ __device__ void init(int M, int N, int G_, int c_, int tokmap_ = 0) { nM = M / BM; nN = N / BM; nwg = nM * nN; G = G_; c = c_; tokmap = tokmap_; }
    __host__ __device__ bool next(int i, Unit& u) const {
        const long L = (long)i * G + c; if (L >= nwg) return false;
        int wgid = (int)L; { const int q = nwg / NXCD, r = nwg % NXCD, xcd = wgid % NXCD, off = wgid / NXCD; wgid = (xcd < r ? xcd * (q + 1) : r * (q + 1) + (xcd - r) * q) + off; }
        const int nig = WGM * nN, gid = wgid / nig, fm = gid * WGM, gsz = (nM - fm) < WGM ? (nM - fm) : WGM;
        u.pm = fm + ((wgid % nig) % gsz); u.pn = (wgid % nig) / gsz; u.r0 = tokmap ? 4112 * (u.pm >> 4) + 16 + 256 * (u.pm & 15) : 256 * u.pm; return true;
    }
    __device__ __forceinline__ const char* b_base(const Gemm& g, const Unit& u, size_t tstep) const { return (const char*)g.Bt + (size_t)u.pn * tstep; }
    __device__ __forceinline__ void a_ready(const Unit&) const {}
    __device__ __forceinline__ void done(const Unit&) const {}
};
__device__ __forceinline__ unsigned cvt_pk_bf16(float lo, float hi) { unsigned r; asm volatile("v_cvt_pk_bf16_f32 %0, %1, %2" : "=v"(r) : "v"(lo), "v"(hi)); return r; }
typedef int i32x8 __attribute__((ext_vector_type(8)));
typedef int i32x4v __attribute__((ext_vector_type(4)));
__device__ __forceinline__ i32x8 cat8(bf16x8 a, bf16x8 b) { const i32x4v x = __builtin_bit_cast(i32x4v, a), y = __builtin_bit_cast(i32x4v, b); return __builtin_shufflevector(x, y, 0, 1, 2, 3, 4, 5, 6, 7); }
__device__ __forceinline__ float clamp448(float x) { return __builtin_amdgcn_fmed3f(x, -448.0f, 448.0f); }
__device__ __forceinline__ unsigned cvt4_fp8(float a, float b, float c, float d) { int w = 0; w = __builtin_amdgcn_cvt_pk_fp8_f32(clamp448(a), clamp448(b), w, false); w = __builtin_amdgcn_cvt_pk_fp8_f32(clamp448(c), clamp448(d), w, true); return (unsigned)w; }
typedef unsigned u32x2v __attribute__((ext_vector_type(2)));
struct EpiStoreBf16 {
    static constexpr bool PERM = true, AFTER_DRAIN = false;
    bf16_t* O; int ldc; float s;
    __device__ __forceinline__ void operator()(const f32x4 (&acc)[2][2][4][2], const Unit& u, int wr, int wc, int fr, int fq) const {
        const int row0 = u.r0 + wr * 64 + fr, col0 = u.pn * BM + wc * 32 + 8 * fq;
#pragma unroll
        for (int ai = 0; ai < 2; ++ai)
#pragma unroll
            for (int m = 0; m < 4; ++m) { bf16_t* rowp = O + (size_t)(row0 + ai * HALF + m * 16) * ldc + col0;
#pragma unroll
                for (int bj = 0; bj < 2; ++bj) { const f32x4 v0 = acc[ai][bj][m][0] * s, v1 = acc[ai][bj][m][1] * s;
                    u32x4 w; w.x = cvt_pk_bf16(v0[0], v0[1]); w.y = cvt_pk_bf16(v0[2], v0[3]); w.z = cvt_pk_bf16(v1[0], v1[1]); w.w = cvt_pk_bf16(v1[2], v1[3]);
                    *(u32x4*)(rowp + bj * HALF) = w; } }
    }
};
struct EpiResAdd {
    static constexpr bool PERM = false, AFTER_DRAIN = false;
    float* H; int ldc; float s;
    __device__ __forceinline__ void operator()(const f32x4 (&acc)[2][2][4][2], const Unit& u, int wr, int wc, int fr, int fq) const {
        const int row0 = u.r0 + wr * 64 + fr, col0 = u.pn * BM + wc * 32 + 4 * fq;
#pragma unroll
        for (int ai = 0; ai < 2; ++ai)
#pragma unroll
            for (int m = 0; m < 4; ++m) { float* rowp = H + (size_t)(row0 + ai * HALF + m * 16) * ldc + col0;
                f32x4 h[2][2];
#pragma unroll
                for (int bj = 0; bj < 2; ++bj)
#pragma unroll
                    for (int n = 0; n < 2; ++n) h[bj][n] = *(const f32x4*)(rowp + bj * HALF + n * 16);
#pragma unroll
                for (int bj = 0; bj < 2; ++bj)
#pragma unroll
                    for (int n = 0; n < 2; ++n) *(f32x4*)(rowp + bj * HALF + n * 16) = h[bj][n] + acc[ai][bj][m][n] * s;
                if (m & 1) asm volatile("" ::: "memory"); }
    }
};
struct EpiResAddB {
    static constexpr bool PERM = true, AFTER_DRAIN = false;
    bf16_t* H; int ldc; float s;
    __device__ __forceinline__ void operator()(const f32x4 (&acc)[2][2][4][2], const Unit& u, int wr, int wc, int fr, int fq) const {
        const int row0 = u.r0 + wr * 64 + fr, col0 = u.pn * BM + wc * 32 + 8 * fq;
#pragma unroll
        for (int ai = 0; ai < 2; ++ai)
#pragma unroll
            for (int m = 0; m < 4; ++m) { bf16_t* rowp = H + (size_t)(row0 + ai * HALF + m * 16) * ldc + col0;
                u32x4 h[2];
#pragma unroll
                for (int bj = 0; bj < 2; ++bj) h[bj] = *(const u32x4*)(rowp + bj * HALF);
#pragma unroll
                for (int bj = 0; bj < 2; ++bj) { const f32x4 v0 = acc[ai][bj][m][0] * s, v1 = acc[ai][bj][m][1] * s; const u32x4 q = h[bj];
                    u32x4 w; w.x = cvt_pk_bf16(__uint_as_float(q.x << 16) + v0[0], __uint_as_float(q.x & 0xffff0000u) + v0[1]); w.y = cvt_pk_bf16(__uint_as_float(q.y << 16) + v0[2], __uint_as_float(q.y & 0xffff0000u) + v0[3]);
                    w.z = cvt_pk_bf16(__uint_as_float(q.z << 16) + v1[0], __uint_as_float(q.z & 0xffff0000u) + v1[1]); w.w = cvt_pk_bf16(__uint_as_float(q.w << 16) + v1[2], __uint_as_float(q.w & 0xffff0000u) + v1[3]);
                    *(u32x4*)(rowp + bj * HALF) = w; }
                if (m & 1) asm volatile("" ::: "memory"); }
    }
};
__device__ __forceinline__ float silu_mul(float g, float u) { return g * __builtin_amdgcn_rcpf(1.0f + __expf(-g)) * u; }
struct EpiSwiGLU {
    static constexpr bool PERM = true, AFTER_DRAIN = false;
    bf16_t* O; int ldc;
    __device__ __forceinline__ void operator()(const f32x4 (&acc)[2][2][4][2], const Unit& u, int wr, int wc, int fr, int fq) const {
        const int row0 = u.r0 + wr * 64 + fr, col0 = u.pn * HALF + wc * 32 + 8 * fq;
#pragma unroll
        for (int ai = 0; ai < 2; ++ai)
#pragma unroll
            for (int m = 0; m < 4; ++m) { bf16_t* rowp = O + (size_t)(row0 + ai * HALF + m * 16) * ldc + col0;
                const f32x4 g0 = acc[ai][0][m][0], g1 = acc[ai][0][m][1], u0 = acc[ai][1][m][0], u1 = acc[ai][1][m][1];
                u32x4 w; w.x = cvt_pk_bf16(silu_mul(g0[0], u0[0]), silu_mul(g0[1], u0[1])); w.y = cvt_pk_bf16(silu_mul(g0[2], u0[2]), silu_mul(g0[3], u0[3]));
                w.z = cvt_pk_bf16(silu_mul(g1[0], u1[0]), silu_mul(g1[1], u1[1])); w.w = cvt_pk_bf16(silu_mul(g1[2], u1[2]), silu_mul(g1[3], u1[3]));
                *(u32x4*)rowp = w; }
    }
};
struct EpiSwiGLU8 {
    static constexpr bool PERM = true, AFTER_DRAIN = false;
    unsigned char* O; int ldc; float sg, so;
    __device__ __forceinline__ void operator()(const f32x4 (&acc)[2][2][4][2], const Unit& u, int wr, int wc, int fr, int fq) const {
        const int row0 = u.r0 + wr * 64 + fr, col0 = u.pn * HALF + wc * 32 + 8 * fq;
        const float ss = sg * sg * so;
#pragma unroll
        for (int ai = 0; ai < 2; ++ai)
#pragma unroll
            for (int m = 0; m < 4; ++m) { unsigned char* rowp = O + (size_t)(row0 + ai * HALF + m * 16) * ldc + col0;
                const f32x4 g0 = acc[ai][0][m][0], g1 = acc[ai][0][m][1], u0 = acc[ai][1][m][0], u1 = acc[ai][1][m][1];
                float a[8];
#pragma unroll
                for (int i = 0; i < 4; ++i) { a[i] = g0[i] * __builtin_amdgcn_rcpf(1.0f + __expf(-sg * g0[i])) * u0[i] * ss; a[4 + i] = g1[i] * __builtin_amdgcn_rcpf(1.0f + __expf(-sg * g1[i])) * u1[i] * ss; }
                u32x2v w; w.x = cvt4_fp8(a[0], a[1], a[2], a[3]); w.y = cvt4_fp8(a[4], a[5], a[6], a[7]);
                *(u32x2v*)rowp = w; }
    }
};
struct EpiMoeDown {
    static constexpr bool PERM = true, AFTER_DRAIN = false;
    bf16_t* Y0; bf16_t* Y1; const int* slot_tok; const float* slot_g; int ldc; float s;
    __device__ __forceinline__ void operator()(const f32x4 (&acc)[2][2][4][2], const Unit& u, int wr, int wc, int fr, int fq) const {
        const int row0 = u.r0 + wr * 64 + fr, col0 = u.pn * BM + wc * 32 + 8 * fq;
#pragma unroll
        for (int ai = 0; ai < 2; ++ai)
#pragma unroll
            for (int m = 0; m < 4; ++m) { const int slot = row0 + ai * HALF + m * 16; const int ti = slot_tok[slot]; const float g = slot_g[slot] * s;
                if (ti >= 0) { bf16_t* rowp = ((ti >> 16) ? Y1 : Y0) + (size_t)(ti & 0xffff) * ldc + col0;
#pragma unroll
                    for (int bj = 0; bj < 2; ++bj) { const f32x4 v0 = acc[ai][bj][m][0] * g, v1 = acc[ai][bj][m][1] * g;
                        u32x4 w; w.x = cvt_pk_bf16(v0[0], v0[1]); w.y = cvt_pk_bf16(v0[2], v0[3]); w.z = cvt_pk_bf16(v1[0], v1[1]); w.w = cvt_pk_bf16(v1[2], v1[3]);
                        *(u32x4*)(rowp + bj * HALF) = w; } } }
    }
};
struct GroupedOrder {
    int nM, nN, nwg, G, c; int p1, p2, p3, p4, p5, p6, p7; size_t estride; int bmajor;
    __device__ __forceinline__ bool next(int i, Unit& u) const {
        const long L = (long)i * G + c; if (L >= nwg) return false;
        int wgid = (int)L; { const int q = nwg / NXCD, r = nwg % NXCD, xcd = wgid % NXCD, off = wgid / NXCD; wgid = (xcd < r ? xcd * (q + 1) : r * (q + 1) + (xcd - r) * q) + off; }
        if (bmajor) {
            const int e = (wgid >= nN * p1) + (wgid >= nN * p2) + (wgid >= nN * p3) + (wgid >= nN * p4) + (wgid >= nN * p5) + (wgid >= nN * p6) + (wgid >= nN * p7);
            const int pe = e == 0 ? 0 : e == 1 ? p1 : e == 2 ? p2 : e == 3 ? p3 : e == 4 ? p4 : e == 5 ? p5 : e == 6 ? p6 : p7;
            const int pe1 = e == 0 ? p1 : e == 1 ? p2 : e == 2 ? p3 : e == 3 ? p4 : e == 4 ? p5 : e == 5 ? p6 : e == 6 ? p7 : nM;
            const int np = pe1 - pe, local = wgid - nN * pe, gsz = np * 7, pg = local / gsz, rem = local - pg * gsz, pmo = rem / 7;
            u.pm = pe + pmo; u.pn = pg * 7 + (rem - pmo * 7); u.r0 = 256 * u.pm; return true;
        }
        const int nig = WGM * nN, gid = wgid / nig, fm = gid * WGM, gsz = (nM - fm) < WGM ? (nM - fm) : WGM;
        u.pm = fm + ((wgid % nig) % gsz); u.pn = (wgid % nig) / gsz; u.r0 = 256 * u.pm; return true;
    }
    __device__ __forceinline__ const char* b_base(const Gemm& g, const Unit& u, size_t tstep) const {
        const int e = (u.pm >= p1) + (u.pm >= p2) + (u.pm >= p3) + (u.pm >= p4) + (u.pm >= p5) + (u.pm >= p6) + (u.pm >= p7);
        return (const char*)g.Bt + (size_t)e * estride + (size_t)u.pn * tstep; }
    __device__ __forceinline__ void a_ready(const Unit&) const {}
    __device__ __forceinline__ void done(const Unit&) const {}
};
template <class Epi, class Sched, bool ALIGN_EPI = false, bool SP2 = false, bool FP8 = false>
__device__ __forceinline__ void gemm_phase(PG8_LAS unsigned char* lds, const Gemm g, const Sched& S, const Epi& E, int tid_in) {
    int tid_ = tid_in; asm volatile("" : "+v"(tid_));
    const int tid = tid_, wid = __builtin_amdgcn_readfirstlane(tid >> 6), lane = tid & 63, wr = wid >> 2, wc = wid & 3, fr = lane & 15, fq = lane >> 4;
    const int K = g.K, nt = K / BK;
    unsigned voffA[2], voffB[2];
#pragma unroll
    for (int i = 0; i < 2; ++i) { int R, C; stage_rc(tid * 16 + i * 8192, R, C); const int Rb = Epi::PERM ? ((R & ~31) + perm32(R & 31)) : R;
        voffA[i] = (unsigned)(R * K + C) * 2u; voffB[i] = (unsigned)(Rb * K + C) * 2u; }
    const size_t kstep = (size_t)(BK * 2);
    const size_t hstep = (size_t)HALF * K * 2;
    const size_t tstep = 2 * hstep;
    const unsigned ldsw = (unsigned)wid * 1024u;
    const int aoff = lds_byte(wr * 64 + fr, fq * 8), boff = lds_byte(wc * 32 + fr, fq * 8);
#define PG8_SA(b, h) (((b) * 2 + (h)) * HTB)
#define PG8_SB(b, h) ((4 + (b) * 2 + (h)) * HTB)
#define PG8_STAGE(bufoff, gbase, voff) do { _Pragma("unroll") for (int _i = 0; _i < 2; ++_i) \
        __builtin_amdgcn_global_load_lds((const unsigned*)((const char*)(gbase) + (voff)[_i]), (PG8_LAS unsigned*)(lds + (bufoff) + ldsw + _i * 8192), 16, 0, 0); } while (0)
#define PG8_LDA(dst, b, h) do { _Pragma("unroll") for (int m = 0; m < 4; ++m) _Pragma("unroll") for (int k = 0; k < 2; ++k) { \
        if constexpr (FP8) { const i32x4v v_ = *(const PG8_LAS i32x4v*)(lds + PG8_SA(b, h) + aoff + m * 2048 + k * 1024); if (k == 0) dst##8[m].lo = v_; else dst##8[m].hi = v_; } \
        else dst[m][k] = *(const PG8_LAS bf16x8*)(lds + PG8_SA(b, h) + aoff + m * 2048 + k * 1024); } } while (0)
#define PG8_LDB(dst, b, h) do { _Pragma("unroll") for (int n = 0; n < 2; ++n) _Pragma("unroll") for (int k = 0; k < 2; ++k) { \
        if constexpr (FP8) { const i32x4v v_ = *(const PG8_LAS i32x4v*)(lds + PG8_SB(b, h) + boff + n * 2048 + k * 1024); if (k == 0) dst##8[n].lo = v_; else dst##8[n].hi = v_; } \
        else dst[n][k] = *(const PG8_LAS bf16x8*)(lds + PG8_SB(b, h) + boff + n * 2048 + k * 1024); } } while (0)
#define PG8_MMA(ai, bj, At, Bt) do { __builtin_amdgcn_s_setprio(1); _Pragma("unroll") for (int m = 0; m < 4; ++m) _Pragma("unroll") for (int n = 0; n < 2; ++n) { \
        if constexpr (FP8) asm volatile("v_mfma_scale_f32_16x16x128_f8f6f4 %0, %1, %2, %0, %3, %3 op_sel_hi:[0,0,0]" : "+v"(acc[ai][bj][m][n]) : "v"(Bt##8[n]), "v"(At##8[m]), "v"(sc7f));   \
        else { _Pragma("unroll") for (int k = 0; k < 2; ++k) acc[ai][bj][m][n] = __builtin_amdgcn_mfma_f32_16x16x32_bf16(Bt[n][k], At[m][k], acc[ai][bj][m][n], 0, 0, 0); } } \
        __builtin_amdgcn_s_setprio(0); } while (0)
#define PG8_WAIT_V(n) asm volatile("s_waitcnt vmcnt(" #n ")" ::: "memory")
#define PG8_WAIT_L(n) asm volatile("s_waitcnt lgkmcnt(" #n ")" ::: "memory")
#define PG8_BAR __builtin_amdgcn_s_barrier()
#define PG8_SCHED __builtin_amdgcn_sched_barrier(0)
    Unit cur, nxt; int ui = 0;
    if (!S.next(0, cur)) return;
    f32x4 acc[2][2][4][2];
#pragma unroll
    for (int a = 0; a < 2; ++a)
#pragma unroll
        for (int b = 0; b < 2; ++b)
#pragma unroll
            for (int m = 0; m < 4; ++m)
#pragma unroll
                for (int n = 0; n < 2; ++n) acc[a][b][m][n] = (f32x4){0.f, 0.f, 0.f, 0.f};
    int sc7f = 0x7f; asm volatile("" : "+v"(sc7f));
    bf16x8 At[4][2], B0[2][2], B1[2][2]; i32x8 At8[4], B08[2], B18[2];
    const char* cA = (const char*)g.A + (size_t)cur.r0 * K * 2; const char* cB = S.b_base(g, cur, tstep);
    S.a_ready(cur);
    if constexpr (SP2) {
        PG8_STAGE(PG8_SB(0, 0), cB, voffB); PG8_STAGE(PG8_SB(0, 1), cB + hstep, voffB); PG8_STAGE(PG8_SA(0, 0), cA, voffA); PG8_STAGE(PG8_SA(0, 1), cA + hstep, voffA);
        if (wr == 1) PG8_BAR;
        PG8_WAIT_V(2); PG8_BAR;
        PG8_STAGE(PG8_SB(1, 0), cB + kstep, voffB); PG8_STAGE(PG8_SA(1, 0), cA + kstep, voffA); PG8_STAGE(PG8_SB(1, 1), cB + hstep + kstep, voffB);
        PG8_WAIT_V(6); PG8_BAR;
    } else {
        PG8_STAGE(PG8_SB(0, 0), cB, voffB); PG8_STAGE(PG8_SA(0, 0), cA, voffA); PG8_STAGE(PG8_SB(0, 1), cB + hstep, voffB); PG8_STAGE(PG8_SA(0, 1), cA + hstep, voffA);
        if (wr == 1) PG8_BAR;
        PG8_WAIT_V(4); PG8_BAR;
        PG8_STAGE(PG8_SB(1, 0), cB + kstep, voffB); PG8_STAGE(PG8_SA(1, 0), cA + kstep, voffA); PG8_STAGE(PG8_SB(1, 1), cB + hstep + kstep, voffB);
        PG8_WAIT_V(6); PG8_BAR;
    }
    for (;;) {
        const bool has_next = S.next(ui + 1, nxt);
        const char* nA = has_next ? (const char*)g.A + (size_t)nxt.r0 * K * 2 : cA; const char* nB = has_next ? S.b_base(g, nxt, tstep) : cB;
        for (int t = 0; t < nt; t += 2) {
            const bool last = (t == nt - 2);
            const char* a1 = cA + (size_t)(t + 1) * kstep;
            const char* a2 = last ? nA : cA + (size_t)(t + 2) * kstep; const char* b2 = last ? nB : cB + (size_t)(t + 2) * kstep;
            const char* a3 = a2 + kstep; const char* b3 = b2 + kstep;
            if (last && has_next) S.a_ready(nxt);
            if constexpr (SP2) {
            PG8_LDB(B0, 0, 0); PG8_LDB(B1, 0, 1); PG8_SCHED; PG8_LDA(At, 0, 0); PG8_STAGE(PG8_SA(1, 1), a1 + hstep, voffA);
            PG8_WAIT_V(8); PG8_WAIT_L(0); PG8_BAR; PG8_MMA(0, 0, At, B0); PG8_MMA(0, 1, At, B1); PG8_BAR; PG8_SCHED;
            PG8_LDA(At, 0, 1); PG8_STAGE(PG8_SB(0, 0), b2, voffB); PG8_STAGE(PG8_SB(0, 1), b2 + hstep, voffB); PG8_STAGE(PG8_SA(0, 0), a2, voffA);
            PG8_WAIT_V(8); PG8_WAIT_L(0); PG8_BAR; PG8_MMA(1, 0, At, B0); PG8_MMA(1, 1, At, B1); PG8_BAR; PG8_SCHED;
            PG8_LDB(B0, 1, 0); PG8_LDB(B1, 1, 1); PG8_SCHED; PG8_LDA(At, 1, 0); PG8_STAGE(PG8_SA(0, 1), a2 + hstep, voffA);
            PG8_WAIT_V(8); PG8_WAIT_L(0); PG8_BAR; PG8_MMA(0, 0, At, B0); PG8_MMA(0, 1, At, B1); PG8_BAR; PG8_SCHED;
            PG8_LDA(At, 1, 1); PG8_STAGE(PG8_SB(1, 0), b3, voffB); PG8_STAGE(PG8_SB(1, 1), b3 + hstep, voffB); PG8_STAGE(PG8_SA(1, 0), a3, voffA);
            PG8_WAIT_V(8); PG8_WAIT_L(0); PG8_BAR; PG8_MMA(1, 0, At, B0); PG8_MMA(1, 1, At, B1); PG8_BAR; PG8_SCHED;
            } else {
            PG8_LDB(B0, 0, 0); PG8_SCHED; PG8_LDA(At, 0, 0); PG8_STAGE(PG8_SA(1, 1), a1 + hstep, voffA);
            PG8_WAIT_L(8); PG8_BAR; PG8_WAIT_L(0); PG8_MMA(0, 0, At, B0); PG8_BAR; PG8_SCHED;
            PG8_LDB(B1, 0, 1); PG8_STAGE(PG8_SB(0, 0), b2, voffB);
            PG8_BAR; PG8_WAIT_L(0); PG8_MMA(0, 1, At, B1); PG8_BAR;
            PG8_LDA(At, 0, 1); PG8_STAGE(PG8_SA(0, 0), a2, voffA);
            PG8_BAR; PG8_WAIT_L(0); PG8_MMA(1, 0, At, B0); PG8_BAR; PG8_SCHED;
            PG8_STAGE(PG8_SB(0, 1), b2 + hstep, voffB);
            PG8_WAIT_V(6); PG8_BAR; PG8_MMA(1, 1, At, B1); PG8_BAR;
            PG8_LDB(B0, 1, 0); PG8_SCHED; PG8_LDA(At, 1, 0); PG8_STAGE(PG8_SA(0, 1), a2 + hstep, voffA);
            PG8_WAIT_L(8); PG8_BAR; PG8_WAIT_L(0); PG8_MMA(0, 0, At, B0); PG8_BAR; PG8_SCHED;
            PG8_LDB(B1, 1, 1); PG8_STAGE(PG8_SB(1, 0), b3, voffB);
            PG8_BAR; PG8_WAIT_L(0); PG8_MMA(0, 1, At, B1); PG8_BAR;
            PG8_LDA(At, 1, 1); PG8_STAGE(PG8_SA(1, 0), a3, voffA);
            PG8_BAR; PG8_WAIT_L(0); PG8_MMA(1, 0, At, B0); PG8_BAR; PG8_SCHED;
            PG8_STAGE(PG8_SB(1, 1), b3 + hstep, voffB);
            PG8_WAIT_V(6); PG8_BAR; PG8_MMA(1, 1, At, B1); PG8_BAR;
            }
        }
        if constexpr (FP8) asm volatile("s_nop 15\n\ts_nop 15" ::: "memory");
        if constexpr (ALIGN_EPI) { if (wr == 0) PG8_BAR; }
        if constexpr (!Epi::AFTER_DRAIN) { E(acc, cur, wr, wc, fr, fq); S.done(cur); }
        if (!has_next) break;
#pragma unroll
        for (int a = 0; a < 2; ++a)
#pragma unroll
            for (int b = 0; b < 2; ++b)
#pragma unroll
                for (int m = 0; m < 4; ++m)
#pragma unroll
                    for (int n = 0; n < 2; ++n) acc[a][b][m][n] = (f32x4){0.f, 0.f, 0.f, 0.f};
        cur = nxt; cA = nA; cB = nB; ++ui;
        if constexpr (ALIGN_EPI) { if (wr == 1) PG8_BAR; }
    }
    PG8_WAIT_V(0);
    if constexpr (!ALIGN_EPI) { if (wr == 0) PG8_BAR; }
    PG8_BAR;
    if constexpr (Epi::AFTER_DRAIN) { E.fused(acc, cur, wr, wc, fr, fq, lds, wid, lane); S.done(cur); }
#undef PG8_SA
#undef PG8_SB
#undef PG8_STAGE
#undef PG8_LDA
#undef PG8_LDB
#undef PG8_MMA
#undef PG8_WAIT_V
#undef PG8_WAIT_L
#undef PG8_BAR
#undef PG8_SCHED
}
}
constexpr int BATCH = 4, SEQ = 4096, NMETA = 16, SL = SEQ + NMETA  , NT = BATCH * SL  , MP = 16640  , D = 1024;
constexpr int DSA_LDW = 2696, DSA_NP = 2816, DQ0 = 0, DK0 = 1024, DV0 = 1280, DIQ0 = 1536, DIK0 = 2560, DIW0 = 2688;
constexpr int ML_LDW = 3080, ML_NP = 3072, MQ0 = 0, MK0 = 512, MV0 = 1024, MO0 = 2048, MG0 = 3072;
constexpr int FF = 3584, GU = 7168, NE = 8;
constexpr int MOE_ROWS = 35072;
constexpr int NWAVES = 8, NTHREADS = 512;
#ifndef FP8_DENSE
#define FP8_DENSE 1
#endif
#ifndef FP8_MOE
#define FP8_MOE 1
#endif
constexpr float SW_GU = 32.0f, SW_DN = 128.0f, SA_ACT = 4.0f;
#ifndef CONV_IN_PROLOGUE
#define CONV_IN_PROLOGUE 0
#endif
#ifndef H_BF16
#define H_BF16 1
#endif
#ifndef MOE_GU_BMAJOR
#define MOE_GU_BMAJOR 0
#endif
#ifndef FP8_DSA
#define FP8_DSA 0
#endif
#ifndef FP8_DSA_IN
#define FP8_DSA_IN 0
#endif
constexpr float SW_DIN = 32.0f, SW_DOUT = 64.0f, SA_ATT = 16.0f;
constexpr int SCLD = 4128;
constexpr float RMS_EPS = 1e-6f;
constexpr size_t MiB = 1u << 20;
constexpr size_t WS_CTL = 0, CTL_ZERO_BYTES = 1 * MiB;
constexpr size_t WS_ROPE = 1 * MiB;
constexpr size_t WS_SM8 = 4 * MiB;
constexpr size_t WS_ROUTE = 5 * MiB;
constexpr size_t WS_MLG = 6 * MiB;
constexpr size_t WS_MLI = 17 * MiB + 256 * 1024;
constexpr size_t WS_NH = 7 * MiB;
constexpr size_t WS_SLOT = 8 * MiB;
constexpr size_t WS_SEL = 9 * MiB;
constexpr size_t WS_WDSA_IN = 18 * MiB, WS_WDSA_OUT = 29 * MiB, WS_WML_IN = 33 * MiB, WS_WML_OUT = 45 * MiB, WS_WFFN_GU = 49 * MiB, WS_WFFN_DN = 77 * MiB;
constexpr size_t WS_WMOE_GU = 91 * MiB, WS_WMOE_DN = 315 * MiB;
constexpr size_t WS_H = 427 * MiB;
constexpr size_t WS_XN = 492 * MiB;
constexpr size_t WS_R = 525 * MiB, WS_K8 = 875 * MiB, WS_XN8 = 875 * MiB, WS_END = 892 * MiB;
constexpr size_t R_PROJ = 0, R_SC = 90 * MiB, R_ACT = 0, R_DC = 98 * MiB, R_CH = 130 * MiB, R_AS = 240 * MiB, R_Y0 = 240 * MiB, R_Y1 = 274 * MiB;
static_assert(R_SC + (size_t)NT * SCLD * 4 + 16384 <= WS_K8 - WS_R, "score matrix (+ 8 KiB of never-read store slots behind it) fits");
static_assert((size_t)MOE_ROWS * FF * 2 <= R_AS && R_AS + (size_t)MOE_ROWS * D * 2 <= WS_K8 - WS_R, "moe buffers fit");
static_assert((size_t)MP * DSA_NP * 2 <= R_SC && (size_t)MP * ML_NP * 2 <= R_DC, "proj fits");
constexpr int CW_BAR = 4096;
constexpr int CW_CNT = 8192;
constexpr int LDS_BYTES = 151552;
constexpr int MISC_OFF = LDS_BYTES - 256;

#define GAS __attribute__((address_space(1)))
#define LAS __attribute__((address_space(3)))
typedef unsigned short bf16;
#if H_BF16
typedef unsigned short HT;
#else
typedef float HT;
#endif
typedef float f32x4 __attribute__((ext_vector_type(4)));
typedef float f32x2 __attribute__((ext_vector_type(2)));
typedef float f32x16 __attribute__((ext_vector_type(16)));
typedef short bf16x8 __attribute__((ext_vector_type(8)));
typedef short s16x4 __attribute__((ext_vector_type(4)));
typedef unsigned u32x4 __attribute__((ext_vector_type(4)));
typedef unsigned u32x2 __attribute__((ext_vector_type(2)));
#define MFMA32(a, b, c) __builtin_amdgcn_mfma_f32_32x32x16_bf16((a), (b), (c), 0, 0, 0)
#define MFMA16(a, b, c) __builtin_amdgcn_mfma_f32_16x16x32_bf16((a), (b), (c), 0, 0, 0)
__device__ __forceinline__ float bf2f(unsigned short b) { return __uint_as_float(((unsigned)b) << 16); }
__device__ __forceinline__ float bflo(unsigned w) { return __uint_as_float(w << 16); }
__device__ __forceinline__ float bfhi(unsigned w) { return __uint_as_float(w & 0xffff0000u); }
__device__ __forceinline__ unsigned pk2(float lo, float hi) { return pg8::cvt_pk_bf16(lo, hi); }
__device__ __forceinline__ float wave_sum(float v) {
#pragma unroll
    for (int o = 1; o < 64; o <<= 1) v += __shfl_xor(v, o);
    return v; }
__device__ __forceinline__ int crow(int r, int hi) { return (r & 3) + 8 * (r >> 2) + 4 * hi; }

#define XB_TMO      128
#define XB_XCNT(j)  (256  + 64 * (j))
#define XB_XSUB(j)  (1280 + 64 * (j))
#define XB_XGEN(j)  (2304 + 64 * (j))
#define XB_TOP      3328
#define XB_TOPGEN   3392
#define XCD_BAR_WORDS 3456
#define XB_SPIN_CAP (1u << 18)
__device__ __forceinline__ unsigned xb_ld(unsigned* p)              { return __hip_atomic_load(p, __ATOMIC_RELAXED, __HIP_MEMORY_SCOPE_AGENT); }
__device__ __forceinline__ unsigned xb_add(unsigned* p, unsigned v) { return __hip_atomic_fetch_add(p, v, __ATOMIC_RELAXED, __HIP_MEMORY_SCOPE_AGENT); }
__device__ __forceinline__ unsigned xb_xcc_id() { return (unsigned)__builtin_amdgcn_s_getreg((3 << 11) | 20) & 0xFu; }
#define XB_SPIN(cond, bar) do { unsigned _sp = 0; while (cond) { __builtin_amdgcn_s_sleep(1); \
    if ((++_sp & 255u) == 0u) { if (xb_ld(&(bar)[XB_TMO])) break; if (_sp > XB_SPIN_CAP) { atomicAdd(&(bar)[XB_TMO], 1u); break; } } } } while (0)
__device__ __forceinline__ int hw_lane() { int l; asm volatile("v_mbcnt_lo_u32_b32 %0, -1, 0\n\tv_mbcnt_hi_u32_b32 %0, -1, %0" : "=v"(l)); return l; }
struct XcdBarrier { unsigned* bar; unsigned x; volatile LAS unsigned* st; int wave; };
__device__ __forceinline__ XcdBarrier xcd_barrier_post(unsigned* bar, volatile LAS unsigned* st, int wave) {
    XcdBarrier b; b.bar = bar; b.x = xb_xcc_id(); b.st = st; b.wave = wave;
    if (wave == 0 && hw_lane() == 0) (void)xb_add(&bar[XB_XCNT(b.x)], 1u);
    return b;
}
__device__ __forceinline__ void xcd_barrier_complete(unsigned* bar, unsigned x, unsigned& nloc, unsigned& nx) {
    const unsigned G = gridDim.x * gridDim.y * gridDim.z;
    unsigned sum, cnt, mine, sp = 0u;
    for (;;) {
        sum = 0u; cnt = 0u; mine = 0u;
#pragma unroll
        for (unsigned j = 0; j < 16; ++j) { const unsigned c = xb_ld(&bar[XB_XCNT(j)]); sum += c; cnt += (c > 0u) ? 1u : 0u; mine = (j == x) ? c : mine; }
        if (sum == G) break;
        __builtin_amdgcn_s_sleep(1);
        if ((++sp & 255u) == 0u) { if (xb_ld(&bar[XB_TMO])) break; if (sp > XB_SPIN_CAP) { atomicAdd(&bar[XB_TMO], 1u); break; } }
    }
    nloc = mine > 0u ? mine : 1u; nx = cnt > 0u ? cnt : 1u;
}
__device__ __forceinline__ void xcd_barrier(const XcdBarrier& b) {
    asm volatile("s_waitcnt vmcnt(0)" ::: "memory");
    __syncthreads();
    if (b.wave == 0 && hw_lane() == 0) {
        unsigned* bar = b.bar;
        __builtin_amdgcn_s_waitcnt(0);
        unsigned nloc = b.st[0], nx = b.st[1];
        if (nloc == 0u) { xcd_barrier_complete(bar, b.x, nloc, nx); b.st[0] = nloc; b.st[1] = nx; }
        const unsigned old = xb_add(&bar[XB_XSUB(b.x)], 1u);
        const unsigned gen = old / nloc;
        if (old + 1u == (gen + 1u) * nloc) {
            __builtin_amdgcn_fence(__ATOMIC_RELEASE, "agent");
            asm volatile("s_waitcnt vmcnt(0)" ::: "memory");
            (void)xb_add(&bar[XB_TOP], 1u);
        }
        const unsigned target = (gen + 1u) * nx;
        XB_SPIN(xb_ld(&bar[XB_TOP]) < target, bar);
        __builtin_amdgcn_fence(__ATOMIC_ACQUIRE, "agent");
        asm volatile("s_waitcnt vmcnt(0)" ::: "memory");
    }
    __syncthreads();
}

struct Params { const float* in[20]; float* out; unsigned char* ws; int ph_lo, ph_hi; };
struct Ctx {
    LAS unsigned char* lds; int tid, lane, wave, G, bid, gw, ngw;
    unsigned* ctl;
    float2* rope; float* sm8; int* route_e; int* route_r1; int* route_r2; float* route_g1;
    float* mlf; float* mlc; float* mlp; float* mli; float* mlg; float* dn; float* nh; int* slot_tok; float* slot_g; unsigned short* sel;
    bf16 *wdsa_in, *wdsa_out, *wml_in, *wml_out, *wffn_gu, *wffn_dn, *wmoe_gu, *wmoe_dn;
    HT* H; bf16* XN; unsigned char* R; unsigned char* xn8;
};
__device__ __forceinline__ void conv_item(const float* W, int K, int ld, int n0, int k0, bf16* WT, int drow0, LAS float* scr, int lane) {
#pragma unroll 8
    for (int i = 0; i < 32; ++i) { const int kk = 2 * i + (lane >> 5); scr[kk * 33 + (lane & 31)] = W[(size_t)(k0 + kk) * ld + n0 + (lane & 31)]; }
    asm volatile("s_waitcnt lgkmcnt(0)" ::: "memory");
    const int c = lane & 7;
#pragma unroll
    for (int j = 0; j < 4; ++j) { const int n = (lane >> 3) + 8 * j; const LAS float* s = scr + (8 * c) * 33 + n;
        u32x4 o; o.x = pk2(s[0 * 33], s[1 * 33]); o.y = pk2(s[2 * 33], s[3 * 33]); o.z = pk2(s[4 * 33], s[5 * 33]); o.w = pk2(s[6 * 33], s[7 * 33]);
        *(u32x4*)(WT + (size_t)(drow0 + n) * K + k0 + 8 * c) = o; }
    asm volatile("s_waitcnt lgkmcnt(0)" ::: "memory");
}
__device__ __forceinline__ void conv_item8(const float* W, int K, int ld, int n0, int k0, unsigned char* WT, int drow0, LAS float* scr, int lane, float scale) {
#pragma unroll 8
    for (int i = 0; i < 32; ++i) { const int kk = 2 * i + (lane >> 5); scr[kk * 33 + (lane & 31)] = W[(size_t)(k0 + kk) * ld + n0 + (lane & 31)]; }
    asm volatile("s_waitcnt lgkmcnt(0)" ::: "memory");
    const int c = lane & 7;
#pragma unroll
    for (int j = 0; j < 4; ++j) { const int n = (lane >> 3) + 8 * j; const LAS float* s = scr + (8 * c) * 33 + n;
        u32x2 o; o.x = pg8::cvt4_fp8(s[0 * 33] * scale, s[1 * 33] * scale, s[2 * 33] * scale, s[3 * 33] * scale); o.y = pg8::cvt4_fp8(s[4 * 33] * scale, s[5 * 33] * scale, s[6 * 33] * scale, s[7 * 33] * scale);
        *(u32x2*)(WT + (size_t)(drow0 + n) * K + k0 + 8 * c) = o; }
    asm volatile("s_waitcnt lgkmcnt(0)" ::: "memory");
}
__device__ __forceinline__ void conv_plain8(const float* W, int K, int N, int ld, unsigned char* WT, int item, LAS float* scr, int lane, float scale) {
    const int nblk = N / 32, kb = item / nblk, nb = item % nblk;
    conv_item8(W, K, ld, 32 * nb, 64 * kb, WT, 32 * nb, scr, lane, scale);
}
__device__ __forceinline__ void conv_gu8(const float* W, int isup, unsigned char* WT, int item, LAS float* scr, int lane, float scale) {
    const int nblk = FF / 32, kb = item / nblk, nb = item % nblk, n0 = 32 * nb;
    conv_item8(W, D, FF, n0, 64 * kb, WT, 256 * (n0 >> 7) + 128 * isup + (n0 & 127), scr, lane, scale);
}
__device__ __forceinline__ void conv_plain(const float* W, int K, int N, int ld, bf16* WT, int item, LAS float* scr, int lane) {
    const int nblk = N / 32, kb = item / nblk, nb = item % nblk;
    conv_item(W, K, ld, 32 * nb, 64 * kb, WT, 32 * nb, scr, lane);
}
__device__ __forceinline__ void conv_gu(const float* W, int isup, bf16* WT, int item, LAS float* scr, int lane) {
    const int nblk = FF / 32, kb = item / nblk, nb = item % nblk, n0 = 32 * nb;
    conv_item(W, D, FF, n0, 64 * kb, WT, 256 * (n0 >> 7) + 128 * isup + (n0 & 127), scr, lane);
}
typedef const __attribute__((address_space(4))) Params* KArgP;
__device__ __forceinline__ void conv_big(const Ctx& C, KArgP P, int m, int r, LAS float* scr) {
    unsigned char* gu8d = (unsigned char*)C.wffn_gu; unsigned char* dn8d = (unsigned char*)C.wffn_dn; unsigned char* gu8m = (unsigned char*)C.wmoe_gu; unsigned char* dn8m = (unsigned char*)C.wmoe_dn;
    if (m < 2) { if (FP8_DENSE) conv_gu8(P->in[13] + (size_t)m * D * FF, 0, gu8d + (size_t)m * GU * D, r, scr, C.lane, SW_GU); else conv_gu(P->in[13] + (size_t)m * D * FF, 0, C.wffn_gu + (size_t)m * GU * D, r, scr, C.lane); }
    else if (m < 4) { if (FP8_DENSE) conv_gu8(P->in[14] + (size_t)(m - 2) * D * FF, 1, gu8d + (size_t)(m - 2) * GU * D, r, scr, C.lane, SW_GU); else conv_gu(P->in[14] + (size_t)(m - 2) * D * FF, 1, C.wffn_gu + (size_t)(m - 2) * GU * D, r, scr, C.lane); }
    else if (m < 6) { if (FP8_DENSE) conv_plain8(P->in[15] + (size_t)(m - 4) * FF * D, FF, D, D, dn8d + (size_t)(m - 4) * D * FF, r, scr, C.lane, SW_DN); else conv_plain(P->in[15] + (size_t)(m - 4) * FF * D, FF, D, D, C.wffn_dn + (size_t)(m - 4) * D * FF, r, scr, C.lane); }
    else if (m < 22) { if (FP8_MOE) conv_gu8(P->in[17] + (size_t)(m - 6) * D * FF, 0, gu8m + (size_t)(m - 6) * GU * D, r, scr, C.lane, SW_GU); else conv_gu(P->in[17] + (size_t)(m - 6) * D * FF, 0, C.wmoe_gu + (size_t)(m - 6) * GU * D, r, scr, C.lane); }
    else if (m < 38) { if (FP8_MOE) conv_gu8(P->in[18] + (size_t)(m - 22) * D * FF, 1, gu8m + (size_t)(m - 22) * GU * D, r, scr, C.lane, SW_GU); else conv_gu(P->in[18] + (size_t)(m - 22) * D * FF, 1, C.wmoe_gu + (size_t)(m - 22) * GU * D, r, scr, C.lane); }
    else { if (FP8_MOE) conv_plain8(P->in[19] + (size_t)(m - 38) * FF * D, FF, D, D, dn8m + (size_t)(m - 38) * D * FF, r, scr, C.lane, SW_DN); else conv_plain(P->in[19] + (size_t)(m - 38) * FF * D, FF, D, D, C.wmoe_dn + (size_t)(m - 38) * D * FF, r, scr, C.lane); }
}
struct ConvD { const float* src; unsigned char* dst; int K; float scale; };
template <int LD>
__device__ __forceinline__ void conv_ld32(const float* src, int lane, float (&v)[32]) {
    const float* p = src + (size_t)(lane >> 5) * LD + (lane & 31);
#pragma unroll
    for (int i = 0; i < 32; ++i) v[i] = p[(size_t)(2 * i) * LD];
}
__device__ __forceinline__ void conv_st8(const ConvD& d, const float (&v)[32], LAS float* scr, int lane) {
#pragma unroll
    for (int i = 0; i < 32; ++i) scr[(2 * i + (lane >> 5)) * 33 + (lane & 31)] = v[i];
    asm volatile("s_waitcnt lgkmcnt(0)" ::: "memory");
    const int c = lane & 7; const float scale = d.scale;
#pragma unroll
    for (int j = 0; j < 4; ++j) { const int n = (lane >> 3) + 8 * j; const LAS float* s = scr + (8 * c) * 33 + n;
        u32x2 o; o.x = pg8::cvt4_fp8(s[0 * 33] * scale, s[1 * 33] * scale, s[2 * 33] * scale, s[3 * 33] * scale); o.y = pg8::cvt4_fp8(s[4 * 33] * scale, s[5 * 33] * scale, s[6 * 33] * scale, s[7 * 33] * scale);
        *(u32x2*)(d.dst + (size_t)n * d.K + 8 * c) = o; }
    asm volatile("s_waitcnt lgkmcnt(0)" ::: "memory");
}
__device__ __forceinline__ bool conv_desc(const Ctx& C, KArgP P, int m, int r, ConvD& d) {
    unsigned char* gu8d = (unsigned char*)C.wffn_gu; unsigned char* dn8d = (unsigned char*)C.wffn_dn; unsigned char* gu8m = (unsigned char*)C.wmoe_gu; unsigned char* dn8m = (unsigned char*)C.wmoe_dn;
    const bool isdn = (m >= 4 && m < 6) || m >= 38;
    if (!isdn) {
        const int isup = (m >= 2 && m < 4) || (m >= 22); const int mm = m < 2 ? m : m < 4 ? m - 2 : m < 22 ? m - 6 : m - 22;
        const float* W = (m < 2 ? P->in[13] : m < 4 ? P->in[14] : m < 22 ? P->in[17] : P->in[18]) + (size_t)mm * D * FF;
        unsigned char* WT = (m < 4 ? gu8d : gu8m) + (size_t)mm * GU * D;
        const int nblk = FF / 32, kb = r / nblk, nb = r % nblk, n0 = 32 * nb, drow0 = 256 * (n0 >> 7) + 128 * isup + (n0 & 127);
        d.src = W + (size_t)(64 * kb) * FF + n0; d.dst = WT + (size_t)drow0 * D + 64 * kb; d.K = D; d.scale = SW_GU; return true;
    } else {
        const int mm = m < 6 ? m - 4 : m - 38;
        const float* W = (m < 6 ? P->in[15] : P->in[19]) + (size_t)mm * FF * D; unsigned char* WT = (m < 6 ? dn8d : dn8m) + (size_t)mm * D * FF;
        const int nblk = D / 32, kb = r / nblk, nb = r % nblk, n0 = 32 * nb;
        d.src = W + (size_t)(64 * kb) * D + n0; d.dst = WT + (size_t)n0 * FF + 64 * kb; d.K = FF; d.scale = SW_DN; return false;
    }
}
constexpr int CONV_TILE = 8 * (256 + 8) * 4;
__device__ __forceinline__ void conv_dma_issue(const ConvD& d, bool pitch_ff, int lane, LAS unsigned char* tile) {
    const unsigned ld = pitch_ff ? FF : D;
    const unsigned voff = ((unsigned)(lane >> 3) * ld + (unsigned)(lane & 7) * 4u) * 4u;
    const char* sb = (const char*)d.src;
#pragma unroll
    for (int t = 0; t < 8; ++t) { __builtin_amdgcn_global_load_lds((const unsigned*)(sb + voff), (LAS unsigned*)(tile + t * 1056), 16, 0, 0); sb += (size_t)ld * 32; }
}
__device__ __forceinline__ void conv_dma_finish(const ConvD& d, const LAS unsigned char* tile, int lane) {
    const int c = lane & 7; const float scale = d.scale;
#pragma unroll
    for (int j = 0; j < 4; ++j) { const int n = (lane >> 3) + 8 * j; const LAS float* s = (const LAS float*)tile + c * 264 + n;
        u32x2 o; o.x = pg8::cvt4_fp8(s[0 * 32] * scale, s[1 * 32] * scale, s[2 * 32] * scale, s[3 * 32] * scale); o.y = pg8::cvt4_fp8(s[4 * 32] * scale, s[5 * 32] * scale, s[6 * 32] * scale, s[7 * 32] * scale);
        *(u32x2*)(d.dst + (size_t)n * d.K + 8 * c) = o; }
    asm volatile("s_waitcnt lgkmcnt(0)" ::: "memory");
}
template <class MOf>
__device__ __forceinline__ void conv_stream(const Ctx& C, KArgP P, int first, int stride, int count, MOf m_of, int scr_pitch = 8448) {
    LAS float* scr = (LAS float*)(C.lds + C.wave * scr_pitch);
    int it = first; if (it >= count) return;
    ConvD da, db; float va[32], vb[32];
#define CONV_LOAD(d, v, i_) do { const bool g_ = conv_desc(C, P, m_of((i_) / 1792), (i_) % 1792, d); if (g_) conv_ld32<FF>(d.src, C.lane, v); else conv_ld32<D>(d.src, C.lane, v); } while (0)
    CONV_LOAD(da, va, it);
    for (;;) {
        const bool hb = it + stride < count;
        if (hb) CONV_LOAD(db, vb, it + stride);
        conv_st8(da, va, scr, C.lane);
        if (!hb) break;
        it += 2 * stride; const bool ha = it < count;
        if (ha) CONV_LOAD(da, va, it);
        conv_st8(db, vb, scr, C.lane);
        if (!ha) break;
    }
#undef CONV_LOAD
}
constexpr int CONV_IB = 1792;
__device__ __forceinline__ void conv_pair(const Ctx& C, KArgP P, int j) {
    conv_stream(C, P, C.gw, C.ngw, 27 * CONV_IB, [j](int q) { return q < 3 ? 2 * q + j : q < 11 ? 6 + 8 * j + (q - 3) : q < 19 ? 22 + 8 * j + (q - 11) : 38 + 8 * j + (q - 19); });
}
__device__ __forceinline__ void prologue_phase(const Ctx& C, KArgP P) {
    LAS float* scr = (LAS float*)(C.lds + C.wave * 8448);
    constexpr int IB = CONV_IB;
    constexpr int N_BIG = CONV_IN_PROLOGUE ? 54 * IB : 0;
    constexpr int I_DIN = 16 * 84, I_SQ = 16 * 32, I_MIN = 16 * 96;
    constexpr int N_SMALL = 2 * (I_DIN + I_SQ + I_MIN + I_SQ);
    if (N_BIG) conv_stream(C, P, C.gw, C.ngw, N_BIG, [](int q) { return q; });
    for (int it = C.gw; it < N_SMALL; it += C.ngw) {
        {
            int r = it;
            const int j = r / (N_SMALL / 2); r -= j * (N_SMALL / 2);
            if (r < I_DIN) { if (FP8_DSA_IN) conv_plain8(P->in[4] + (size_t)j * D * DSA_LDW, D, 2688, DSA_LDW, (unsigned char*)C.wdsa_in + (size_t)j * DSA_NP * D, r, scr, C.lane, SW_DIN);
                             else conv_plain(P->in[4] + (size_t)j * D * DSA_LDW, D, 2688, DSA_LDW, C.wdsa_in + (size_t)j * DSA_NP * D, r, scr, C.lane); continue; } r -= I_DIN;
            if (r < I_SQ) { if (FP8_DSA) conv_plain8(P->in[7] + (size_t)j * D * D, D, D, D, (unsigned char*)C.wdsa_out + (size_t)j * D * D, r, scr, C.lane, SW_DOUT);
                            else conv_plain(P->in[7] + (size_t)j * D * D, D, D, D, C.wdsa_out + (size_t)j * D * D, r, scr, C.lane); continue; } r -= I_SQ;
            if (r < I_MIN) { conv_plain(P->in[8] + (size_t)j * D * ML_LDW, D, ML_NP, ML_LDW, C.wml_in + (size_t)j * ML_NP * D, r, scr, C.lane); continue; } r -= I_MIN;
            conv_plain(P->in[12] + (size_t)j * D * D, D, D, D, C.wml_out + (size_t)j * D * D, r, scr, C.lane);
        }
    }
    const int gt = C.bid * NTHREADS + C.tid, ngt = C.G * NTHREADS;
    for (int i = gt; i < 2 * 128 * D / 8; i += ngt) { const int j = i / (128 * D / 8), o = i % (128 * D / 8);
        if (FP8_DSA_IN) { if (o < 128 * D / 16) *(u32x4*)((unsigned char*)C.wdsa_in + (size_t)j * DSA_NP * D + (size_t)2688 * D + (size_t)o * 16) = (u32x4){0u, 0u, 0u, 0u}; }
        else *(u32x4*)(C.wdsa_in + (size_t)j * DSA_NP * D + (size_t)2688 * D + (size_t)o * 8) = (u32x4){0u, 0u, 0u, 0u}; }
    for (int i = gt; i < (MP - NT) * D / 8; i += ngt) *(u32x4*)(C.XN + (size_t)NT * D + (size_t)i * 8) = (u32x4){0u, 0u, 0u, 0u};
    const float* x = P->in[0]; const float* meta = P->in[1];
    for (int i = gt; i < MP * (D / 4); i += ngt) { const int row = i / (D / 4), c4 = i % (D / 4); f32x4 v = (f32x4){0.f, 0.f, 0.f, 0.f};
        if (row < NT) { const int b = row / SL, p = row % SL;
            v = (p < NMETA) ? *(const f32x4*)(meta + (size_t)p * D + c4 * 4) : *(const f32x4*)(x + ((size_t)b * SEQ + (p - NMETA)) * D + c4 * 4); }
#if H_BF16
        u32x2 hv; hv.x = pk2(v[0], v[1]); hv.y = pk2(v[2], v[3]); *(u32x2*)(C.H + (size_t)row * D + c4 * 4) = hv; }
#else
        *(f32x4*)(C.H + (size_t)row * D + c4 * 4) = v; }
#endif
    for (int i = gt; i < SL * 64; i += ngt) { const int pos = i >> 6, k = i & 63; double inv = 1.0;
        for (int q = 0; q < k; ++q) inv *= 0.86596432336006535;
        const double a = (double)pos * inv; C.rope[i] = make_float2((float)cos(a), (float)sin(a)); }
}

template <int MODE, bool ADDY, bool OUT8 = false>
__device__ __forceinline__ void norm_phase(const Ctx& C, const float* gain, const float* W8, int ldw, int moe_layer, const float* aux0 = nullptr, const float* aux1 = nullptr) {
    const bf16* Y0 = (const bf16*)(C.R + R_Y0); const bf16* Y1 = (const bf16*)(C.R + R_Y1);
    const int lane = C.lane;
    float w8r[4][4][8];
    if (MODE != 3) {
#pragma unroll
        for (int j = 0; j < 4; ++j)
#pragma unroll
            for (int i = 0; i < 4; ++i) { const float* wp = W8 + (size_t)(256 * j + 4 * lane + i) * ldw; const f32x4 w0 = *(const f32x4*)wp, w1 = *(const f32x4*)(wp + 4);
                w8r[j][i][0] = w0[0]; w8r[j][i][1] = w0[1]; w8r[j][i][2] = w0[2]; w8r[j][i][3] = w0[3]; w8r[j][i][4] = w1[0]; w8r[j][i][5] = w1[1]; w8r[j][i][6] = w1[2]; w8r[j][i][7] = w1[3]; }
    }
    f32x4 gv[4];
#pragma unroll
    for (int j = 0; j < 4; ++j) gv[j] = ((const f32x4*)gain)[64 * j + C.lane];
    int prow = -1, pe = 0, pr1 = 0, pr2 = 0; float pg1 = 0.f;
#if H_BF16
    u32x2 hq[4], ya[4], yb[4];
#define NORM_ISSUE(row_) do { const HT* hr_ = C.H + (size_t)(row_) * D; _Pragma("unroll") for (int j = 0; j < 4; ++j) hq[j] = ((const u32x2*)hr_)[64 * j + C.lane]; \
        if (ADDY) { _Pragma("unroll") for (int j = 0; j < 4; ++j) { ya[j] = *(const u32x2*)(Y0 + (size_t)(row_) * D + 256 * j + 4 * C.lane); yb[j] = *(const u32x2*)(Y1 + (size_t)(row_) * D + 256 * j + 4 * C.lane); } } } while (0)
    if (C.gw < NT) NORM_ISSUE(C.gw);
#endif
    for (int row = C.gw; row < NT; row += C.ngw) {
        HT* hrow = C.H + (size_t)row * D;
        f32x4 v[4]; float ss = 0.f;
#if H_BF16
#pragma unroll
        for (int j = 0; j < 4; ++j) { v[j][0] = bflo(hq[j].x); v[j][1] = bfhi(hq[j].x); v[j][2] = bflo(hq[j].y); v[j][3] = bfhi(hq[j].y); }
        if (ADDY) {
#pragma unroll
            for (int j = 0; j < 4; ++j) { const u32x2 a = ya[j], b = yb[j];
                v[j][0] += bflo(a.x) + bflo(b.x); v[j][1] += bfhi(a.x) + bfhi(b.x); v[j][2] += bflo(a.y) + bflo(b.y); v[j][3] += bfhi(a.y) + bfhi(b.y);
                { u32x2 hv; hv.x = pk2(v[j][0], v[j][1]); hv.y = pk2(v[j][2], v[j][3]); ((u32x2*)hrow)[64 * j + C.lane] = hv; } }
        }
        if (row + C.ngw < NT) NORM_ISSUE(row + C.ngw);
#else
#pragma unroll
        for (int j = 0; j < 4; ++j) v[j] = ((const f32x4*)hrow)[64 * j + C.lane];
        if (ADDY) {
#pragma unroll
            for (int j = 0; j < 4; ++j) { const u32x2 a = *(const u32x2*)(Y0 + (size_t)row * D + 256 * j + 4 * C.lane), b = *(const u32x2*)(Y1 + (size_t)row * D + 256 * j + 4 * C.lane);
                v[j][0] += bflo(a.x) + bflo(b.x); v[j][1] += bfhi(a.x) + bfhi(b.x); v[j][2] += bflo(a.y) + bflo(b.y); v[j][3] += bfhi(a.y) + bfhi(b.y);
                ((f32x4*)hrow)[64 * j + C.lane] = v[j]; }
        }
#endif
#pragma unroll
        for (int j = 0; j < 4; ++j) ss += (v[j][0] * v[j][0] + v[j][1] * v[j][1]) + (v[j][2] * v[j][2] + v[j][3] * v[j][3]);
        const float rstd = 1.0f / sqrtf(wave_sum(ss) * (1.0f / D) + RMS_EPS);
#pragma unroll
        for (int j = 0; j < 4; ++j) { const f32x4 g = gv[j]; v[j] = v[j] * rstd * g;
            if (OUT8) *(unsigned*)(C.xn8 + (size_t)row * D + 256 * j + 4 * C.lane) = pg8::cvt4_fp8(v[j][0], v[j][1], v[j][2], v[j][3]);
            else { u32x2 o; o.x = pk2(v[j][0], v[j][1]); o.y = pk2(v[j][2], v[j][3]); *(u32x2*)(C.XN + (size_t)row * D + 256 * j + 4 * C.lane) = o; } }
        if (MODE != 3) {
            float dot[8];
#pragma unroll
            for (int e = 0; e < 8; ++e) dot[e] = 0.f;
#pragma unroll
            for (int j = 0; j < 4; ++j)
#pragma unroll
                for (int i = 0; i < 4; ++i) { const float y = v[j][i];
#pragma unroll
                    for (int e = 0; e < 8; ++e) dot[e] = fmaf(y, w8r[j][i][e], dot[e]); }
            float r4[4], r2[2], r1;
#pragma unroll
            for (int k = 0; k < 4; ++k) { const float send = (lane & 1) ? dot[k] : dot[4 + k], keep = (lane & 1) ? dot[4 + k] : dot[k]; r4[k] = keep + __shfl_xor(send, 1); }
#pragma unroll
            for (int k = 0; k < 2; ++k) { const float send = (lane & 2) ? r4[k] : r4[2 + k], keep = (lane & 2) ? r4[2 + k] : r4[k]; r2[k] = keep + __shfl_xor(send, 2); }
            { const float send = (lane & 4) ? r2[0] : r2[1], keep = (lane & 4) ? r2[1] : r2[0]; r1 = keep + __shfl_xor(send, 4); }
            r1 += __shfl_xor(r1, 8); r1 += __shfl_xor(r1, 16); r1 += __shfl_xor(r1, 32);
            const int ev = 4 * (lane & 1) + 2 * ((lane >> 1) & 1) + ((lane >> 2) & 1);
            if (MODE == 0) { if (lane < 8) C.sm8[(size_t)row * 8 + ev] = r1 * 0.03125f; }
            if (MODE == 1) {
                if (lane < 8) { const int b = row / SL, pos = row % SL, sl_ = pos / 65, si = pos % 65, h = ev & 3;
                    const float z = (r1 + (ev < 4 ? aux0[h] : aux1[h])) * (2.0f / 15.0f);
                    const float x = 15.0f * (1.0f - 2.0f / (1.0f + __expf(z)));
                    float* dst = (ev < 4 ? C.mli : C.mlg) + ((b * 4 + h) * 65 + si) * 64 + sl_;
                    *dst = (ev < 4) ? x : fminf(x, 0.f) - __logf(1.0f + __expf(-fabsf(x))); } }
            if (MODE == 2) {
#pragma unroll
                for (int e = 0; e < 8; ++e) dot[e] = __shfl(r1, (e >> 2) + 2 * ((e >> 1) & 1) + 4 * (e & 1));
                if (lane == 0) {
                    float v1 = dot[0]; int e1 = 0;
#pragma unroll
                    for (int e = 1; e < 8; ++e) if (dot[e] > v1) { v1 = dot[e]; e1 = e; }
                    float v2 = -INFINITY; int e2 = 0;
#pragma unroll
                    for (int e = 0; e < 8; ++e) if (e != e1 && dot[e] > v2) { v2 = dot[e]; e2 = e; }
                    const float g1 = 1.0f / (1.0f + expf(v2 - v1));
                    const int r1i = (int)atomicAdd(C.ctl + CW_CNT + (moe_layer * 8 + e1) * 64, 1u), r2i = (int)atomicAdd(C.ctl + CW_CNT + (moe_layer * 8 + e2) * 64, 1u);
                    if (prow >= 0) { C.route_e[prow] = pe; C.route_r1[prow] = pr1; C.route_r2[prow] = pr2; C.route_g1[prow] = pg1; }
                    prow = row; pe = e1 | (e2 << 8); pr1 = r1i; pr2 = r2i; pg1 = g1;
                }
            }
        }
    }
    if (MODE == 2) { if (lane == 0 && prow >= 0) { C.route_e[prow] = pe; C.route_r1[prow] = pr1; C.route_r2[prow] = pr2; C.route_g1[prow] = pg1; } }
#if H_BF16
#undef NORM_ISSUE
#endif
}

__device__ __forceinline__ void unpack8(const u32x4 w, float (&x)[8]) { x[0] = bflo(w.x); x[1] = bfhi(w.x); x[2] = bflo(w.y); x[3] = bfhi(w.y); x[4] = bflo(w.z); x[5] = bfhi(w.z); x[6] = bflo(w.w); x[7] = bfhi(w.w); }
__device__ __forceinline__ u32x4 pack8(const float (&x)[8]) { u32x4 w; w.x = pk2(x[0], x[1]); w.y = pk2(x[2], x[3]); w.z = pk2(x[4], x[5]); w.w = pk2(x[6], x[7]); return w; }
__device__ __forceinline__ void dsa_post_phase(const Ctx& C, const float* gq, const float* gk) {
    bf16* PROJ = (bf16*)(C.R + R_PROJ);
    for (int row = C.gw; row < NT; row += C.ngw) {
        const int pos = row % SL; bf16* pr = PROJ + (size_t)row * DSA_NP; const float2* rp = C.rope + (size_t)pos * 64;
        const int lane = C.lane;
#pragma unroll
        for (int pass = 0; pass < 2; ++pass) {
            if (pass == 1 && lane >= 16) break;
            const int head = lane >> 2, part = lane & 3; bf16* hp = pr + (pass == 0 ? DQ0 : DK0) + head * 64 + 8 * part; const float* gg = pass == 0 ? gq : gk;
            float x1[8], x2[8]; unpack8(*(const u32x4*)hp, x1); unpack8(*(const u32x4*)(hp + 32), x2);
            float ss = 0.f;
#pragma unroll
            for (int e = 0; e < 8; ++e) ss += x1[e] * x1[e] + x2[e] * x2[e];
            ss += __shfl_xor(ss, 1); ss += __shfl_xor(ss, 2);
            const float rstd = 1.0f / sqrtf(ss * (1.0f / 64.0f) + RMS_EPS), osc = pass == 0 ? 0.125f : 1.0f;
#pragma unroll
            for (int e = 0; e < 8; ++e) { const int i = 8 * part + e; const float2 cs = rp[2 * i];
                const float y1 = x1[e] * rstd * gg[i], y2 = x2[e] * rstd * gg[i + 32];
                x1[e] = (y1 * cs.x - y2 * cs.y) * osc; x2[e] = (y2 * cs.x + y1 * cs.y) * osc; }
            *(u32x4*)hp = pack8(x1); *(u32x4*)(hp + 32) = pack8(x2);
        }
#pragma unroll
        for (int pass = 0; pass < 2; ++pass) {
            if (pass == 1 && lane >= 8) break;
            const int head = lane >> 3, part = lane & 7; bf16* hp = pr + (pass == 0 ? DIQ0 + head * 128 : DIK0) + 8 * part;
            float x1[8], x2[8]; unpack8(*(const u32x4*)hp, x1); unpack8(*(const u32x4*)(hp + 64), x2);
#pragma unroll
            for (int e = 0; e < 8; ++e) { const float2 cs = rp[8 * part + e]; const float y1 = x1[e], y2 = x2[e];
                x1[e] = y1 * cs.x - y2 * cs.y; x2[e] = y2 * cs.x + y1 * cs.y; }
            *(u32x4*)hp = pack8(x1); *(u32x4*)(hp + 64) = pack8(x2);
        }
    }
}
__device__ __forceinline__ void score_phase(const Ctx& C) {
    const bf16* PROJ = (const bf16*)(C.R + R_PROJ); float* SC = (float*)(C.R + R_SC);
    const int lane = C.lane, m31 = lane & 31, hi = lane >> 5, w = C.wave;
    const int aq = 2 * (m31 >> 4) + ((m31 >> 2) & 1), ah = 4 * ((m31 >> 3) & 1) + (m31 & 3);
    constexpr int SCP = 1088, SCB = 8 * SCP;
    LAS unsigned char* ring = C.lds;
    const LAS unsigned char* bfp = ring + (m31 >> 2) * SCP + 64 * hi + 16 * (m31 & 3);
    constexpr int TPB = 65 + 57 + 49 + 41 + 33 + 25 + 17 + 9 + 1;
    for (int t = C.bid; t < BATCH * TPB; t += C.G) {
        const int b = t / TPB, tt = t % TPB;
        const int kc = (tt >= 65) + (tt >= 122) + (tt >= 171) + (tt >= 212) + (tt >= 245) + (tt >= 270) + (tt >= 287) + (tt >= 296);
        const int toff = 65 * kc - 4 * kc * (kc - 1);
        const int qg = 64 * kc + 8 * (tt - toff) + w; const bool act = qg < 514;
        const int qgc = act ? qg : 513, q0 = 8 * qgc, k0 = 512 * kc;
        const int qlast = 64 * kc + 8 * (tt - toff) + 7, qmax = (qlast < 514 ? qlast : 513) * 8 + 8;
        const int kendw = (k0 + 512 < q0 + 8) ? k0 + 512 : q0 + 8;
        const int kendg = (k0 + 512 < qmax) ? k0 + 512 : qmax;
        const int nkt = (kendg - k0 + 31) >> 5, nktw = act ? (kendw - k0 + 31) >> 5 : 0;
        bf16x8 a[2][8]; f32x4 wv[2][4];
#pragma unroll
        for (int rb = 0; rb < 2; ++rb) {
            const bf16* ap = PROJ + (size_t)(b * SL + q0 + 4 * rb + aq) * DSA_NP + DIQ0 + ah * 128 + 8 * hi;
#pragma unroll
            for (int ks = 0; ks < 8; ++ks) a[rb][ks] = *(const bf16x8*)(ap + 16 * ks);
            const float* w0 = C.sm8 + (size_t)(b * SL + q0 + 4 * rb + hi) * 8; const float* w1 = w0 + 16;
            wv[rb][0] = *(const f32x4*)w0; wv[rb][1] = *(const f32x4*)(w0 + 4); wv[rb][2] = *(const f32x4*)w1; wv[rb][3] = *(const f32x4*)(w1 + 4);
        }
        float* sc0 = SC + (size_t)(b * SL + q0 + hi) * SCLD;
        const bf16* ikb = PROJ + (size_t)b * SL * DSA_NP + DIK0 + (lane >> 2) * 8;
        const int kr0 = k0 + 4 * w + (lane & 3);
#define SC_ISSUE(kt_) do { if ((kt_) < nkt) { const int key_ = kr0 + 32 * (kt_), kc_ = key_ < SL ? key_ : SL - 1; \
            __builtin_amdgcn_global_load_lds((const unsigned*)(ikb + (size_t)kc_ * DSA_NP), (LAS unsigned*)(ring + ((kt_) & 3) * SCB + w * SCP), 16, 0, 0); } } while (0)
        asm volatile("s_waitcnt vmcnt(0)" ::: "memory");
#pragma unroll
        for (int rb = 0; rb < 2; ++rb) {
#pragma unroll
            for (int ks = 0; ks < 8; ++ks) asm volatile("" : "+v"(a[rb][ks]));
#pragma unroll
            for (int q = 0; q < 4; ++q) asm volatile("" : "+v"(wv[rb][q])); }
        __builtin_amdgcn_s_barrier();
        SC_ISSUE(0); SC_ISSUE(1); SC_ISSUE(2);
        float* dum = SC + (size_t)NT * SCLD + 4 * C.tid;
        for (int kt = 0; kt < nkt; ++kt) {
            { const int cnt = 4 * (kt < 3 ? kt : 3) + (kt + 1 < nkt) + (kt + 2 < nkt);
              switch (cnt) { case 0: asm volatile("s_waitcnt vmcnt(0)" ::: "memory"); break; case 1: asm volatile("s_waitcnt vmcnt(1)" ::: "memory"); break; case 2: asm volatile("s_waitcnt vmcnt(2)" ::: "memory"); break;
                case 4: asm volatile("s_waitcnt vmcnt(4)" ::: "memory"); break; case 5: asm volatile("s_waitcnt vmcnt(5)" ::: "memory"); break; case 6: asm volatile("s_waitcnt vmcnt(6)" ::: "memory"); break;
                case 8: asm volatile("s_waitcnt vmcnt(8)" ::: "memory"); break; case 9: asm volatile("s_waitcnt vmcnt(9)" ::: "memory"); break; case 10: asm volatile("s_waitcnt vmcnt(10)" ::: "memory"); break;
                case 12: asm volatile("s_waitcnt vmcnt(12)" ::: "memory"); break; case 13: asm volatile("s_waitcnt vmcnt(13)" ::: "memory"); break; default: asm volatile("s_waitcnt vmcnt(14)" ::: "memory"); break; } }
            __builtin_amdgcn_s_barrier();
            asm volatile("" ::: "memory");
            SC_ISSUE(kt + 3);
            asm volatile("" ::: "memory");
            const int key = k0 + 32 * kt + m31;
            float v00 = 0.f, v01 = 0.f, v10 = 0.f, v11 = 0.f;
            if (kt < nktw) {
                const LAS unsigned char* bp = bfp + (kt & 3) * SCB;
                bf16x8 bf_[8];
#pragma unroll
                for (int ks = 0; ks < 8; ++ks) bf_[ks] = *(const LAS bf16x8*)(bp + 128 * ks);
                asm volatile("s_waitcnt lgkmcnt(0)" ::: "memory");
                f32x16 acc0, acc1;
#pragma unroll
                for (int r = 0; r < 16; ++r) { acc0[r] = 0.f; acc1[r] = 0.f; }
#pragma unroll
                for (int ks = 0; ks < 8; ++ks) { acc0 = MFMA32(a[0][ks], bf_[ks], acc0); acc1 = MFMA32(a[1][ks], bf_[ks], acc1); }
#pragma unroll
                for (int e = 0; e < 8; ++e) { v00 = fmaf(fmaxf(acc0[e], 0.f), wv[0][e >> 2][e & 3], v00); v01 = fmaf(fmaxf(acc0[8 + e], 0.f), wv[0][2 + (e >> 2)][e & 3], v01);
                    v10 = fmaf(fmaxf(acc1[e], 0.f), wv[1][e >> 2][e & 3], v10); v11 = fmaf(fmaxf(acc1[8 + e], 0.f), wv[1][2 + (e >> 2)][e & 3], v11); }
            }
            const bool okst = kt < nktw && key < kendw;
            float* p0 = okst ? sc0 + key : dum; float* p1 = okst ? sc0 + (size_t)2 * SCLD + key : dum + 1; float* p2 = okst ? sc0 + (size_t)4 * SCLD + key : dum + 2; float* p3 = okst ? sc0 + (size_t)6 * SCLD + key : dum + 3;
            asm volatile("" ::: "memory");
            __builtin_nontemporal_store(v00, p0); __builtin_nontemporal_store(v01, p1); __builtin_nontemporal_store(v10, p2); __builtin_nontemporal_store(v11, p3);
            asm volatile("" ::: "memory");
        }
#undef SC_ISSUE
    }
}

template <int NR>
__device__ __forceinline__ void topk_keys(const float* sr, unsigned (&k)[NR], int n, int lane) {
    float v[NR];
#pragma unroll
    for (int j = 0; j < NR; ++j) { const int idx = 64 * j + lane; v[j] = __builtin_nontemporal_load(sr + (idx < n ? idx : n - 1)); }
#pragma unroll
    for (int j = 0; j < NR; ++j) { const int idx = 64 * j + lane; const unsigned u = __float_as_uint(v[j] + 0.0f); const unsigned key = (u & 0x80000000u) ? ~u : (u | 0x80000000u);
        k[j] = idx < n ? key : 0u; }
}
constexpr int TOPK_MID_BIT = -1, TOPK_MID_NR = 40;
template <int NR, class Mid>
__device__ __forceinline__ void topk_select(const unsigned (&k)[NR], unsigned short* sel, int lane, Mid mid) {
    unsigned T = 0u; bool exact = false;
    for (int bit = 31; bit >= 0; --bit) {
        if (bit == TOPK_MID_BIT) mid();
        const unsigned cand = T | (1u << bit); int cl = 0;
#define TK_CA(n_) "v_cmp_ge_u32 vcc, %" #n_ ", %1\n\tv_addc_co_u32 %0, vcc, 0, %0, vcc\n\t"
#pragma unroll
        for (int j = 0; j + 8 <= NR; j += 8)
            asm(TK_CA(2) TK_CA(3) TK_CA(4) TK_CA(5) TK_CA(6) TK_CA(7) TK_CA(8) TK_CA(9) : "+v"(cl) : "v"(cand), "v"(k[j]), "v"(k[j + 1]), "v"(k[j + 2]), "v"(k[j + 3]), "v"(k[j + 4]), "v"(k[j + 5]), "v"(k[j + 6]), "v"(k[j + 7]) : "vcc");
#pragma unroll
        for (int j = NR & ~7; j < NR; ++j) asm("v_cmp_ge_u32 vcc, %1, %2\n\tv_addc_co_u32 %0, vcc, 0, %0, vcc" : "+v"(cl) : "v"(k[j]), "v"(cand) : "vcc");
#undef TK_CA
        int cnt = 0;
#pragma unroll
        for (int bb = 0; bb < 7; ++bb) cnt += __popcll(__ballot((cl >> bb) & 1)) << bb;
        if (cnt >= 256) { T = cand; if (cnt == 256) { exact = true; break; } }
    }
    int base = 0;
#pragma unroll
    for (int j = 0; j < NR; ++j) { const bool f = exact ? (k[j] >= T) : (k[j] > T); const unsigned long long mk = __ballot(f);
        if (f) sel[base + __builtin_amdgcn_mbcnt_hi((unsigned)(mk >> 32), __builtin_amdgcn_mbcnt_lo((unsigned)mk, 0u))] = (unsigned short)(64 * j + lane);
        base += __popcll(mk); }
    if (!exact) {
#pragma unroll
        for (int j = 0; j < NR; ++j) { const bool f = (k[j] == T); const unsigned long long mk = __ballot(f);
            const int p = base + (int)__builtin_amdgcn_mbcnt_hi((unsigned)(mk >> 32), __builtin_amdgcn_mbcnt_lo((unsigned)mk, 0u));
            if (f && p < 256) sel[p] = (unsigned short)(64 * j + lane);
            base += __popcll(mk); }
    }
}
__device__ __forceinline__ int conv_m_of(int q, int j) { return q < 3 ? 2 * q + j : q < 11 ? 6 + 8 * j + (q - 3) : q < 19 ? 22 + 8 * j + (q - 11) : 38 + 8 * j + (q - 19); }
template <bool CONV>
__device__ __forceinline__ void topk_phase_t(const Ctx& C, KArgP P, int j) {
    const float* SC = (const float*)(C.R + R_SC);
    LAS unsigned char* tile0 = C.lds + C.wave * (2 * CONV_TILE); LAS unsigned char* tile1 = tile0 + CONV_TILE;
    constexpr int pcount = CONV ? 27 * (CONV_IB / 2) : 0;
    int cit = C.gw; const int cs = C.ngw; bool pend = false;
    auto pair_desc = [&](int p, ConvD& d0, ConvD& d1) -> bool { const int m = conv_m_of(p / (CONV_IB / 2), j), rp = p % (CONV_IB / 2); const bool isdn = (m >= 4 && m < 6) || m >= 38;
        const int nblk = isdn ? D / 32 : FF / 32, kb2 = rp / nblk, nb = rp - kb2 * nblk, r0 = 2 * kb2 * nblk + nb;
        const bool g = conv_desc(C, P, m, r0, d0); conv_desc(C, P, m, r0 + nblk, d1); return g; };
    auto issue = [&](int lane) { if (CONV && cit < pcount) { ConvD d0, d1; const bool g = pair_desc(cit, d0, d1); conv_dma_issue(d0, g, lane, tile0); conv_dma_issue(d1, g, lane, tile1); pend = true; } };
    auto finish = [&](int lane) { if (CONV && pend) { ConvD d0, d1; pair_desc(cit, d0, d1);
                                      asm volatile("s_waitcnt vmcnt(0)" ::: "memory"); conv_dma_finish(d0, tile0, lane); conv_dma_finish(d1, tile1, lane); cit += cs; pend = false; } };
    for (int rr = C.gw; rr < NT; rr += C.ngw) { const int row = NT - 1 - rr;
        int lane = C.lane; asm volatile("" : "+v"(lane));
        const int pos = row % SL, n = pos + 1;
        unsigned short* sel = C.sel + (size_t)row * 256;
        if (n <= 256) {
            u32x2 o; o.x = (unsigned)(4 * lane) | ((unsigned)(4 * lane + 1) << 16); o.y = (unsigned)(4 * lane + 2) | ((unsigned)(4 * lane + 3) << 16);
            *(u32x2*)(sel + 4 * lane) = o;
            continue;
        }
        const float* sr = SC + (size_t)row * SCLD;
        const int nr8 = (n + 511) >> 9;
#define TOPK_CASE(NR) { unsigned k[NR]; topk_keys<NR>(sr, k, n, lane); _Pragma("unroll") for (int q_ = 0; q_ < NR; ++q_) asm volatile("" : "+v"(k[q_]) :: "memory");   \
            issue(lane); topk_select<NR>(k, sel, lane, [&]() { if (NR >= TOPK_MID_NR) { finish(lane); issue(lane); } }); }
        switch (nr8) {
            case 1: TOPK_CASE(8) break;   case 2: TOPK_CASE(16) break; case 3: TOPK_CASE(24) break;
            case 4: TOPK_CASE(32) break;  case 5: TOPK_CASE(40) break; case 6: TOPK_CASE(48) break;
            case 7: TOPK_CASE(56) break;  case 8: TOPK_CASE(64) break; default: TOPK_CASE(65) break;
        }
#undef TOPK_CASE
        finish(lane);
    }
    while (CONV && cit < pcount) { int lane = C.lane; asm volatile("" : "+v"(lane)); issue(lane); finish(lane); }
}
__device__ __forceinline__ void topk_phase(const Ctx& C, KArgP P, int j) {
    if (CONV_IN_PROLOGUE) topk_phase_t<false>(C, P, j); else topk_phase_t<true>(C, P, j);
}

constexpr int ATT_VROW = 544, ATT_WAVE_LDS = 32 * ATT_VROW + 512;
__device__ __forceinline__ s16x4 tr16(const LAS unsigned char* p) { return __builtin_bit_cast(s16x4, __builtin_amdgcn_ds_read_tr16_b64_v4i16((LAS s16x4*)p)); }
constexpr int AT_PITCH = 1088, AT_BUF = 8 * AT_PITCH;
template <bool OUT8>
__device__ __forceinline__ void attn2b_phase(const Ctx& C, bf16* OUT) {
    const bf16* PROJ = (const bf16*)(C.R + R_PROJ);
    const int lane = C.lane, n15 = lane & 15, kq = lane >> 4, g = n15 >> 2, oo = lane & 1, chh = lane >> 1;
    LAS unsigned char* wb = C.lds + C.wave * ATT_WAVE_LDS;
    LAS unsigned short* selE = (LAS unsigned short*)(wb + 2 * AT_BUF); LAS unsigned short* selO = selE + 128;
    static_assert(2 * AT_BUF + 512 <= ATT_WAVE_LDS, "attention LDS");
    int b0, nbat, wv, nwv;
    if ((C.G & 7) == 0) { b0 = (C.bid & 7) >> 1; nbat = 1; wv = ((C.bid >> 3) * 2 + (C.bid & 1)) * NWAVES + C.wave; nwv = (C.G >> 2) * NWAVES; }
    else { b0 = 0; nbat = BATCH; wv = C.gw; nwv = C.ngw; }
    for (int bi = 0; bi < nbat; ++bi) { const int b = b0 + bi;
    for (int pos = wv; pos < SL; pos += nwv) {
        const int row = b * SL + pos, nk = pos + 1 < 256 ? pos + 1 : 256, ng = (nk + 15) >> 4, ntile = 2 * ng;
        const bf16* kvb = PROJ + (size_t)b * SL * DSA_NP;
        { const u32x2 sv = *(const u32x2*)(C.sel + (size_t)row * 256 + 4 * lane);
          const unsigned s0 = (4 * lane < nk) ? (sv.x & 0xffffu) : 0u, s1 = (4 * lane + 1 < nk) ? (sv.x >> 16) : 0u, s2 = (4 * lane + 2 < nk) ? (sv.y & 0xffffu) : 0u, s3 = (4 * lane + 3 < nk) ? (sv.y >> 16) : 0u;
          asm volatile("" ::: "memory");
          selE[2 * lane] = (unsigned short)s0; selE[2 * lane + 1] = (unsigned short)s2; selO[2 * lane] = (unsigned short)s1; selO[2 * lane + 1] = (unsigned short)s3; }
        bf16x8 qf[8];
        { const bf16* qp = PROJ + (size_t)row * DSA_NP + DQ0 + n15 * 64 + 8 * kq; const bf16x8 q0 = *(const bf16x8*)qp, q1 = *(const bf16x8*)(qp + 32);
          const bf16x8 z = (bf16x8){0, 0, 0, 0, 0, 0, 0, 0};
#pragma unroll
          for (int ks = 0; ks < 8; ++ks) qf[ks] = ((ks >> 1) == g) ? ((ks & 1) ? q1 : q0) : z; }
        asm volatile("s_waitcnt vmcnt(0) lgkmcnt(0)" ::: "memory");
#pragma unroll
        for (int ks = 0; ks < 8; ++ks) asm volatile("" : "+v"(qf[ks]));
#define AT_ISSUE(i_, bo_) do { const int ii_ = (i_); const int gi_ = ii_ < ng ? ii_ : ii_ - ng; const int c0_ = ii_ < ng ? DK0 : DV0; \
            const u32x4 k8_ = *(const LAS u32x4*)((oo ? selO : selE) + 8 * gi_); const bf16* gb_ = kvb + c0_ + chh * 8; LAS unsigned char* db_ = wb + (bo_); \
            __builtin_amdgcn_global_load_lds((const unsigned*)(gb_ + (size_t)(k8_.x & 0xffffu) * DSA_NP), (LAS unsigned*)(db_ + 0 * AT_PITCH), 16, 0, 0); \
            __builtin_amdgcn_global_load_lds((const unsigned*)(gb_ + (size_t)(k8_.x >> 16) * DSA_NP), (LAS unsigned*)(db_ + 1 * AT_PITCH), 16, 0, 0); \
            __builtin_amdgcn_global_load_lds((const unsigned*)(gb_ + (size_t)(k8_.y & 0xffffu) * DSA_NP), (LAS unsigned*)(db_ + 2 * AT_PITCH), 16, 0, 0); \
            __builtin_amdgcn_global_load_lds((const unsigned*)(gb_ + (size_t)(k8_.y >> 16) * DSA_NP), (LAS unsigned*)(db_ + 3 * AT_PITCH), 16, 0, 0); \
            __builtin_amdgcn_global_load_lds((const unsigned*)(gb_ + (size_t)(k8_.z & 0xffffu) * DSA_NP), (LAS unsigned*)(db_ + 4 * AT_PITCH), 16, 0, 0); \
            __builtin_amdgcn_global_load_lds((const unsigned*)(gb_ + (size_t)(k8_.z >> 16) * DSA_NP), (LAS unsigned*)(db_ + 5 * AT_PITCH), 16, 0, 0); \
            __builtin_amdgcn_global_load_lds((const unsigned*)(gb_ + (size_t)(k8_.w & 0xffffu) * DSA_NP), (LAS unsigned*)(db_ + 6 * AT_PITCH), 16, 0, 0); \
            __builtin_amdgcn_global_load_lds((const unsigned*)(gb_ + (size_t)(k8_.w >> 16) * DSA_NP), (LAS unsigned*)(db_ + 7 * AT_PITCH), 16, 0, 0); } while (0)
#define AT_WAIT(i_) do { if ((i_) + 1 < ntile) asm volatile("s_waitcnt vmcnt(8)" ::: "memory"); else asm volatile("s_waitcnt vmcnt(0)" ::: "memory"); } while (0)
        AT_ISSUE(0, 0); AT_ISSUE(1, AT_BUF);
        f32x4 lg[16];
        const LAS unsigned char* kfp = wb + (n15 >> 1) * AT_PITCH + 32 * kq + 16 * (n15 & 1);
#pragma unroll
        for (int G = 0; G < 16; ++G) {
            f32x4 acc = (f32x4){0.f, 0.f, 0.f, 0.f};
            if (G < ng) {
                AT_WAIT(G);
                bf16x8 af[8];
#pragma unroll
                for (int ks = 0; ks < 8; ++ks) af[ks] = *(const LAS bf16x8*)(kfp + (G & 1) * AT_BUF + 128 * ks);
                asm volatile("s_waitcnt lgkmcnt(0)" ::: "memory");
                if (G + 2 < ntile) AT_ISSUE(G + 2, (G & 1) * AT_BUF);
#pragma unroll
                for (int ks = 0; ks < 8; ++ks) acc = MFMA16(af[ks], qf[ks], acc);
            }
#pragma unroll
            for (int i = 0; i < 4; ++i) lg[G][i] = (16 * G + 4 * kq + i < nk) ? acc[i] : -INFINITY;
        }
        float mx = -INFINITY;
#pragma unroll
        for (int G = 0; G < 16; ++G) mx = fmaxf(fmaxf(fmaxf(lg[G][0], lg[G][1]), fmaxf(lg[G][2], lg[G][3])), mx);
        mx = fmaxf(mx, __shfl_xor(mx, 16)); mx = fmaxf(mx, __shfl_xor(mx, 32));
        float sum = 0.f;
#pragma unroll
        for (int G = 0; G < 16; ++G)
#pragma unroll
            for (int i = 0; i < 4; ++i) { const float p = __expf(lg[G][i] - mx); lg[G][i] = p; sum += p; }
        sum += __shfl_xor(sum, 16); sum += __shfl_xor(sum, 32);
        f32x4 O[16];
#pragma unroll
        for (int nb = 0; nb < 16; ++nb) O[nb] = (f32x4){0.f, 0.f, 0.f, 0.f};
        const int vr = 4 * kq + (n15 >> 2);
        const LAS unsigned char* vfp = wb + (vr >> 1) * AT_PITCH + 16 * (vr & 1) + 32 * ((lane & 3) >> 1) + 8 * (lane & 1);
#pragma unroll
        for (int G = 0; G < 16; ++G) {
            if (G < ng) {
                const int ti = ng + G, bo = (ti & 1) * AT_BUF;
                AT_WAIT(ti);
                u32x2 pw; pw.x = pk2(lg[G][0], lg[G][1]); pw.y = pk2(lg[G][2], lg[G][3]);
                const s16x4 pa = __builtin_bit_cast(s16x4, pw);
                s16x4 vf[16];
#pragma unroll
                for (int nb = 0; nb < 16; ++nb) vf[nb] = tr16(vfp + bo + 64 * nb);
                asm volatile("s_waitcnt lgkmcnt(0)" ::: "memory");
                if (ti + 2 < ntile) AT_ISSUE(ti + 2, bo);
#pragma unroll
                for (int nb = 0; nb < 16; ++nb) O[nb] = __builtin_amdgcn_mfma_f32_16x16x16bf16_1k(pa, vf[nb], O[nb], 0, 0, 0);
            }
        }
#undef AT_ISSUE
#undef AT_WAIT
        bf16* orow = OUT + (size_t)row * D; unsigned char* orow8 = (unsigned char*)OUT + (size_t)row * D;
        float inv[4];
#pragma unroll
        for (int i = 0; i < 4; ++i) inv[i] = 1.0f / __shfl(sum, 4 * kq + i);
#pragma unroll
        for (int x = 0; x < 4; ++x) {
            const f32x4 o = (kq == 0) ? O[x] : (kq == 1) ? O[4 + x] : (kq == 2) ? O[8 + x] : O[12 + x];
#pragma unroll
            for (int i = 0; i < 4; ++i) { if (OUT8) orow8[(4 * kq + i) * 64 + 16 * x + n15] = (unsigned char)(pg8::cvt4_fp8(o[i] * inv[i] * SA_ATT, 0.f, 0.f, 0.f) & 0xffu);
                                          else orow[(4 * kq + i) * 64 + 16 * x + n15] = (bf16)(pk2(o[i] * inv[i], 0.f) & 0xffffu); }
        }
    } }
}
__device__ __forceinline__ int ml_start(int c) { return c == 0 ? 0 : 16 + 256 * (c - 1); }
__device__ __forceinline__ int ml_len(int c) { return c == 0 ? 16 : 256; }
template <bool ISMAX> __device__ __forceinline__ float wave_scan_incl(float v, int lane) {
#pragma unroll
    for (int d = 1; d < 64; d <<= 1) { const float t = __shfl_up(v, d); if (lane >= d) v = ISMAX ? fmaxf(v, t) : v + t; }
    return v; }
__device__ __forceinline__ void ml_scan_phase(const Ctx& C) {
    if (C.gw >= 16) return;
    const int bh = C.gw, lane = C.lane, p0 = 65 * lane;
    float* F = C.mlf + bh * SL; float* Cc = C.mlc + bh * SL; float* Pp = C.mlp + bh * SL;
    float li[65], lf[65];
#pragma unroll
    for (int i = 0; i < 65; ++i) { const bool ok = p0 + i < SL; li[i] = ok ? C.mli[(bh * 65 + i) * 64 + lane] : -INFINITY; lf[i] = ok ? C.mlg[(bh * 65 + i) * 64 + lane] : 0.f; }
    float s = 0.f;
#pragma unroll
    for (int i = 0; i < 65; ++i) s += lf[i];
    float run = wave_scan_incl<false>(s, lane) - s, mx = -INFINITY;
#pragma unroll
    for (int i = 0; i < 65; ++i) { run += lf[i]; lf[i] = run; li[i] = li[i] - run; mx = fmaxf(mx, li[i]); }
    const float inc = wave_scan_incl<true>(mx, lane); float pm = __shfl_up(inc, 1); if (lane == 0) pm = -INFINITY;
    LAS float* T = (LAS float*)(C.lds + C.wave * 16640);
#define ML_SCAN_OUT(dst_) do { asm volatile("s_waitcnt lgkmcnt(0)" ::: "memory"); \
        _Pragma("unroll") for (int t = 0; t < 65; ++t) { const float x_ = T[64 * t + lane]; if (64 * t + lane < SL) (dst_)[64 * t + lane] = x_; } \
        asm volatile("s_waitcnt lgkmcnt(0)" ::: "memory"); } while (0)
#pragma unroll
    for (int i = 0; i < 65; ++i) T[p0 + i] = lf[i];
    ML_SCAN_OUT(F);
#pragma unroll
    for (int i = 0; i < 65; ++i) T[p0 + i] = li[i];
    ML_SCAN_OUT(Cc);
#pragma unroll
    for (int i = 0; i < 65; ++i) { pm = fmaxf(pm, li[i]); T[p0 + i] = pm; }
    ML_SCAN_OUT(Pp);
#undef ML_SCAN_OUT
}
constexpr int TP = 40;
__device__ __forceinline__ void stage_T(const Ctx& C, LAS bf16* T, const bf16* src, int ld, int ncol, int row0tok, int s0, int nvalid, const float* cvals, float pend, float kscale) {
    const int nchunk = 32 * (ncol / 8);
    for (int id = C.tid; id < nchunk; id += NTHREADS) {
        const int s = id & 31, dc = id >> 5; const int sl_ = s0 + s; const bool ok = sl_ < nvalid; const int sc = ok ? sl_ : nvalid - 1;
        float x[8]; unpack8(*(const u32x4*)(src + (size_t)(row0tok + sc) * ld + 8 * dc), x);
        float w = ok ? 1.0f : 0.0f; if (cvals) w = ok ? __expf(cvals[sc] - pend) * kscale : 0.0f;
#pragma unroll
        for (int e = 0; e < 8; ++e) T[(8 * dc + e) * TP + s] = (bf16)(pk2(x[e] * w, 0.f) & 0xffffu);
    }
}
__device__ __forceinline__ void ml_dc_phase(const Ctx& C) {
    const bf16* PROJ = (const bf16*)(C.R + R_PROJ); float* DC = (float*)(C.R + R_DC);
    LAS bf16* KT = (LAS bf16*)C.lds; LAS bf16* VT = KT + 128 * TP;
    const int lane = C.lane, m31 = lane & 31, hi = lane >> 5, w = C.wave;
    for (int task = C.bid; task < 256; task += C.G) {
        const int bh = task >> 4, c = task & 15, b = bh >> 2, h = bh & 3, start = ml_start(c), n = ml_len(c), tok0 = b * SL + start;
        const float pend = C.mlp[bh * SL + start + n - 1];
        f32x16 acc[4];
#pragma unroll
        for (int nb = 0; nb < 4; ++nb)
#pragma unroll
            for (int r = 0; r < 16; ++r) acc[nb][r] = 0.f;
        float dn = 0.f;
        for (int s0 = 0; s0 < n; s0 += 32) {
            stage_T(C, KT, PROJ + MK0 + h * 128, ML_NP, 128, tok0, s0, n, C.mlc + bh * SL + start, pend, 0.08838834764831845f);
            stage_T(C, VT, PROJ + MV0 + h * 256, ML_NP, 256, tok0, s0, n, nullptr, 0.f, 1.f);
            __syncthreads();
#pragma unroll
            for (int ks = 0; ks < 2; ++ks) { const bf16x8 a = *(const LAS bf16x8*)(VT + (32 * w + m31) * TP + 16 * ks + 8 * hi);
#pragma unroll
                for (int nb = 0; nb < 4; ++nb) acc[nb] = MFMA32(a, *(const LAS bf16x8*)(KT + (32 * nb + m31) * TP + 16 * ks + 8 * hi), acc[nb]); }
            if (C.tid < 128) {
#pragma unroll
                for (int q = 0; q < 4; ++q) { float x[8]; unpack8(*(const LAS u32x4*)(KT + C.tid * TP + 8 * q), x);
#pragma unroll
                    for (int e = 0; e < 8; ++e) dn += x[e]; } }
            __syncthreads();
        }
        float* dc = DC + (size_t)(bh * 16 + c) * 256 * 128;
#pragma unroll
        for (int nb = 0; nb < 4; ++nb)
#pragma unroll
            for (int r = 0; r < 16; ++r) dc[(size_t)(32 * w + crow(r, hi)) * 128 + 32 * nb + m31] = acc[nb][r];
        if (C.tid < 128) C.dn[(bh * 16 + c) * 128 + C.tid] = dn;
    }
}
__device__ __forceinline__ void ml_state_phase(const Ctx& C) {
    const float* DC = (const float*)(C.R + R_DC); bf16* CH = (bf16*)(C.R + R_CH);
    const int gt = C.bid * NTHREADS + C.tid, ngt = C.G * NTHREADS;
    for (int i = gt; i < 16 * 8192 + 16 * 128; i += ngt) {
        const bool isn = i >= 16 * 8192; const int ii = isn ? i - 16 * 8192 : i; const int bh = isn ? ii >> 7 : ii >> 13, off = isn ? (ii & 127) : 4 * (ii & 8191);
        f32x4 st = (f32x4){0.f, 0.f, 0.f, 0.f}; float pprev = 0.f;
        for (int c = 0; c < 16; ++c) {
            const float pend = C.mlp[bh * SL + ml_start(c) + ml_len(c) - 1];
            const float decay = (c == 0) ? 0.f : __expf(pprev - pend); pprev = pend;
            if (isn) { st[0] = decay * st[0] + C.dn[(bh * 16 + c) * 128 + off]; C.nh[(bh * 16 + c) * 128 + off] = st[0]; }
            else { st = decay * st + *(const f32x4*)(DC + (size_t)(bh * 16 + c) * 32768 + off);
                   u32x2 o; o.x = pk2(st[0], st[1]); o.y = pk2(st[2], st[3]); *(u32x2*)(CH + (size_t)(bh * 16 + c) * 32768 + off) = o; }
        }
    }
}
constexpr int MLP_ = 136;
__device__ __forceinline__ void ml_out_phase(const Ctx& C, const float* gout) {
    const bf16* PROJ = (const bf16*)(C.R + R_PROJ); const bf16* CH = (const bf16*)(C.R + R_CH);
    LAS bf16* VT = (LAS bf16*)C.lds; LAS bf16* KL = VT + 256 * TP; LAS float* CV = (LAS float*)(KL + 32 * MLP_); LAS bf16* CHL = (LAS bf16*)(CV + 32);
    const int w = C.wave;
    for (int task = C.bid; task < 272; task += C.G) {
        int lane = C.lane, tid = C.tid; asm volatile("" : "+v"(lane), "+v"(tid));
        const int m31 = lane & 31, hi = lane >> 5;
        const int bh = task < 256 ? task >> 4 : task - 256, c = task < 256 ? 1 + (task & 15) : 0;
        const int b = bh >> 2, h = bh & 3, start = ml_start(c), n = ml_len(c), tok0 = b * SL + start;
        const int tl = 32 * w + m31, tlc = tl < n ? tl : n - 1; const bool wact = 32 * w < n;
        const float Pt = C.mlp[bh * SL + start + tlc];
        const bf16* qp = PROJ + (size_t)(tok0 + tlc) * ML_NP + MQ0 + h * 128 + 8 * hi;
        const int nst = (n + 31) >> 5;
        const int vs = tid & 31, vd0 = tid >> 5, ks_ = tid >> 4, kc_ = tid & 15;
        u32x4 rv0, rv1, rk; float rc = 0.f;
#define ML_LOAD(st_) do { const int s0_ = 32 * (st_); const int a_ = s0_ + vs < n ? s0_ + vs : n - 1, k_ = s0_ + ks_ < n ? s0_ + ks_ : n - 1; \
            const bf16* vp_ = PROJ + (size_t)(tok0 + a_) * ML_NP + MV0 + h * 256 + 8 * vd0; rv0 = *(const u32x4*)vp_; rv1 = *(const u32x4*)(vp_ + 128); \
            rk = *(const u32x4*)(PROJ + (size_t)(tok0 + k_) * ML_NP + MK0 + h * 128 + 8 * kc_); \
            if (tid < 32) rc = C.mlc[bh * SL + start + (s0_ + tid < n ? s0_ + tid : n - 1)]; } while (0)
#define ML_WRITE(st_) do { const int s0_ = 32 * (st_); const bool ok_ = s0_ + vs < n; float x_[8]; unpack8(rv0, x_); \
            _Pragma("unroll") for (int e = 0; e < 8; ++e) VT[(8 * vd0 + e) * TP + vs] = ok_ ? (bf16)(pk2(x_[e], 0.f) & 0xffffu) : (bf16)0; \
            unpack8(rv1, x_); _Pragma("unroll") for (int e = 0; e < 8; ++e) VT[(8 * (vd0 + 16) + e) * TP + vs] = ok_ ? (bf16)(pk2(x_[e], 0.f) & 0xffffu) : (bf16)0; \
            *(LAS u32x4*)(KL + ks_ * MLP_ + 8 * kc_) = rk; if (tid < 32) CV[tid] = rc; } while (0)
        float den = 0.f;
        f32x16 acc[8];
#pragma unroll
        for (int mb = 0; mb < 8; ++mb)
#pragma unroll
            for (int r = 0; r < 16; ++r) acc[mb][r] = 0.f;
        if (c >= 1 && wact) {
            const bf16* ch = CH + (size_t)(bh * 16 + c - 1) * 32768;
            bf16x8 qf[8];
#pragma unroll
            for (int ks = 0; ks < 8; ++ks) qf[ks] = *(const bf16x8*)(qp + 16 * ks);
#pragma unroll
            for (int mb = 0; mb < 8; ++mb)
#pragma unroll
                for (int ks = 0; ks < 8; ++ks) acc[mb] = MFMA32(*(const bf16x8*)(ch + (size_t)(32 * mb + m31) * 128 + 16 * ks + 8 * hi), qf[ks], acc[mb]);
            const float sc = __expf(C.mlp[bh * SL + start - 1] - Pt);
#pragma unroll
            for (int mb = 0; mb < 8; ++mb)
#pragma unroll
                for (int r = 0; r < 16; ++r) acc[mb][r] *= sc;
            const float* nh = C.nh + (bh * 16 + c - 1) * 128 + 8 * hi; float d = 0.f;
#pragma unroll
            for (int ks = 0; ks < 8; ++ks) { const f32x4 n0 = *(const f32x4*)(nh + 16 * ks), n1 = *(const f32x4*)(nh + 16 * ks + 4); float q[8]; unpack8(__builtin_bit_cast(u32x4, qf[ks]), q);
                d += (n0[0] * q[0] + n0[1] * q[1]) + (n0[2] * q[2] + n0[3] * q[3]) + (n1[0] * q[4] + n1[1] * q[5]) + (n1[2] * q[6] + n1[3] * q[7]); }
            d += __shfl_xor(d, 32); den = sc * d;
        }
        float den_in = 0.f;
        ML_LOAD(0);
        for (int st = 0; st < nst; ++st) {
            ML_WRITE(st);
            __syncthreads();
            const bool act = st <= w && wact;
            if (!act && st + 1 < nst) ML_LOAD(st + 1);
            if (act) {
                f32x16 X;
#pragma unroll
                for (int r = 0; r < 16; ++r) X[r] = 0.f;
                bf16x8 qf[8];
#pragma unroll
                for (int ks = 0; ks < 8; ++ks) qf[ks] = *(const bf16x8*)(qp + 16 * ks);
#pragma unroll
                for (int ks = 0; ks < 8; ++ks) X = MFMA32(*(const LAS bf16x8*)(KL + m31 * MLP_ + 16 * ks + 8 * hi), qf[ks], X);
                asm volatile("" ::: "memory");
                if (st + 1 < nst) ML_LOAD(st + 1);
                float Wt[16];
#pragma unroll
                for (int q4 = 0; q4 < 4; ++q4) { const int sb = 32 * st + 8 * q4 + 4 * hi;
                    const f32x4 cv = *(const LAS f32x4*)(CV + 8 * q4 + 4 * hi);
#pragma unroll
                    for (int e = 0; e < 4; ++e) { const int sl_ = sb + e; const bool ok = sl_ < n && sl_ <= tl;
                        const float wgt = ok ? X[4 * q4 + e] * 0.08838834764831845f * __expf(cv[e] - Pt) : 0.f; Wt[4 * q4 + e] = wgt; den_in += wgt; } }
#pragma unroll
                for (int s2 = 0; s2 < 2; ++s2) {
                    u32x4 pw; pw.x = pk2(Wt[8 * s2], Wt[8 * s2 + 1]); pw.y = pk2(Wt[8 * s2 + 2], Wt[8 * s2 + 3]); pw.z = pk2(Wt[8 * s2 + 4], Wt[8 * s2 + 5]); pw.w = pk2(Wt[8 * s2 + 6], Wt[8 * s2 + 7]);
                    const bf16x8 wf = __builtin_bit_cast(bf16x8, pw);
#pragma unroll
                    for (int mb = 0; mb < 8; ++mb) { const LAS bf16* vp = VT + (32 * mb + m31) * TP + 16 * s2 + 4 * hi;
                        const u32x2 lo = *(const LAS u32x2*)vp, hi2 = *(const LAS u32x2*)(vp + 8);
                        const u32x4 av = (u32x4){lo.x, lo.y, hi2.x, hi2.y};
                        acc[mb] = MFMA32(__builtin_bit_cast(bf16x8, av), wf, acc[mb]); }
                }
            }
            __syncthreads();
        }
#undef ML_LOAD
#undef ML_WRITE
        if (wact) {
            den += den_in + __shfl_xor(den_in, 32);
            const float Ft = C.mlf[bh * SL + start + tlc];
            const float dnm = fmaxf(fabsf(den), __expf(-(Ft + Pt))), invd = 1.0f / dnm;
            float ss = 0.f;
#pragma unroll
            for (int mb = 0; mb < 8; ++mb)
#pragma unroll
                for (int r = 0; r < 16; ++r) { const float hv = acc[mb][r] * invd; acc[mb][r] = hv; ss += hv * hv; }
            ss += __shfl_xor(ss, 32);
            const float rstd = 1.0f / sqrtf(ss * (1.0f / 256.0f) + RMS_EPS);
            if (tl < n) {
                const bf16* orow = PROJ + (size_t)(tok0 + tl) * ML_NP + MO0 + h * 256; bf16* yrow = C.XN + (size_t)(tok0 + tl) * D + h * 256; const float* gr = gout + h * 256;
#pragma unroll
                for (int mb = 0; mb < 8; ++mb)
#pragma unroll
                    for (int q4 = 0; q4 < 4; ++q4) { const int dv0 = 32 * mb + 8 * q4 + 4 * hi; const f32x4 gg = *(const f32x4*)(gr + dv0); const u32x2 ow = *(const u32x2*)(orow + dv0);
                        const float o0 = bflo(ow.x), o1 = bfhi(ow.x), o2 = bflo(ow.y), o3 = bfhi(ow.y);
                        const float y0 = acc[mb][4 * q4] * rstd * gg[0] / (1.0f + __expf(-o0)), y1 = acc[mb][4 * q4 + 1] * rstd * gg[1] / (1.0f + __expf(-o1));
                        const float y2 = acc[mb][4 * q4 + 2] * rstd * gg[2] / (1.0f + __expf(-o2)), y3 = acc[mb][4 * q4 + 3] * rstd * gg[3] / (1.0f + __expf(-o3));
                        u32x2 o; o.x = pk2(y0, y1); o.y = pk2(y2, y3); *(u32x2*)(yrow + dv0) = o; }
            }
        }
    }
}

__device__ __forceinline__ void moe_bases(const Ctx& C, int layer, int (&pb)[9]) {
    pb[0] = 0;
#pragma unroll
    for (int e = 0; e < 8; ++e) { const int ne = (int)__hip_atomic_load(C.ctl + CW_CNT + (layer * 8 + e) * 64, __ATOMIC_RELAXED, __HIP_MEMORY_SCOPE_AGENT); pb[e + 1] = pb[e] + ((ne + 255) >> 8); }
}
__device__ __forceinline__ void moe_gather_phase(const Ctx& C, int layer) {
    bf16* AS = (bf16*)(C.R + R_AS);
    LAS int* lb = (LAS int*)C.lds;
    if (C.tid == 0) { int pb[9]; moe_bases(C, layer, pb);
#pragma unroll
        for (int e = 0; e < 8; ++e) { lb[e] = pb[e] * 256; lb[8 + e] = (int)__hip_atomic_load(C.ctl + CW_CNT + (layer * 8 + e) * 64, __ATOMIC_RELAXED, __HIP_MEMORY_SCOPE_AGENT); } }
    __syncthreads();
    for (int row = C.gw; row < NT; row += C.ngw) {
        const int ee = C.route_e[row]; const float g1 = C.route_g1[row];
        u32x4 x0, x1 = (u32x4){0u, 0u, 0u, 0u};
        if (FP8_MOE) x0 = *(const u32x4*)(C.xn8 + (size_t)row * D + 16 * C.lane);
        else { x0 = *(const u32x4*)(C.XN + (size_t)row * D + 8 * C.lane); x1 = *(const u32x4*)(C.XN + (size_t)row * D + 512 + 8 * C.lane); }
#pragma unroll
        for (int wh = 0; wh < 2; ++wh) { const int e = wh ? (ee >> 8) : (ee & 0xff), r = wh ? C.route_r2[row] : C.route_r1[row]; const int slot = lb[e] + r;
            if (FP8_MOE) *(u32x4*)((unsigned char*)AS + (size_t)slot * D + 16 * C.lane) = x0;
            else { *(u32x4*)(AS + (size_t)slot * D + 8 * C.lane) = x0; *(u32x4*)(AS + (size_t)slot * D + 512 + 8 * C.lane) = x1; }
            if (C.lane == 0) { C.slot_tok[slot] = row | (wh << 16); C.slot_g[slot] = wh ? 1.0f - g1 : g1; } }
    }
    u32x4 zero4 = (u32x4){0u, 0u, 0u, 0u}; asm volatile("" : "+v"(zero4));
    for (int e = 0; e < 8; ++e) { const int ne = lb[8 + e], first = lb[e] + ne, last = lb[e] + ((ne + 255) & ~255);
        for (int slot = first + C.gw; slot < last; slot += C.ngw) {
            if (FP8_MOE) *(u32x4*)((unsigned char*)AS + (size_t)slot * D + 16 * C.lane) = zero4;
            else { *(u32x4*)(AS + (size_t)slot * D + 8 * C.lane) = zero4; *(u32x4*)(AS + (size_t)slot * D + 512 + 8 * C.lane) = zero4; }
            if (C.lane == 0) { C.slot_tok[slot] = -1; C.slot_g[slot] = 0.f; } } }
    __syncthreads();
}
__device__ __forceinline__ void final_phase(const Ctx& C, float* out) {
    const bf16* Y0 = (const bf16*)(C.R + R_Y0); const bf16* Y1 = (const bf16*)(C.R + R_Y1);
    const int gt = C.bid * NTHREADS + C.tid, ngt = C.G * NTHREADS;
    for (int i = gt; i < BATCH * SEQ * (D / 4); i += ngt) { const int orow = i >> 8, c4 = i & 255, b = orow >> 12, s = orow & 4095; const size_t row = (size_t)b * SL + NMETA + s;
#if H_BF16
        f32x4 v; { const u32x2 hq = *(const u32x2*)(C.H + row * D + 4 * c4); v[0] = bflo(hq.x); v[1] = bfhi(hq.x); v[2] = bflo(hq.y); v[3] = bfhi(hq.y); }
#else
        f32x4 v = *(const f32x4*)(C.H + row * D + 4 * c4);
#endif
        const u32x2 a = *(const u32x2*)(Y0 + row * D + 4 * c4), bb = *(const u32x2*)(Y1 + row * D + 4 * c4);
        v[0] += bflo(a.x) + bflo(bb.x); v[1] += bfhi(a.x) + bfhi(bb.x); v[2] += bflo(a.y) + bflo(bb.y); v[3] += bfhi(a.y) + bfhi(bb.y);
        *(f32x4*)(out + (size_t)orow * D + 4 * c4) = v; }
}
template <int MODE, int KSW  , bool FP8 = false>
__device__ __forceinline__ void skinny_phase(const Ctx& C, const bf16* A16, const bf16* Bt, int N, int K, bf16* O, int ldo, HT* H, float sa = 1.0f, float so = 1.0f) {
    const int lane = C.lane, n15 = lane & 15, kq = lane >> 4, w = C.wave;
    LAS f32x4* red = (LAS f32x4*)C.lds;
    const int nblk = (MODE == 2) ? N / 32 : N / 16;
    for (int cb = C.bid; cb < nblk; cb += C.G) {
        int rowB0 = 16 * cb, rowB1 = 0;
        if (MODE == 2) { const int c0 = 16 * cb; rowB0 = 256 * (c0 >> 7) + (c0 & 127); rowB1 = rowB0 + 128; }
        f32x4 acc0 = (f32x4){0.f, 0.f, 0.f, 0.f}, acc1 = (f32x4){0.f, 0.f, 0.f, 0.f};
        const bf16* ap = A16 + (size_t)n15 * K + 8 * kq; const bf16* bp0 = Bt + (size_t)(rowB0 + n15) * K + 8 * kq; const bf16* bp1 = Bt + (size_t)(rowB1 + n15) * K + 8 * kq;
        if constexpr (FP8) {
            const unsigned char* ap8 = (const unsigned char*)A16 + (size_t)n15 * K + 8 * kq; const unsigned char* bq0 = (const unsigned char*)Bt + (size_t)(rowB0 + n15) * K + 8 * kq; const unsigned char* bq1 = (const unsigned char*)Bt + (size_t)(rowB1 + n15) * K + 8 * kq;
            long af[KSW], b0f[KSW], b1f[MODE == 2 ? KSW : 1];
#pragma unroll
            for (int i = 0; i < KSW; ++i) { const int ks = w + NWAVES * i; af[i] = *(const long*)(ap8 + 32 * ks); b0f[i] = *(const long*)(bq0 + 32 * ks); if (MODE == 2) b1f[i] = *(const long*)(bq1 + 32 * ks); }
#pragma unroll
            for (int i = 0; i < KSW; ++i) { acc0 = __builtin_amdgcn_mfma_f32_16x16x32_fp8_fp8(af[i], b0f[i], acc0, 0, 0, 0); if (MODE == 2) acc1 = __builtin_amdgcn_mfma_f32_16x16x32_fp8_fp8(af[i], b1f[i], acc1, 0, 0, 0); }
        } else {
            bf16x8 af[KSW], b0f[KSW], b1f[MODE == 2 ? KSW : 1];
#pragma unroll
            for (int i = 0; i < KSW; ++i) { const int ks = w + NWAVES * i; af[i] = *(const bf16x8*)(ap + 32 * ks); b0f[i] = *(const bf16x8*)(bp0 + 32 * ks); if (MODE == 2) b1f[i] = *(const bf16x8*)(bp1 + 32 * ks); }
#pragma unroll
            for (int i = 0; i < KSW; ++i) { acc0 = MFMA16(af[i], b0f[i], acc0); if (MODE == 2) acc1 = MFMA16(af[i], b1f[i], acc1); }
        }
        red[w * 64 + lane] = acc0; if (MODE == 2) red[512 + w * 64 + lane] = acc1;
        __syncthreads();
        if (w == 0) {
            f32x4 s0 = red[lane], s1 = (f32x4){0.f, 0.f, 0.f, 0.f};
#pragma unroll
            for (int ww = 1; ww < NWAVES; ++ww) s0 += red[ww * 64 + lane];
            if (MODE == 2) { s1 = red[512 + lane];
#pragma unroll
                for (int ww = 1; ww < NWAVES; ++ww) s1 += red[512 + ww * 64 + lane]; }
            const int col = 16 * cb + n15;
#pragma unroll
            for (int i = 0; i < 4; ++i) { const int m = 4 * kq + i;
                if (MODE == 0) { const bf16 v = (bf16)(pk2(s0[i] * sa, 0.f) & 0xffffu);
#pragma unroll
                    for (int b = 0; b < BATCH; ++b) O[(size_t)(b * SL + m) * ldo + col] = v; }
                if (MODE == 1) {
#pragma unroll
#if H_BF16
                    for (int b = 0; b < BATCH; ++b) { HT* hp = H + (size_t)(b * SL + m) * D + col; *hp = (HT)(pk2(bf2f(*hp) + s0[i] * sa, 0.f) & 0xffffu); } }
#else
                    for (int b = 0; b < BATCH; ++b) H[(size_t)(b * SL + m) * D + col] += s0[i] * sa; }
#endif
                if (MODE == 2) { if (FP8) ((unsigned char*)O)[(size_t)m * ldo + col] = (unsigned char)(pg8::cvt4_fp8(pg8::silu_mul(s0[i] * sa, s1[i] * sa) * so, 0.f, 0.f, 0.f) & 0xffu);
                                 else O[(size_t)m * ldo + col] = (bf16)(pk2(pg8::silu_mul(s0[i], s1[i]), 0.f) & 0xffffu); }
            }
        }
        __syncthreads();
    }
}
typedef const __attribute__((address_space(4))) Params* KArg;
__device__ __forceinline__ KArg karg() { KArg p = (KArg)__builtin_amdgcn_kernarg_segment_ptr(); asm volatile("" : "+s"(p)); return p; }
__device__ __forceinline__ void ctx_init(Ctx& C, KArg P, LAS unsigned char* lds_, int wv0) {
    C.lds = lds_;
    { int t_ = wv0 * 64 + hw_lane(); asm volatile("" : "+v"(t_)); C.tid = t_; } C.lane = C.tid & 63; C.wave = __builtin_amdgcn_readfirstlane(C.tid >> 6); C.G = gridDim.x; C.bid = blockIdx.x;
    C.gw = C.bid * NWAVES + C.wave; C.ngw = C.G * NWAVES;
    unsigned char* ws = P->ws;
    C.ctl = (unsigned*)(ws + WS_CTL);
    C.rope = (float2*)(ws + WS_ROPE); C.sm8 = (float*)(ws + WS_SM8);
    C.route_e = (int*)(ws + WS_ROUTE); C.route_r1 = C.route_e + NT; C.route_r2 = C.route_r1 + NT; C.route_g1 = (float*)(C.route_r2 + NT);
    C.mlf = (float*)(ws + WS_MLG); C.mlc = C.mlf + 16 * SL; C.mlp = C.mlc + 16 * SL; C.mli = (float*)(ws + WS_MLI); C.mlg = C.mli + 16 * 65 * 64;
    C.dn = (float*)(ws + WS_NH); C.nh = C.dn + 16 * 16 * 128;
    C.slot_tok = (int*)(ws + WS_SLOT); C.slot_g = (float*)(C.slot_tok + MOE_ROWS); C.sel = (unsigned short*)(ws + WS_SEL);
    C.wdsa_in = (bf16*)(ws + WS_WDSA_IN); C.wdsa_out = (bf16*)(ws + WS_WDSA_OUT); C.wml_in = (bf16*)(ws + WS_WML_IN); C.wml_out = (bf16*)(ws + WS_WML_OUT);
    C.wffn_gu = (bf16*)(ws + WS_WFFN_GU); C.wffn_dn = (bf16*)(ws + WS_WFFN_DN); C.wmoe_gu = (bf16*)(ws + WS_WMOE_GU); C.wmoe_dn = (bf16*)(ws + WS_WMOE_DN);
    C.H = (HT*)(ws + WS_H); C.XN = (bf16*)(ws + WS_XN); C.R = ws + WS_R; C.xn8 = ws + WS_XN8;
}
constexpr int N_PHASES = 44;
#if H_BF16
typedef pg8::EpiResAddB EpiResAddH;
#else
typedef pg8::EpiResAdd EpiResAddH;
#endif
template <int SITE> __global__ void __launch_bounds__(NTHREADS, 2) fwd(Params Pval) {
    extern __shared__ __attribute__((aligned(16))) unsigned char lds_raw[];
    LAS unsigned char* const lds_base = (LAS unsigned char*)lds_raw;
    unsigned* ctl0; int lo, hi; { KArg P0 = karg(); ctl0 = (unsigned*)(P0->ws + WS_CTL); lo = P0->ph_lo; hi = P0->ph_hi; }
    volatile LAS unsigned* MISC = (volatile LAS unsigned*)(lds_base + MISC_OFF);
    int wv0 = __builtin_amdgcn_readfirstlane((int)threadIdx.x >> 6); asm volatile("" : "+s"(wv0));
    if (threadIdx.x < 64) MISC[threadIdx.x] = 0u;
    __syncthreads();
    XcdBarrier bar; bar.bar = ctl0 + CW_BAR; bar.x = 0; bar.st = MISC + 8;
    if (hi - lo > 1) bar = xcd_barrier_post(ctl0 + CW_BAR, MISC + 8, wv0);
    int ph = 0;
#ifndef SKIP_SITE
#define SKIP_SITE -5
#endif
#ifndef REPEAT_MASK
#define REPEAT_MASK 0u
#endif
#define PH_BEGIN_(id) if ((SITE < 0 || SITE == (id)) && SKIP_SITE != (id) && ph >= lo && ph < hi) { for (int rep = 0; rep < (((REPEAT_MASK >> (id)) & 1u) ? 2 : 1); ++rep) { KArg P = karg(); Ctx C; ctx_init(C, P, lds_base, wv0); HT* Hres = rep ? (HT*)(C.R + 160 * MiB) : C.H; (void)Hres; bf16* PROJ = (bf16*)(C.R + R_PROJ); bf16* ACT = (bf16*)(C.R + R_ACT); bf16* AS = (bf16*)(C.R + R_AS); (void)PROJ; (void)ACT; (void)AS;
#define PH_END } if (ph + 1 < hi) xcd_barrier(bar); } ++ph;
    using namespace pg8;

    PH_BEGIN_(0) prologue_phase(C, P); PH_END

    for (int j = 0; j < 2; ++j) {
        PH_BEGIN_(1)
            const float* gain = P->in[2] + (size_t)(2 * j) * D; const float* w8 = P->in[4] + (size_t)j * D * DSA_LDW + DIW0;
            if (j == 0) norm_phase<0, false, FP8_DSA_IN != 0>(C, gain, w8, DSA_LDW, 0); else norm_phase<0, true, FP8_DSA_IN != 0>(C, gain, w8, DSA_LDW, 0);
        PH_END
        PH_BEGIN_(2) {
#if FP8_DSA_IN
                   const bf16* w8 = (const bf16*)((const unsigned char*)C.wdsa_in + (size_t)j * DSA_NP * D);
                   Gemm g{(const bf16*)C.xn8, w8, 16384, DSA_NP, D / 2}; StaticOrder S; S.init(16384, DSA_NP, C.G, C.bid, 1); EpiStoreBf16 E{PROJ, DSA_NP, 1.0f / SW_DIN};
                   gemm_phase<EpiStoreBf16, StaticOrder, true, true, true>(C.lds, g, S, E, C.tid); skinny_phase<0, 4, true>(C, (const bf16*)C.xn8, w8, DSA_NP, D, PROJ, DSA_NP, nullptr, 1.0f / SW_DIN);
#else
                   Gemm g{C.XN, C.wdsa_in + (size_t)j * DSA_NP * D, 16384, DSA_NP, D}; StaticOrder S; S.init(16384, DSA_NP, C.G, C.bid, 1); EpiStoreBf16 E{PROJ, DSA_NP, 1.0f};
                   gemm_phase<EpiStoreBf16, StaticOrder, true, true>(C.lds, g, S, E, C.tid); skinny_phase<0, 4>(C, C.XN, C.wdsa_in + (size_t)j * DSA_NP * D, DSA_NP, D, PROJ, DSA_NP, nullptr);
#endif
                   } PH_END
        PH_BEGIN_(3) dsa_post_phase(C, P->in[5] + j * 64, P->in[6] + j * 64); PH_END
        PH_BEGIN_(4) score_phase(C); PH_END
        PH_BEGIN_(5) topk_phase(C, P, j); PH_END
        PH_BEGIN_(6) if (FP8_DSA) attn2b_phase<true>(C, (bf16*)C.xn8); else attn2b_phase<false>(C, C.XN); PH_END
        PH_BEGIN_(7) {
#if FP8_DSA
                   const bf16* w8 = (const bf16*)((const unsigned char*)C.wdsa_out + (size_t)j * D * D);
                   Gemm g{(const bf16*)C.xn8, w8, 16384, D, D / 2}; StaticOrder S; S.init(16384, D, C.G, C.bid, 1); EpiResAddH E{Hres, D, 1.0f / (SW_DOUT * SA_ATT)};
                   gemm_phase<EpiResAddH, StaticOrder, true, true, true>(C.lds, g, S, E, C.tid); skinny_phase<1, 4, true>(C, (const bf16*)C.xn8, w8, D, D, nullptr, 0, Hres, 1.0f / (SW_DOUT * SA_ATT));
#else
                   Gemm g{C.XN, C.wdsa_out + (size_t)j * D * D, 16384, D, D}; StaticOrder S; S.init(16384, D, C.G, C.bid, 1); EpiResAddH E{Hres, D, 1.0f};
                   gemm_phase<EpiResAddH, StaticOrder, true, true>(C.lds, g, S, E, C.tid); skinny_phase<1, 4>(C, C.XN, C.wdsa_out + (size_t)j * D * D, D, D, nullptr, 0, Hres);
#endif
                   } PH_END
        PH_BEGIN_(8) norm_phase<3, false, FP8_DENSE != 0>(C, P->in[3] + (size_t)(2 * j) * D, nullptr, 0, 0); PH_END
        PH_BEGIN_(9) {
#if FP8_DENSE
                   const bf16* w8 = (const bf16*)((const unsigned char*)C.wffn_gu + (size_t)j * GU * D);
                   Gemm g{(const bf16*)C.xn8, w8, 16384, GU, D / 2}; StaticOrder S; S.init(16384, GU, C.G, C.bid, 1); EpiSwiGLU8 E{(unsigned char*)ACT, FF, 1.0f / SW_GU, SA_ACT};
                   gemm_phase<EpiSwiGLU8, StaticOrder, true, true, true>(C.lds, g, S, E, C.tid); skinny_phase<2, 4, true>(C, (const bf16*)C.xn8, w8, GU, D, ACT, FF, nullptr, 1.0f / SW_GU, SA_ACT);
#else
                   Gemm g{C.XN, C.wffn_gu + (size_t)j * GU * D, 16384, GU, D}; StaticOrder S; S.init(16384, GU, C.G, C.bid, 1); EpiSwiGLU E{ACT, FF};
                   gemm_phase<EpiSwiGLU, StaticOrder, true, true>(C.lds, g, S, E, C.tid); skinny_phase<2, 4>(C, C.XN, C.wffn_gu + (size_t)j * GU * D, GU, D, ACT, FF, nullptr);
#endif
                   } PH_END
        PH_BEGIN_(10) {
#if FP8_DENSE
                   const bf16* w8 = (const bf16*)((const unsigned char*)C.wffn_dn + (size_t)j * D * FF);
                   Gemm g{ACT, w8, 16384, D, FF / 2}; StaticOrder S; S.init(16384, D, C.G, C.bid, 1); EpiResAddH E{Hres, D, 1.0f / (SW_DN * SA_ACT)};
                   gemm_phase<EpiResAddH, StaticOrder, true, true, true>(C.lds, g, S, E, C.tid); skinny_phase<1, 14, true>(C, ACT, w8, D, FF, nullptr, 0, Hres, 1.0f / (SW_DN * SA_ACT));
#else
                   Gemm g{ACT, C.wffn_dn + (size_t)j * D * FF, 16384, D, FF}; StaticOrder S; S.init(16384, D, C.G, C.bid, 1); EpiResAddH E{Hres, D, 1.0f};
                   gemm_phase<EpiResAddH, StaticOrder, true, true>(C.lds, g, S, E, C.tid); skinny_phase<1, 14>(C, ACT, C.wffn_dn + (size_t)j * D * FF, D, FF, nullptr, 0, Hres);
#endif
                   } PH_END
        PH_BEGIN_(11) norm_phase<1, false>(C, P->in[2] + (size_t)(2 * j + 1) * D, P->in[8] + (size_t)j * D * ML_LDW + MG0, ML_LDW, 0, P->in[9] + j * 4, P->in[10] + j * 4); PH_END
        PH_BEGIN_(12) { Gemm g{C.XN, C.wml_in + (size_t)j * ML_NP * D, 16384, ML_NP, D}; StaticOrder S; S.init(16384, ML_NP, C.G, C.bid, 1); EpiStoreBf16 E{PROJ, ML_NP, 1.0f};
                   gemm_phase<EpiStoreBf16, StaticOrder, true, true>(C.lds, g, S, E, C.tid); skinny_phase<0, 4>(C, C.XN, C.wml_in + (size_t)j * ML_NP * D, ML_NP, D, PROJ, ML_NP, nullptr); } PH_END
        PH_BEGIN_(13) ml_scan_phase(C); PH_END
        PH_BEGIN_(14) ml_dc_phase(C); PH_END
        PH_BEGIN_(15) ml_state_phase(C); PH_END
        PH_BEGIN_(16) ml_out_phase(C, P->in[11] + (size_t)j * D); PH_END
        PH_BEGIN_(17) { Gemm g{C.XN, C.wml_out + (size_t)j * D * D, 16384, D, D}; StaticOrder S; S.init(16384, D, C.G, C.bid, 1); EpiResAddH E{Hres, D, 1.0f};
                   gemm_phase<EpiResAddH, StaticOrder, true, true>(C.lds, g, S, E, C.tid); skinny_phase<1, 4>(C, C.XN, C.wml_out + (size_t)j * D * D, D, D, nullptr, 0, Hres); } PH_END
        PH_BEGIN_(18) norm_phase<2, false, FP8_MOE != 0>(C, P->in[3] + (size_t)(2 * j + 1) * D, P->in[16] + (size_t)j * D * 8, 8, j); PH_END
        PH_BEGIN_(19) moe_gather_phase(C, j); PH_END
        PH_BEGIN_(20) { int pb[9]; moe_bases(C, j, pb);
                   GroupedOrder S; S.nM = pb[8]; S.nN = GU / 256; S.nwg = S.nM * S.nN; S.G = C.G; S.c = C.bid; S.p1 = pb[1]; S.p2 = pb[2]; S.p3 = pb[3]; S.p4 = pb[4]; S.p5 = pb[5]; S.p6 = pb[6]; S.p7 = pb[7]; S.bmajor = MOE_GU_BMAJOR;
#if FP8_MOE
                   Gemm g{AS, (const bf16*)((const unsigned char*)C.wmoe_gu + (size_t)j * NE * GU * D), pb[8] * 256, GU, D / 2}; S.estride = (size_t)GU * D;
                   EpiSwiGLU8 E{(unsigned char*)ACT, FF, 1.0f / SW_GU, SA_ACT};
                   gemm_phase<EpiSwiGLU8, GroupedOrder, true, true, true>(C.lds, g, S, E, C.tid);
#else
                   Gemm g{AS, C.wmoe_gu + (size_t)j * NE * GU * D, pb[8] * 256, GU, D}; S.estride = (size_t)GU * D * 2;
                   EpiSwiGLU E{ACT, FF};
                   gemm_phase<EpiSwiGLU, GroupedOrder, true, true>(C.lds, g, S, E, C.tid);
#endif
                   } PH_END
        PH_BEGIN_(21) { int pb[9]; moe_bases(C, j, pb);
                   GroupedOrder S; S.nM = pb[8]; S.nN = D / 256; S.nwg = S.nM * S.nN; S.G = C.G; S.c = C.bid; S.p1 = pb[1]; S.p2 = pb[2]; S.p3 = pb[3]; S.p4 = pb[4]; S.p5 = pb[5]; S.p6 = pb[6]; S.p7 = pb[7]; S.bmajor = 0;
#if FP8_MOE
                   Gemm g{ACT, (const bf16*)((const unsigned char*)C.wmoe_dn + (size_t)j * NE * D * FF), pb[8] * 256, D, FF / 2}; S.estride = (size_t)D * FF;
                   EpiMoeDown E{(bf16*)(C.R + R_Y0), (bf16*)(C.R + R_Y1), C.slot_tok, C.slot_g, D, 1.0f / (SW_DN * SA_ACT)};
                   gemm_phase<EpiMoeDown, GroupedOrder, true, true, true>(C.lds, g, S, E, C.tid);
#else
                   Gemm g{ACT, C.wmoe_dn + (size_t)j * NE * D * FF, pb[8] * 256, D, FF}; S.estride = (size_t)D * FF * 2;
                   EpiMoeDown E{(bf16*)(C.R + R_Y0), (bf16*)(C.R + R_Y1), C.slot_tok, C.slot_g, D, 1.0f};
                   gemm_phase<EpiMoeDown, GroupedOrder, true, true>(C.lds, g, S, E, C.tid);
#endif
                   } PH_END
    }
#ifdef PROBE_BAR
    for (int q_ = 0; q_ < PROBE_BAR; ++q_) xcd_barrier(bar);
#endif
    PH_BEGIN_(22) final_phase(C, P->out); PH_END
#undef PH_BEGIN_
#undef PH_END
}

constexpr int NSITES = 24;
template <int S> struct SiteTab { static const void* get(int s) { return s == S ? (const void*)fwd<S> : SiteTab<S - 1>::get(s); } };
template <> struct SiteTab<-1> { static const void* get(int) { return nullptr; } };
#if N_LAUNCH_SPLIT
static const void* site_fn(int s) { return s >= 23 ? (const void*)fwd<22> : SiteTab<22>::get(s); }
#else
static const void* site_fn(int) { return (const void*)fwd<-1>; }
#endif
extern "C" void kernel_launch(void* const* d_in, const int* in_sizes, int n_in, void* d_out, int out_size, void* d_ws, size_t ws_size, hipStream_t stream) {
    static int grid = 0;
    if (grid == 0) {
        if (n_in != 20 || ws_size < WS_END) { fprintf(stderr, "kernel_launch: need 20 inputs and %zu bytes of workspace; got %d, %zu\n", (size_t)WS_END, n_in, ws_size); grid = -1; return; }
        int dev = 0, cus = 0, per_cu = 0;
        if (hipGetDevice(&dev) != hipSuccess || hipDeviceGetAttribute(&cus, hipDeviceAttributeMultiprocessorCount, dev) != hipSuccess) { grid = -1; return; }
        for (int s = 0; s < NSITES; ++s) if (hipFuncSetAttribute(site_fn(s), hipFuncAttributeMaxDynamicSharedMemorySize, LDS_BYTES) != hipSuccess) { fprintf(stderr, "kernel_launch: hipFuncSetAttribute failed\n"); grid = -1; return; }
        if (hipOccupancyMaxActiveBlocksPerMultiprocessor(&per_cu, site_fn(N_LAUNCH_SPLIT ? 1 : NSITES - 1), NTHREADS, LDS_BYTES) != hipSuccess || per_cu < 1) fprintf(stderr, "kernel_launch: occupancy query says %d\n", per_cu);
        (void)hipGetLastError();
        grid = cus;
    }
    if (grid < 0) return;
    (void)hipMemsetAsync((char*)d_ws + WS_CTL, 0, CTL_ZERO_BYTES, stream);
    Params p{};
    for (int i = 0; i < 20; ++i) p.in[i] = (const float*)d_in[i];
    p.out = (float*)d_out; p.ws = (unsigned char*)d_ws;
#if N_LAUNCH_SPLIT
    for (int ph = 0; ph < N_PHASES; ++ph) { p.ph_lo = ph; p.ph_hi = ph + 1; const int site = ph == 0 ? 0 : ph == N_PHASES - 1 ? 22 : 1 + (ph - 1) % 21; void* args[] = {&p};
        (void)hipLaunchKernel(site_fn(site), dim3(grid), dim3(NTHREADS), args, LDS_BYTES, stream); }
#else
    p.ph_lo = 0; p.ph_hi = N_PHASES; { void* args[] = {&p}; (void)hipLaunchKernel(site_fn(NSITES - 1), dim3(grid), dim3(NTHREADS), args, LDS_BYTES, stream); }
#endif
}
```

```cpp
#include <hip/hip_runtime.h>
#include <cstdio>
#include <cstdint>
#ifndef N_LAUNCH_SPLIT
#define N_LAUNCH_SPLIT 0
#endif
namespace pg8 {
#define PG8_LAS __attribute__((address_space(3)))
typedef unsigned short bf16_t;
typedef short bf16x8 __attribute__((ext_vector_type(8)));
typedef float f32x4 __attribute__((ext_vector_type(4)));
typedef unsigned u32x4 __attribute__((ext_vector_type(4)));
constexpr int BM = 256, BK = 64, HALF = 128, HTB = HALF * BK * 2  , STAGE_BYTES = 8 * HTB, NXCD = 8, WGM = 8;

__host__ __device__ __forceinline__ int lds_byte(int r, int c) { const int st = (r >> 4) * 2 + (c >> 5), rr = r & 15, cc = c & 31, ob = rr * 64 + cc * 2; return st * 1024 + (ob ^ (((ob >> 9) & 1) << 5)); }
__host__ __device__ __forceinline__ void stage_rc(int b, int& R, int& C) { const int st = b / 1024, sb = b % 1024, swz = sb ^ (((sb >> 9) & 1) << 5); R = (st >> 1) * 16 + swz / 64; C = (st & 1) * 32 + (swz % 64) / 2; }
__host__ __device__ __forceinline__ int perm32(int rho) { const int n = rho >> 4, i = rho & 15; return 8 * (i >> 2) + 4 * n + (i & 3); }

struct Unit { int pm, pn, r0; };
struct Gemm { const bf16_t* A; const bf16_t* Bt; int M, N, K; };

struct StaticOrder {
    int nM, nN, nwg, G, c, tokmap;
    __host__ __device__ void init(int M, int N, int G_, int c_, int tokmap_ = 0) { nM = M / BM; nN = N / BM; nwg = nM * nN; G = G_; c = c_; tokmap = tokmap_; }
    __host__ __device__ bool next(int i, Unit& u) const {
        const long L = (long)i * G + c; if (L >= nwg) return false;
        int wgid = (int)L; { const int q = nwg / NXCD, r = nwg % NXCD, xcd = wgid % NXCD, off = wgid / NXCD; wgid = (xcd < r ? xcd * (q + 1) : r * (q + 1) + (xcd - r) * q) + off; }
        const int nig = WGM * nN, gid = wgid / nig, fm = gid * WGM, gsz = (nM - fm) < WGM ? (nM - fm) : WGM;
        u.pm = fm + ((wgid % nig) % gsz); u.pn = (wgid % nig) / gsz; u.r0 = tokmap ? 4112 * (u.pm >> 4) + 16 + 256 * (u.pm & 15) : 256 * u.pm; return true;
    }
    __device__ __forceinline__ const char* b_base(const Gemm& g, const Unit& u, size_t tstep) const { return (const char*)g.Bt + (size_t)u.pn * tstep; }
    __device__ __forceinline__ void a_ready(const Unit&) const {}
    __device__ __forceinline__ void done(const Unit&) const {}
};
__device__ __forceinline__ unsigned cvt_pk_bf16(float lo, float hi) { unsigned r; asm volatile("v_cvt_pk_bf16_f32 %0, %1, %2" : "=v"(r) : "v"(lo), "v"(hi)); return r; }
typedef int i32x8 __attribute__((ext_vector_type(8)));
typedef int i32x4v __attribute__((ext_vector_type(4)));
__device__ __forceinline__ i32x8 cat8(bf16x8 a, bf16x8 b) { const i32x4v x = __builtin_bit_cast(i32x4v, a), y = __builtin_bit_cast(i32x4v, b); return __builtin_shufflevector(x, y, 0, 1, 2, 3, 4, 5, 6, 7); }
__device__ __forceinline__ float clamp448(float x) { return __builtin_amdgcn_fmed3f(x, -448.0f, 448.0f); }
__device__ __forceinline__ unsigned cvt4_fp8(float a, float b, float c, float d) { int w = 0; w = __builtin_amdgcn_cvt_pk_fp8_f32(clamp448(a), clamp448(b), w, false); w = __builtin_amdgcn_cvt_pk_fp8_f32(clamp448(c), clamp448(d), w, true); return (unsigned)w; }
typedef unsigned u32x2v __attribute__((ext_vector_type(2)));
struct EpiStoreBf16 {
    static constexpr bool PERM = true, AFTER_DRAIN = false;
    bf16_t* O; int ldc; float s;
    __device__ __forceinline__ void operator()(const f32x4 (&acc)[2][2][4][2], const Unit& u, int wr, int wc, int fr, int fq) const {
        const int row0 = u.r0 + wr * 64 + fr, col0 = u.pn * BM + wc * 32 + 8 * fq;
#pragma unroll
        for (int ai = 0; ai < 2; ++ai)
#pragma unroll
            for (int m = 0; m < 4; ++m) { bf16_t* rowp = O + (size_t)(row0 + ai * HALF + m * 16) * ldc + col0;
#pragma unroll
                for (int bj = 0; bj < 2; ++bj) { const f32x4 v0 = acc[ai][bj][m][0] * s, v1 = acc[ai][bj][m][1] * s;
                    u32x4 w; w.x = cvt_pk_bf16(v0[0], v0[1]); w.y = cvt_pk_bf16(v0[2], v0[3]); w.z = cvt_pk_bf16(v1[0], v1[1]); w.w = cvt_pk_bf16(v1[2], v1[3]);
                    *(u32x4*)(rowp + bj * HALF) = w; } }
    }
};
struct EpiResAdd {
    static constexpr bool PERM = false, AFTER_DRAIN = false;
    float* H; int ldc; float s;
    __device__ __forceinline__ void operator()(const f32x4 (&acc)[2][2][4][2], const Unit& u, int wr, int wc, int fr, int fq) const {
        const int row0 = u.r0 + wr * 64 + fr, col0 = u.pn * BM + wc * 32 + 4 * fq;
#pragma unroll
        for (int ai = 0; ai < 2; ++ai)
#pragma unroll
            for (int m = 0; m < 4; ++m) { float* rowp = H + (size_t)(row0 + ai * HALF + m * 16) * ldc + col0;
                f32x4 h[2][2];
#pragma unroll
                for (int bj = 0; bj < 2; ++bj)
#pragma unroll
                    for (int n = 0; n < 2; ++n) h[bj][n] = *(const f32x4*)(rowp + bj * HALF + n * 16);
#pragma unroll
                for (int bj = 0; bj < 2; ++bj)
#pragma unroll
                    for (int n = 0; n < 2; ++n) *(f32x4*)(rowp + bj * HALF + n * 16) = h[bj][n] + acc[ai][bj][m][n] * s;
                if (m & 1) asm volatile("" ::: "memory"); }
    }
};
struct EpiResAddB {
    static constexpr bool PERM = true, AFTER_DRAIN = false;
    bf16_t* H; int ldc; float s;
    __device__ __forceinline__ void operator()(const f32x4 (&acc)[2][2][4][2], const Unit& u, int wr, int wc, int fr, int fq) const {
        const int row0 = u.r0 + wr * 64 + fr, col0 = u.pn * BM + wc * 32 + 8 * fq;
#pragma unroll
        for (int ai = 0; ai < 2; ++ai)
#pragma unroll
            for (int m = 0; m < 4; ++m) { bf16_t* rowp = H + (size_t)(row0 + ai * HALF + m * 16) * ldc + col0;
                u32x4 h[2];
#pragma unroll
                for (int bj = 0; bj < 2; ++bj) h[bj] = *(const u32x4*)(rowp + bj * HALF);
#pragma unroll
                for (int bj = 0; bj < 2; ++bj) { const f32x4 v0 = acc[ai][bj][m][0] * s, v1 = acc[ai][bj][m][1] * s; const u32x4 q = h[bj];
                    u32x4 w; w.x = cvt_pk_bf16(__uint_as_float(q.x << 16) + v0[0], __uint_as_float(q.x & 0xffff0000u) + v0[1]); w.y = cvt_pk_bf16(__uint_as_float(q.y << 16) + v0[2], __uint_as_float(q.y & 0xffff0000u) + v0[3]);
                    w.z = cvt_pk_bf16(__uint_as_float(q.z << 16) + v1[0], __uint_as_float(q.z & 0xffff0000u) + v1[1]); w.w = cvt_pk_bf16(__uint_as_float(q.w << 16) + v1[2], __uint_as_float(q.w & 0xffff0000u) + v1[3]);
                    *(u32x4*)(rowp + bj * HALF) = w; }
                if (m & 1) asm volatile("" ::: "memory"); }
    }
};
__device__ __forceinline__ float silu_mul(float g, float u) { return g * __builtin_amdgcn_rcpf(1.0f + __expf(-g)) * u; }
struct EpiSwiGLU {
    static constexpr bool PERM = true, AFTER_DRAIN = false;
    bf16_t* O; int ldc;
    __device__ __forceinline__ void operator()(const f32x4 (&acc)[2][2][4][2], const Unit& u, int wr, int wc, int fr, int fq) const {
        const int row0 = u.r0 + wr * 64 + fr, col0 = u.pn * HALF + wc * 32 + 8 * fq;
#pragma unroll
        for (int ai = 0; ai < 2; ++ai)
#pragma unroll
            for (int m = 0; m < 4; ++m) { bf16_t* rowp = O + (size_t)(row0 + ai * HALF + m * 16) * ldc + col0;
                const f32x4 g0 = acc[ai][0][m][0], g1 = acc[ai][0][m][1], u0 = acc[ai][1][m][0], u1 = acc[ai][1][m][1];
                u32x4 w; w.x = cvt_pk_bf16(silu_mul(g0[0], u0[0]), silu_mul(g0[1], u0[1])); w.y = cvt_pk_bf16(silu_mul(g0[2], u0[2]), silu_mul(g0[3], u0[3]));
                w.z = cvt_pk_bf16(silu_mul(g1[0], u1[0]), silu_mul(g1[1], u1[1])); w.w = cvt_pk_bf16(silu_mul(g1[2], u1[2]), silu_mul(g1[3], u1[3]));
                *(u32x4*)rowp = w; }
    }
};
struct EpiSwiGLU8 {
    static constexpr bool PERM = true, AFTER_DRAIN = false;
    unsigned char* O; int ldc; float sg, so;
    __device__ __forceinline__ void operator()(const f32x4 (&acc)[2][2][4][2], const Unit& u, int wr, int wc, int fr, int fq) const {
        const int row0 = u.r0 + wr * 64 + fr, col0 = u.pn * HALF + wc * 32 + 8 * fq;
        const float ss = sg * sg * so;
#pragma unroll
        for (int ai = 0; ai < 2; ++ai)
#pragma unroll
            for (int m = 0; m < 4; ++m) { unsigned char* rowp = O + (size_t)(row0 + ai * HALF + m * 16) * ldc + col0;
                const f32x4 g0 = acc[ai][0][m][0], g1 = acc[ai][0][m][1], u0 = acc[ai][1][m][0], u1 = acc[ai][1][m][1];
                float a[8];
#pragma unroll
                for (int i = 0; i < 4; ++i) { a[i] = g0[i] * __builtin_amdgcn_rcpf(1.0f + __expf(-sg * g0[i])) * u0[i] * ss; a[4 + i] = g1[i] * __builtin_amdgcn_rcpf(1.0f + __expf(-sg * g1[i])) * u1[i] * ss; }
                u32x2v w; w.x = cvt4_fp8(a[0], a[1], a[2], a[3]); w.y = cvt4_fp8(a[4], a[5], a[6], a[7]);
                *(u32x2v*)rowp = w; }
    }
};
struct EpiMoeDown {
    static constexpr bool PERM = true, AFTER_DRAIN = false;
    bf16_t* Y0; bf16_t* Y1; const int* slot_tok; const float* slot_g; int ldc; float s;
    __device__ __forceinline__ void operator()(const f32x4 (&acc)[2][2][4][2], const Unit& u, int wr, int wc, int fr, int fq) const {
        const int row0 = u.r0 + wr * 64 + fr, col0 = u.pn * BM + wc * 32 + 8 * fq;
#pragma unroll
        for (int ai = 0; ai < 2; ++ai)
#pragma unroll
            for (int m = 0; m < 4; ++m) { const int slot = row0 + ai * HALF + m * 16; const int ti = slot_tok[slot]; const float g = slot_g[slot] * s;
                if (ti >= 0) { bf16_t* rowp = ((ti >> 16) ? Y1 : Y0) + (size_t)(ti & 0xffff) * ldc + col0;
#pragma unroll
                    for (int bj = 0; bj < 2; ++bj) { const f32x4 v0 = acc[ai][bj][m][0] * g, v1 = acc[ai][bj][m][1] * g;
                        u32x4 w; w.x = cvt_pk_bf16(v0[0], v0[1]); w.y = cvt_pk_bf16(v0[2], v0[3]); w.z = cvt_pk_bf16(v1[0], v1[1]); w.w = cvt_pk_bf16(v1[2], v1[3]);
                        *(u32x4*)(rowp + bj * HALF) = w; } } }
    }
};
struct GroupedOrder {
    int nM, nN, nwg, G, c; int p1, p2, p3, p4, p5, p6, p7; size_t estride; int bmajor;
    __device__ __forceinline__ bool next(int i, Unit& u) const {
        const long L = (long)i * G + c; if (L >= nwg) return false;
        int wgid = (int)L; { const int q = nwg / NXCD, r = nwg % NXCD, xcd = wgid % NXCD, off = wgid / NXCD; wgid = (xcd < r ? xcd * (q + 1) : r * (q + 1) + (xcd - r) * q) + off; }
        if (bmajor) {
            const int e = (wgid >= nN * p1) + (wgid >= nN * p2) + (wgid >= nN * p3) + (wgid >= nN * p4) + (wgid >= nN * p5) + (wgid >= nN * p6) + (wgid >= nN * p7);
            const int pe = e == 0 ? 0 : e == 1 ? p1 : e == 2 ? p2 : e == 3 ? p3 : e == 4 ? p4 : e == 5 ? p5 : e == 6 ? p6 : p7;
            const int pe1 = e == 0 ? p1 : e == 1 ? p2 : e == 2 ? p3 : e == 3 ? p4 : e == 4 ? p5 : e == 5 ? p6 : e == 6 ? p7 : nM;
            const int np = pe1 - pe, local = wgid - nN * pe, gsz = np * 7, pg = local / gsz, rem = local - pg * gsz, pmo = rem / 7;
            u.pm = pe + pmo; u.pn = pg * 7 + (rem - pmo * 7); u.r0 = 256 * u.pm; return true;
        }
        const int nig = WGM * nN, gid = wgid / nig, fm = gid * WGM, gsz = (nM - fm) < WGM ? (nM - fm) : WGM;
        u.pm = fm + ((wgid % nig) % gsz); u.pn = (wgid % nig) / gsz; u.r0 = 256 * u.pm; return true;
    }
    __device__ __forceinline__ const char* b_base(const Gemm& g, const Unit& u, size_t tstep) const {
        const int e = (u.pm >= p1) + (u.pm >= p2) + (u.pm >= p3) + (u.pm >= p4) + (u.pm >= p5) + (u.pm >= p6) + (u.pm >= p7);
        return (const char*)g.Bt + (size_t)e * estride + (size_t)u.pn * tstep; }
    __device__ __forceinline__ void a_ready(const Unit&) const {}
    __device__ __forceinline__ void done(const Unit&) const {}
};
template <class Epi, class Sched, bool ALIGN_EPI = false, bool SP2 = false, bool FP8 = false>
__device__ __forceinline__ void gemm_phase(PG8_LAS unsigned char* lds, const Gemm g, const Sched& S, const Epi& E, int tid_in) {
    int tid_ = tid_in; asm volatile("" : "+v"(tid_));
    const int tid = tid_, wid = __builtin_amdgcn_readfirstlane(tid >> 6), lane = tid & 63, wr = wid >> 2, wc = wid & 3, fr = lane & 15, fq = lane >> 4;
    const int K = g.K, nt = K / BK;
    unsigned voffA[2], voffB[2];
#pragma unroll
    for (int i = 0; i < 2; ++i) { int R, C; stage_rc(tid * 16 + i * 8192, R, C); const int Rb = Epi::PERM ? ((R & ~31) + perm32(R & 31)) : R;
        voffA[i] = (unsigned)(R * K + C) * 2u; voffB[i] = (unsigned)(Rb * K + C) * 2u; }
    const size_t kstep = (size_t)(BK * 2);
    const size_t hstep = (size_t)HALF * K * 2;
    const size_t tstep = 2 * hstep;
    const unsigned ldsw = (unsigned)wid * 1024u;
    const int aoff = lds_byte(wr * 64 + fr, fq * 8), boff = lds_byte(wc * 32 + fr, fq * 8);
#define PG8_SA(b, h) (((b) * 2 + (h)) * HTB)
#define PG8_SB(b, h) ((4 + (b) * 2 + (h)) * HTB)
#define PG8_STAGE(bufoff, gbase, voff) do { _Pragma("unroll") for (int _i = 0; _i < 2; ++_i) \
        __builtin_amdgcn_global_load_lds((const unsigned*)((const char*)(gbase) + (voff)[_i]), (PG8_LAS unsigned*)(lds + (bufoff) + ldsw + _i * 8192), 16, 0, 0); } while (0)
#define PG8_LDA(dst, b, h) do { _Pragma("unroll") for (int m = 0; m < 4; ++m) _Pragma("unroll") for (int k = 0; k < 2; ++k) { \
        if constexpr (FP8) { const i32x4v v_ = *(const PG8_LAS i32x4v*)(lds + PG8_SA(b, h) + aoff + m * 2048 + k * 1024); if (k == 0) dst##8[m].lo = v_; else dst##8[m].hi = v_; } \
        else dst[m][k] = *(const PG8_LAS bf16x8*)(lds + PG8_SA(b, h) + aoff + m * 2048 + k * 1024); } } while (0)
#define PG8_LDB(dst, b, h) do { _Pragma("unroll") for (int n = 0; n < 2; ++n) _Pragma("unroll") for (int k = 0; k < 2; ++k) { \
        if constexpr (FP8) { const i32x4v v_ = *(const PG8_LAS i32x4v*)(lds + PG8_SB(b, h) + boff + n * 2048 + k * 1024); if (k == 0) dst##8[n].lo = v_; else dst##8[n].hi = v_; } \
        else dst[n][k] = *(const PG8_LAS bf16x8*)(lds + PG8_SB(b, h) + boff + n * 2048 + k * 1024); } } while (0)
#define PG8_MMA(ai, bj, At, Bt) do { __builtin_amdgcn_s_setprio(1); _Pragma("unroll") for (int m = 0; m < 4; ++m) _Pragma("unroll") for (int n = 0; n < 2; ++n) { \
        if constexpr (FP8) asm volatile("v_mfma_scale_f32_16x16x128_f8f6f4 %0, %1, %2, %0, %3, %3 op_sel_hi:[0,0,0]" : "+v"(acc[ai][bj][m][n]) : "v"(Bt##8[n]), "v"(At##8[m]), "v"(sc7f));   \
        else { _Pragma("unroll") for (int k = 0; k < 2; ++k) acc[ai][bj][m][n] = __builtin_amdgcn_mfma_f32_16x16x32_bf16(Bt[n][k], At[m][k], acc[ai][bj][m][n], 0, 0, 0); } } \
        __builtin_amdgcn_s_setprio(0); } while (0)
#define PG8_WAIT_V(n) asm volatile("s_waitcnt vmcnt(" #n ")" ::: "memory")
#define PG8_WAIT_L(n) asm volatile("s_waitcnt lgkmcnt(" #n ")" ::: "memory")
#define PG8_BAR __builtin_amdgcn_s_barrier()
#define PG8_SCHED __builtin_amdgcn_sched_barrier(0)
    Unit cur, nxt; int ui = 0;
    if (!S.next(0, cur)) return;
    f32x4 acc[2][2][4][2];
#pragma unroll
    for (int a = 0; a < 2; ++a)
#pragma unroll
        for (int b = 0; b < 2; ++b)
#pragma unroll
            for (int m = 0; m < 4; ++m)
#pragma unroll
                for (int n = 0; n < 2; ++n) acc[a][b][m][n] = (f32x4){0.f, 0.f, 0.f, 0.f};
    int sc7f = 0x7f; asm volatile("" : "+v"(sc7f));
    bf16x8 At[4][2], B0[2][2], B1[2][2]; i32x8 At8[4], B08[2], B18[2];
    const char* cA = (const char*)g.A + (size_t)cur.r0 * K * 2; const char* cB = S.b_base(g, cur, tstep);
    S.a_ready(cur);
    if constexpr (SP2) {
        PG8_STAGE(PG8_SB(0, 0), cB, voffB); PG8_STAGE(PG8_SB(0, 1), cB + hstep, voffB); PG8_STAGE(PG8_SA(0, 0), cA, voffA); PG8_STAGE(PG8_SA(0, 1), cA + hstep, voffA);
        if (wr == 1) PG8_BAR;
        PG8_WAIT_V(2); PG8_BAR;
        PG8_STAGE(PG8_SB(1, 0), cB + kstep, voffB); PG8_STAGE(PG8_SA(1, 0), cA + kstep, voffA); PG8_STAGE(PG8_SB(1, 1), cB + hstep + kstep, voffB);
        PG8_WAIT_V(6); PG8_BAR;
    } else {
        PG8_STAGE(PG8_SB(0, 0), cB, voffB); PG8_STAGE(PG8_SA(0, 0), cA, voffA); PG8_STAGE(PG8_SB(0, 1), cB + hstep, voffB); PG8_STAGE(PG8_SA(0, 1), cA + hstep, voffA);
        if (wr == 1) PG8_BAR;
        PG8_WAIT_V(4); PG8_BAR;
        PG8_STAGE(PG8_SB(1, 0), cB + kstep, voffB); PG8_STAGE(PG8_SA(1, 0), cA + kstep, voffA); PG8_STAGE(PG8_SB(1, 1), cB + hstep + kstep, voffB);
        PG8_WAIT_V(6); PG8_BAR;
    }
    for (;;) {
        const bool has_next = S.next(ui + 1, nxt);
        const char* nA = has_next ? (const char*)g.A + (size_t)nxt.r0 * K * 2 : cA; const char* nB = has_next ? S.b_base(g, nxt, tstep) : cB;
        for (int t = 0; t < nt; t += 2) {
            const bool last = (t == nt - 2);
            const char* a1 = cA + (size_t)(t + 1) * kstep;
            const char* a2 = last ? nA : cA + (size_t)(t + 2) * kstep; const char* b2 = last ? nB : cB + (size_t)(t + 2) * kstep;
            const char* a3 = a2 + kstep; const char* b3 = b2 + kstep;
            if (last && has_next) S.a_ready(nxt);
            if constexpr (SP2) {
            PG8_LDB(B0, 0, 0); PG8_LDB(B1, 0, 1); PG8_SCHED; PG8_LDA(At, 0, 0); PG8_STAGE(PG8_SA(1, 1), a1 + hstep, voffA);
            PG8_WAIT_V(8); PG8_WAIT_L(0); PG8_BAR; PG8_MMA(0, 0, At, B0); PG8_MMA(0, 1, At, B1); PG8_BAR; PG8_SCHED;
            PG8_LDA(At, 0, 1); PG8_STAGE(PG8_SB(0, 0), b2, voffB); PG8_STAGE(PG8_SB(0, 1), b2 + hstep, voffB); PG8_STAGE(PG8_SA(0, 0), a2, voffA);
            PG8_WAIT_V(8); PG8_WAIT_L(0); PG8_BAR; PG8_MMA(1, 0, At, B0); PG8_MMA(1, 1, At, B1); PG8_BAR; PG8_SCHED;
            PG8_LDB(B0, 1, 0); PG8_LDB(B1, 1, 1); PG8_SCHED; PG8_LDA(At, 1, 0); PG8_STAGE(PG8_SA(0, 1), a2 + hstep, voffA);
            PG8_WAIT_V(8); PG8_WAIT_L(0); PG8_BAR; PG8_MMA(0, 0, At, B0); PG8_MMA(0, 1, At, B1); PG8_BAR; PG8_SCHED;
            PG8_LDA(At, 1, 1); PG8_STAGE(PG8_SB(1, 0), b3, voffB); PG8_STAGE(PG8_SB(1, 1), b3 + hstep, voffB); PG8_STAGE(PG8_SA(1, 0), a3, voffA);
            PG8_WAIT_V(8); PG8_WAIT_L(0); PG8_BAR; PG8_MMA(1, 0, At, B0); PG8_MMA(1, 1, At, B1); PG8_BAR; PG8_SCHED;
            } else {
            PG8_LDB(B0, 0, 0); PG8_SCHED; PG8_LDA(At, 0, 0); PG8_STAGE(PG8_SA(1, 1), a1 + hstep, voffA);
            PG8_WAIT_L(8); PG8_BAR; PG8_WAIT_L(0); PG8_MMA(0, 0, At, B0); PG8_BAR; PG8_SCHED;
            PG8_LDB(B1, 0, 1); PG8_STAGE(PG8_SB(0, 0), b2, voffB);
            PG8_BAR; PG8_WAIT_L(0); PG8_MMA(0, 1, At, B1); PG8_BAR;
            PG8_LDA(At, 0, 1); PG8_STAGE(PG8_SA(0, 0), a2, voffA);
            PG8_BAR; PG8_WAIT_L(0); PG8_MMA(1, 0, At, B0); PG8_BAR; PG8_SCHED;
            PG8_STAGE(PG8_SB(0, 1), b2 + hstep, voffB);
            PG8_WAIT_V(6); PG8_BAR; PG8_MMA(1, 1, At, B1); PG8_BAR;
            PG8_LDB(B0, 1, 0); PG8_SCHED; PG8_LDA(At, 1, 0); PG8_STAGE(PG8_SA(0, 1), a2 + hstep, voffA);
            PG8_WAIT_L(8); PG8_BAR; PG8_WAIT_L(0); PG8_MMA(0, 0, At, B0); PG8_BAR; PG8_SCHED;
            PG8_LDB(B1, 1, 1); PG8_STAGE(PG8_SB(1, 0), b3, voffB);
            PG8_BAR; PG8_WAIT_L(0); PG8_MMA(0, 1, At, B1); PG8_BAR;
            PG8_LDA(At, 1, 1); PG8_STAGE(PG8_SA(1, 0), a3, voffA);
            PG8_BAR; PG8_WAIT_L(0); PG8_MMA(1, 0, At, B0); PG8_BAR; PG8_SCHED;
            PG8_STAGE(PG8_SB(1, 1), b3 + hstep, voffB);
            PG8_WAIT_V(6); PG8_BAR; PG8_MMA(1, 1, At, B1); PG8_BAR;
            }
        }
        if constexpr (FP8) asm volatile("s_nop 15\n\ts_nop 15" ::: "memory");
        if constexpr (ALIGN_EPI) { if (wr == 0) PG8_BAR; }
        if constexpr (!Epi::AFTER_DRAIN) { E(acc, cur, wr, wc, fr, fq); S.done(cur); }
        if (!has_next) break;
#pragma unroll
        for (int a = 0; a < 2; ++a)
#pragma unroll
            for (int b = 0; b < 2; ++b)
#pragma unroll
                for (int m = 0; m < 4; ++m)
#pragma unroll
                    for (int n = 0; n < 2; ++n) acc[a][b][m][n] = (f32x4){0.f, 0.f, 0.f, 0.f};
        cur = nxt; cA = nA; cB = nB; ++ui;
        if constexpr (ALIGN_EPI) { if (wr == 1) PG8_BAR; }
    }
    PG8_WAIT_V(0);
    if constexpr (!ALIGN_EPI) { if (wr == 0) PG8_BAR; }
    PG8_BAR;
    if constexpr (Epi::AFTER_DRAIN) { E.fused(acc, cur, wr, wc, fr, fq, lds, wid, lane); S.done(cur); }
#undef PG8_SA
#undef PG8_SB
#undef PG8_STAGE
#undef PG8_LDA
#undef PG8_LDB
#undef PG8_MMA
#undef PG8_WAIT_V
#undef PG8_WAIT_L
#undef PG8_BAR
#undef PG8_SCHED
}
}
constexpr int BATCH = 4, SEQ = 4096, NMETA = 16, SL = SEQ + NMETA  , NT = BATCH * SL  , MP = 16640  , D = 1024;
constexpr int DSA_LDW = 2696, DSA_NP = 2816, DQ0 = 0, DK0 = 1024, DV0 = 1280, DIQ0 = 1536, DIK0 = 2560, DIW0 = 2688;
constexpr int ML_LDW = 3080, ML_NP = 3072, MQ0 = 0, MK0 = 512, MV0 = 1024, MO0 = 2048, MG0 = 3072;
constexpr int FF = 3584, GU = 7168, NE = 8;
constexpr int MOE_ROWS = 35072;
constexpr int NWAVES = 8, NTHREADS = 512;
#ifndef FP8_DENSE
#define FP8_DENSE 1
#endif
#ifndef FP8_MOE
#define FP8_MOE 1
#endif
constexpr float SW_GU = 32.0f, SW_DN = 128.0f, SA_ACT = 4.0f;
#ifndef CONV_IN_PROLOGUE
#define CONV_IN_PROLOGUE 0
#endif
#ifndef H_BF16
#define H_BF16 1
#endif
#ifndef MOE_GU_BMAJOR
#define MOE_GU_BMAJOR 0
#endif
#ifndef FP8_DSA
#define FP8_DSA 0
#endif
#ifndef FP8_DSA_IN
#define FP8_DSA_IN 0
#endif
constexpr float SW_DIN = 32.0f, SW_DOUT = 64.0f, SA_ATT = 16.0f;
constexpr int SCLD = 4128;
constexpr float RMS_EPS = 1e-6f;
constexpr size_t MiB = 1u << 20;
constexpr size_t WS_CTL = 0, CTL_ZERO_BYTES = 1 * MiB;
constexpr size_t WS_ROPE = 1 * MiB;
constexpr size_t WS_SM8 = 4 * MiB;
constexpr size_t WS_ROUTE = 5 * MiB;
constexpr size_t WS_MLG = 6 * MiB;
constexpr size_t WS_MLI = 17 * MiB + 256 * 1024;
constexpr size_t WS_NH = 7 * MiB;
constexpr size_t WS_SLOT = 8 * MiB;
constexpr size_t WS_SEL = 9 * MiB;
constexpr size_t WS_WDSA_IN = 18 * MiB, WS_WDSA_OUT = 29 * MiB, WS_WML_IN = 33 * MiB, WS_WML_OUT = 45 * MiB, WS_WFFN_GU = 49 * MiB, WS_WFFN_DN = 77 * MiB;
constexpr size_t WS_WMOE_GU = 91 * MiB, WS_WMOE_DN = 315 * MiB;
constexpr size_t WS_H = 427 * MiB;
constexpr size_t WS_XN = 492 * MiB;
constexpr size_t WS_R = 525 * MiB, WS_K8 = 875 * MiB, WS_XN8 = 875 * MiB, WS_END = 892 * MiB;
constexpr size_t R_PROJ = 0, R_SC = 90 * MiB, R_ACT = 0, R_DC = 98 * MiB, R_CH = 130 * MiB, R_AS = 240 * MiB, R_Y0 = 240 * MiB, R_Y1 = 274 * MiB;
static_assert(R_SC + (size_t)NT * SCLD * 4 + 16384 <= WS_K8 - WS_R, "score matrix (+ 8 KiB of never-read store slots behind it) fits");
static_assert((size_t)MOE_ROWS * FF * 2 <= R_AS && R_AS + (size_t)MOE_ROWS * D * 2 <= WS_K8 - WS_R, "moe buffers fit");
static_assert((size_t)MP * DSA_NP * 2 <= R_SC && (size_t)MP * ML_NP * 2 <= R_DC, "proj fits");
constexpr int CW_BAR = 4096;
constexpr int CW_CNT = 8192;
constexpr int LDS_BYTES = 151552;
constexpr int MISC_OFF = LDS_BYTES - 256;

#define GAS __attribute__((address_space(1)))
#define LAS __attribute__((address_space(3)))
typedef unsigned short bf16;
#if H_BF16
typedef unsigned short HT;
#else
typedef float HT;
#endif
typedef float f32x4 __attribute__((ext_vector_type(4)));
typedef float f32x2 __attribute__((ext_vector_type(2)));
typedef float f32x16 __attribute__((ext_vector_type(16)));
typedef short bf16x8 __attribute__((ext_vector_type(8)));
typedef short s16x4 __attribute__((ext_vector_type(4)));
typedef unsigned u32x4 __attribute__((ext_vector_type(4)));
typedef unsigned u32x2 __attribute__((ext_vector_type(2)));
#define MFMA32(a, b, c) __builtin_amdgcn_mfma_f32_32x32x16_bf16((a), (b), (c), 0, 0, 0)
#define MFMA16(a, b, c) __builtin_amdgcn_mfma_f32_16x16x32_bf16((a), (b), (c), 0, 0, 0)
__device__ __forceinline__ float bf2f(unsigned short b) { return __uint_as_float(((unsigned)b) << 16); }
__device__ __forceinline__ float bflo(unsigned w) { return __uint_as_float(w << 16); }
__device__ __forceinline__ float bfhi(unsigned w) { return __uint_as_float(w & 0xffff0000u); }
__device__ __forceinline__ unsigned pk2(float lo, float hi) { return pg8::cvt_pk_bf16(lo, hi); }
__device__ __forceinline__ float wave_sum(float v) {
#pragma unroll
    for (int o = 1; o < 64; o <<= 1) v += __shfl_xor(v, o);
    return v; }
__device__ __forceinline__ int crow(int r, int hi) { return (r & 3) + 8 * (r >> 2) + 4 * hi; }

#define XB_TMO      128
#define XB_XCNT(j)  (256  + 64 * (j))
#define XB_XSUB(j)  (1280 + 64 * (j))
#define XB_XGEN(j)  (2304 + 64 * (j))
#define XB_TOP      3328
#define XB_TOPGEN   3392
#define XCD_BAR_WORDS 3456
#define XB_SPIN_CAP (1u << 18)
__device__ __forceinline__ unsigned xb_ld(unsigned* p)              { return __hip_atomic_load(p, __ATOMIC_RELAXED, __HIP_MEMORY_SCOPE_AGENT); }
__device__ __forceinline__ unsigned xb_add(unsigned* p, unsigned v) { return __hip_atomic_fetch_add(p, v, __ATOMIC_RELAXED, __HIP_MEMORY_SCOPE_AGENT); }
__device__ __forceinline__ unsigned xb_xcc_id() { return (unsigned)__builtin_amdgcn_s_getreg((3 << 11) | 20) & 0xFu; }
#define XB_SPIN(cond, bar) do { unsigned _sp = 0; while (cond) { __builtin_amdgcn_s_sleep(1); \
    if ((++_sp & 255u) == 0u) { if (xb_ld(&(bar)[XB_TMO])) break; if (_sp > XB_SPIN_CAP) { atomicAdd(&(bar)[XB_TMO], 1u); break; } } } } while (0)
__device__ __forceinline__ int hw_lane() { int l; asm volatile("v_mbcnt_lo_u32_b32 %0, -1, 0\n\tv_mbcnt_hi_u32_b32 %0, -1, %0" : "=v"(l)); return l; }
struct XcdBarrier { unsigned* bar; unsigned x; volatile LAS unsigned* st; int wave; };
__device__ __forceinline__ XcdBarrier xcd_barrier_post(unsigned* bar, volatile LAS unsigned* st, int wave) {
    XcdBarrier b; b.bar = bar; b.x = xb_xcc_id(); b.st = st; b.wave = wave;
    if (wave == 0 && hw_lane() == 0) (void)xb_add(&bar[XB_XCNT(b.x)], 1u);
    return b;
}
__device__ __forceinline__ void xcd_barrier_complete(unsigned* bar, unsigned x, unsigned& nloc, unsigned& nx) {
    const unsigned G = gridDim.x * gridDim.y * gridDim.z;
    unsigned sum, cnt, mine, sp = 0u;
    for (;;) {
        sum = 0u; cnt = 0u; mine = 0u;
#pragma unroll
        for (unsigned j = 0; j < 16; ++j) { const unsigned c = xb_ld(&bar[XB_XCNT(j)]); sum += c; cnt += (c > 0u) ? 1u : 0u; mine = (j == x) ? c : mine; }
        if (sum == G) break;
        __builtin_amdgcn_s_sleep(1);
        if ((++sp & 255u) == 0u) { if (xb_ld(&bar[XB_TMO])) break; if (sp > XB_SPIN_CAP) { atomicAdd(&bar[XB_TMO], 1u); break; } }
    }
    nloc = mine > 0u ? mine : 1u; nx = cnt > 0u ? cnt : 1u;
}
__device__ __forceinline__ void xcd_barrier(const XcdBarrier& b) {
    asm volatile("s_waitcnt vmcnt(0)" ::: "memory");
    __syncthreads();
    if (b.wave == 0 && hw_lane() == 0) {
        unsigned* bar = b.bar;
        __builtin_amdgcn_s_waitcnt(0);
        unsigned nloc = b.st[0], nx = b.st[1];
        if (nloc == 0u) { xcd_barrier_complete(bar, b.x, nloc, nx); b.st[0] = nloc; b.st[1] = nx; }
        const unsigned old = xb_add(&bar[XB_XSUB(b.x)], 1u);
        const unsigned gen = old / nloc;
        if (old + 1u == (gen + 1u) * nloc) {
            __builtin_amdgcn_fence(__ATOMIC_RELEASE, "agent");
            asm volatile("s_waitcnt vmcnt(0)" ::: "memory");
            (void)xb_add(&bar[XB_TOP], 1u);
        }
        const unsigned target = (gen + 1u) * nx;
        XB_SPIN(xb_ld(&bar[XB_TOP]) < target, bar);
        __builtin_amdgcn_fence(__ATOMIC_ACQUIRE, "agent");
        asm volatile("s_waitcnt vmcnt(0)" ::: "memory");
    }
    __syncthreads();
}

struct Params { const float* in[20]; float* out; unsigned char* ws; int ph_lo, ph_hi; };
struct Ctx {
    LAS unsigned char* lds; int tid, lane, wave, G, bid, gw, ngw;
    unsigned* ctl;
    float2* rope; float* sm8; int* route_e; int* route_r1; int* route_r2; float* route_g1;
    float* mlf; float* mlc; float* mlp; float* mli; float* mlg; float* dn; float* nh; int* slot_tok; float* slot_g; unsigned short* sel;
    bf16 *wdsa_in, *wdsa_out, *wml_in, *wml_out, *wffn_gu, *wffn_dn, *wmoe_gu, *wmoe_dn;
    HT* H; bf16* XN; unsigned char* R; unsigned char* xn8;
};
__device__ __forceinline__ void conv_item(const float* W, int K, int ld, int n0, int k0, bf16* WT, int drow0, LAS float* scr, int lane) {
#pragma unroll 8
    for (int i = 0; i < 32; ++i) { const int kk = 2 * i + (lane >> 5); scr[kk * 33 + (lane & 31)] = W[(size_t)(k0 + kk) * ld + n0 + (lane & 31)]; }
    asm volatile("s_waitcnt lgkmcnt(0)" ::: "memory");
    const int c = lane & 7;
#pragma unroll
    for (int j = 0; j < 4; ++j) { const int n = (lane >> 3) + 8 * j; const LAS float* s = scr + (8 * c) * 33 + n;
        u32x4 o; o.x = pk2(s[0 * 33], s[1 * 33]); o.y = pk2(s[2 * 33], s[3 * 33]); o.z = pk2(s[4 * 33], s[5 * 33]); o.w = pk2(s[6 * 33], s[7 * 33]);
        *(u32x4*)(WT + (size_t)(drow0 + n) * K + k0 + 8 * c) = o; }
    asm volatile("s_waitcnt lgkmcnt(0)" ::: "memory");
}
__device__ __forceinline__ void conv_item8(const float* W, int K, int ld, int n0, int k0, unsigned char* WT, int drow0, LAS float* scr, int lane, float scale) {
#pragma unroll 8
    for (int i = 0; i < 32; ++i) { const int kk = 2 * i + (lane >> 5); scr[kk * 33 + (lane & 31)] = W[(size_t)(k0 + kk) * ld + n0 + (lane & 31)]; }
    asm volatile("s_waitcnt lgkmcnt(0)" ::: "memory");
    const int c = lane & 7;
#pragma unroll
    for (int j = 0; j < 4; ++j) { const int n = (lane >> 3) + 8 * j; const LAS float* s = scr + (8 * c) * 33 + n;
        u32x2 o; o.x = pg8::cvt4_fp8(s[0 * 33] * scale, s[1 * 33] * scale, s[2 * 33] * scale, s[3 * 33] * scale); o.y = pg8::cvt4_fp8(s[4 * 33] * scale, s[5 * 33] * scale, s[6 * 33] * scale, s[7 * 33] * scale);
        *(u32x2*)(WT + (size_t)(drow0 + n) * K + k0 + 8 * c) = o; }
    asm volatile("s_waitcnt lgkmcnt(0)" ::: "memory");
}
__device__ __forceinline__ void conv_plain8(const float* W, int K, int N, int ld, unsigned char* WT, int item, LAS float* scr, int lane, float scale) {
    const int nblk = N / 32, kb = item / nblk, nb = item % nblk;
    conv_item8(W, K, ld, 32 * nb, 64 * kb, WT, 32 * nb, scr, lane, scale);
}
__device__ __forceinline__ void conv_gu8(const float* W, int isup, unsigned char* WT, int item, LAS float* scr, int lane, float scale) {
    const int nblk = FF / 32, kb = item / nblk, nb = item % nblk, n0 = 32 * nb;
    conv_item8(W, D, FF, n0, 64 * kb, WT, 256 * (n0 >> 7) + 128 * isup + (n0 & 127), scr, lane, scale);
}
__device__ __forceinline__ void conv_plain(const float* W, int K, int N, int ld, bf16* WT, int item, LAS float* scr, int lane) {
    const int nblk = N / 32, kb = item / nblk, nb = item % nblk;
    conv_item(W, K, ld, 32 * nb, 64 * kb, WT, 32 * nb, scr, lane);
}
__device__ __forceinline__ void conv_gu(const float* W, int isup, bf16* WT, int item, LAS float* scr, int lane) {
    const int nblk = FF / 32, kb = item / nblk, nb = item % nblk, n0 = 32 * nb;
    conv_item(W, D, FF, n0, 64 * kb, WT, 256 * (n0 >> 7) + 128 * isup + (n0 & 127), scr, lane);
}
typedef const __attribute__((address_space(4))) Params* KArgP;
__device__ __forceinline__ void conv_big(const Ctx& C, KArgP P, int m, int r, LAS float* scr) {
    unsigned char* gu8d = (unsigned char*)C.wffn_gu; unsigned char* dn8d = (unsigned char*)C.wffn_dn; unsigned char* gu8m = (unsigned char*)C.wmoe_gu; unsigned char* dn8m = (unsigned char*)C.wmoe_dn;
    if (m < 2) { if (FP8_DENSE) conv_gu8(P->in[13] + (size_t)m * D * FF, 0, gu8d + (size_t)m * GU * D, r, scr, C.lane, SW_GU); else conv_gu(P->in[13] + (size_t)m * D * FF, 0, C.wffn_gu + (size_t)m * GU * D, r, scr, C.lane); }
    else if (m < 4) { if (FP8_DENSE) conv_gu8(P->in[14] + (size_t)(m - 2) * D * FF, 1, gu8d + (size_t)(m - 2) * GU * D, r, scr, C.lane, SW_GU); else conv_gu(P->in[14] + (size_t)(m - 2) * D * FF, 1, C.wffn_gu + (size_t)(m - 2) * GU * D, r, scr, C.lane); }
    else if (m < 6) { if (FP8_DENSE) conv_plain8(P->in[15] + (size_t)(m - 4) * FF * D, FF, D, D, dn8d + (size_t)(m - 4) * D * FF, r, scr, C.lane, SW_DN); else conv_plain(P->in[15] + (size_t)(m - 4) * FF * D, FF, D, D, C.wffn_dn + (size_t)(m - 4) * D * FF, r, scr, C.lane); }
    else if (m < 22) { if (FP8_MOE) conv_gu8(P->in[17] + (size_t)(m - 6) * D * FF, 0, gu8m + (size_t)(m - 6) * GU * D, r, scr, C.lane, SW_GU); else conv_gu(P->in[17] + (size_t)(m - 6) * D * FF, 0, C.wmoe_gu + (size_t)(m - 6) * GU * D, r, scr, C.lane); }
    else if (m < 38) { if (FP8_MOE) conv_gu8(P->in[18] + (size_t)(m - 22) * D * FF, 1, gu8m + (size_t)(m - 22) * GU * D, r, scr, C.lane, SW_GU); else conv_gu(P->in[18] + (size_t)(m - 22) * D * FF, 1, C.wmoe_gu + (size_t)(m - 22) * GU * D, r, scr, C.lane); }
    else { if (FP8_MOE) conv_plain8(P->in[19] + (size_t)(m - 38) * FF * D, FF, D, D, dn8m + (size_t)(m - 38) * D * FF, r, scr, C.lane, SW_DN); else conv_plain(P->in[19] + (size_t)(m - 38) * FF * D, FF, D, D, C.wmoe_dn + (size_t)(m - 38) * D * FF, r, scr, C.lane); }
}
struct ConvD { const float* src; unsigned char* dst; int K; float scale; };
template <int LD>
__device__ __forceinline__ void conv_ld32(const float* src, int lane, float (&v)[32]) {
    const float* p = src + (size_t)(lane >> 5) * LD + (lane & 31);
#pragma unroll
    for (int i = 0; i < 32; ++i) v[i] = p[(size_t)(2 * i) * LD];
}
__device__ __forceinline__ void conv_st8(const ConvD& d, const float (&v)[32], LAS float* scr, int lane) {
#pragma unroll
    for (int i = 0; i < 32; ++i) scr[(2 * i + (lane >> 5)) * 33 + (lane & 31)] = v[i];
    asm volatile("s_waitcnt lgkmcnt(0)" ::: "memory");
    const int c = lane & 7; const float scale = d.scale;
#pragma unroll
    for (int j = 0; j < 4; ++j) { const int n = (lane >> 3) + 8 * j; const LAS float* s = scr + (8 * c) * 33 + n;
        u32x2 o; o.x = pg8::cvt4_fp8(s[0 * 33] * scale, s[1 * 33] * scale, s[2 * 33] * scale, s[3 * 33] * scale); o.y = pg8::cvt4_fp8(s[4 * 33] * scale, s[5 * 33] * scale, s[6 * 33] * scale, s[7 * 33] * scale);
        *(u32x2*)(d.dst + (size_t)n * d.K + 8 * c) = o; }
    asm volatile("s_waitcnt lgkmcnt(0)" ::: "memory");
}
__device__ __forceinline__ bool conv_desc(const Ctx& C, KArgP P, int m, int r, ConvD& d) {
    unsigned char* gu8d = (unsigned char*)C.wffn_gu; unsigned char* dn8d = (unsigned char*)C.wffn_dn; unsigned char* gu8m = (unsigned char*)C.wmoe_gu; unsigned char* dn8m = (unsigned char*)C.wmoe_dn;
    const bool isdn = (m >= 4 && m < 6) || m >= 38;
    if (!isdn) {
        const int isup = (m >= 2 && m < 4) || (m >= 22); const int mm = m < 2 ? m : m < 4 ? m - 2 : m < 22 ? m - 6 : m - 22;
        const float* W = (m < 2 ? P->in[13] : m < 4 ? P->in[14] : m < 22 ? P->in[17] : P->in[18]) + (size_t)mm * D * FF;
        unsigned char* WT = (m < 4 ? gu8d : gu8m) + (size_t)mm * GU * D;
        const int nblk = FF / 32, kb = r / nblk, nb = r % nblk, n0 = 32 * nb, drow0 = 256 * (n0 >> 7) + 128 * isup + (n0 & 127);
        d.src = W + (size_t)(64 * kb) * FF + n0; d.dst = WT + (size_t)drow0 * D + 64 * kb; d.K = D; d.scale = SW_GU; return true;
    } else {
        const int mm = m < 6 ? m - 4 : m - 38;
        const float* W = (m < 6 ? P->in[15] : P->in[19]) + (size_t)mm * FF * D; unsigned char* WT = (m < 6 ? dn8d : dn8m) + (size_t)mm * D * FF;
        const int nblk = D / 32, kb = r / nblk, nb = r % nblk, n0 = 32 * nb;
        d.src = W + (size_t)(64 * kb) * D + n0; d.dst = WT + (size_t)n0 * FF + 64 * kb; d.K = FF; d.scale = SW_DN; return false;
    }
}
constexpr int CONV_TILE = 8 * (256 + 8) * 4;
__device__ __forceinline__ void conv_dma_issue(const ConvD& d, bool pitch_ff, int lane, LAS unsigned char* tile) {
    const unsigned ld = pitch_ff ? FF : D;
    const unsigned voff = ((unsigned)(lane >> 3) * ld + (unsigned)(lane & 7) * 4u) * 4u;
    const char* sb = (const char*)d.src;
#pragma unroll
    for (int t = 0; t < 8; ++t) { __builtin_amdgcn_global_load_lds((const unsigned*)(sb + voff), (LAS unsigned*)(tile + t * 1056), 16, 0, 0); sb += (size_t)ld * 32; }
}
__device__ __forceinline__ void conv_dma_finish(const ConvD& d, const LAS unsigned char* tile, int lane) {
    const int c = lane & 7; const float scale = d.scale;
#pragma unroll
    for (int j = 0; j < 4; ++j) { const int n = (lane >> 3) + 8 * j; const LAS float* s = (const LAS float*)tile + c * 264 + n;
        u32x2 o; o.x = pg8::cvt4_fp8(s[0 * 32] * scale, s[1 * 32] * scale, s[2 * 32] * scale, s[3 * 32] * scale); o.y = pg8::cvt4_fp8(s[4 * 32] * scale, s[5 * 32] * scale, s[6 * 32] * scale, s[7 * 32] * scale);
        *(u32x2*)(d.dst + (size_t)n * d.K + 8 * c) = o; }
    asm volatile("s_waitcnt lgkmcnt(0)" ::: "memory");
}
template <class MOf>
__device__ __forceinline__ void conv_stream(const Ctx& C, KArgP P, int first, int stride, int count, MOf m_of, int scr_pitch = 8448) {
    LAS float* scr = (LAS float*)(C.lds + C.wave * scr_pitch);
    int it = first; if (it >= count) return;
    ConvD da, db; float va[32], vb[32];
#define CONV_LOAD(d, v, i_) do { const bool g_ = conv_desc(C, P, m_of((i_) / 1792), (i_) % 1792, d); if (g_) conv_ld32<FF>(d.src, C.lane, v); else conv_ld32<D>(d.src, C.lane, v); } while (0)
    CONV_LOAD(da, va, it);
    for (;;) {
        const bool hb = it + stride < count;
        if (hb) CONV_LOAD(db, vb, it + stride);
        conv_st8(da, va, scr, C.lane);
        if (!hb) break;
        it += 2 * stride; const bool ha = it < count;
        if (ha) CONV_LOAD(da, va, it);
        conv_st8(db, vb, scr, C.lane);
        if (!ha) break;
    }
#undef CONV_LOAD
}
constexpr int CONV_IB = 1792;
__device__ __forceinline__ void conv_pair(const Ctx& C, KArgP P, int j) {
    conv_stream(C, P, C.gw, C.ngw, 27 * CONV_IB, [j](int q) { return q < 3 ? 2 * q + j : q < 11 ? 6 + 8 * j + (q - 3) : q < 19 ? 22 + 8 * j + (q - 11) : 38 + 8 * j + (q - 19); });
}
__device__ __forceinline__ void prologue_phase(const Ctx& C, KArgP P) {
    LAS float* scr = (LAS float*)(C.lds + C.wave * 8448);
    constexpr int IB = CONV_IB;
    constexpr int N_BIG = CONV_IN_PROLOGUE ? 54 * IB : 0;
    constexpr int I_DIN = 16 * 84, I_SQ = 16 * 32, I_MIN = 16 * 96;
    constexpr int N_SMALL = 2 * (I_DIN + I_SQ + I_MIN + I_SQ);
    if (N_BIG) conv_stream(C, P, C.gw, C.ngw, N_BIG, [](int q) { return q; });
    for (int it = C.gw; it < N_SMALL; it += C.ngw) {
        {
            int r = it;
            const int j = r / (N_SMALL / 2); r -= j * (N_SMALL / 2);
            if (r < I_DIN) { if (FP8_DSA_IN) conv_plain8(P->in[4] + (size_t)j * D * DSA_LDW, D, 2688, DSA_LDW, (unsigned char*)C.wdsa_in + (size_t)j * DSA_NP * D, r, scr, C.lane, SW_DIN);
                             else conv_plain(P->in[4] + (size_t)j * D * DSA_LDW, D, 2688, DSA_LDW, C.wdsa_in + (size_t)j * DSA_NP * D, r, scr, C.lane); continue; } r -= I_DIN;
            if (r < I_SQ) { if (FP8_DSA) conv_plain8(P->in[7] + (size_t)j * D * D, D, D, D, (unsigned char*)C.wdsa_out + (size_t)j * D * D, r, scr, C.lane, SW_DOUT);
                            else conv_plain(P->in[7] + (size_t)j * D * D, D, D, D, C.wdsa_out + (size_t)j * D * D, r, scr, C.lane); continue; } r -= I_SQ;
            if (r < I_MIN) { conv_plain(P->in[8] + (size_t)j * D * ML_LDW, D, ML_NP, ML_LDW, C.wml_in + (size_t)j * ML_NP * D, r, scr, C.lane); continue; } r -= I_MIN;
            conv_plain(P->in[12] + (size_t)j * D * D, D, D, D, C.wml_out + (size_t)j * D * D, r, scr, C.lane);
        }
    }
    const int gt = C.bid * NTHREADS + C.tid, ngt = C.G * NTHREADS;
    for (int i = gt; i < 2 * 128 * D / 8; i += ngt) { const int j = i / (128 * D / 8), o = i % (128 * D / 8);
        if (FP8_DSA_IN) { if (o < 128 * D / 16) *(u32x4*)((unsigned char*)C.wdsa_in + (size_t)j * DSA_NP * D + (size_t)2688 * D + (size_t)o * 16) = (u32x4){0u, 0u, 0u, 0u}; }
        else *(u32x4*)(C.wdsa_in + (size_t)j * DSA_NP * D + (size_t)2688 * D + (size_t)o * 8) = (u32x4){0u, 0u, 0u, 0u}; }
    for (int i = gt; i < (MP - NT) * D / 8; i += ngt) *(u32x4*)(C.XN + (size_t)NT * D + (size_t)i * 8) = (u32x4){0u, 0u, 0u, 0u};
    const float* x = P->in[0]; const float* meta = P->in[1];
    for (int i = gt; i < MP * (D / 4); i += ngt) { const int row = i / (D / 4), c4 = i % (D / 4); f32x4 v = (f32x4){0.f, 0.f, 0.f, 0.f};
        if (row < NT) { const int b = row / SL, p = row % SL;
            v = (p < NMETA) ? *(const f32x4*)(meta + (size_t)p * D + c4 * 4) : *(const f32x4*)(x + ((size_t)b * SEQ + (p - NMETA)) * D + c4 * 4); }
#if H_BF16
        u32x2 hv; hv.x = pk2(v[0], v[1]); hv.y = pk2(v[2], v[3]); *(u32x2*)(C.H + (size_t)row * D + c4 * 4) = hv; }
#else
        *(f32x4*)(C.H + (size_t)row * D + c4 * 4) = v; }
#endif
    for (int i = gt; i < SL * 64; i += ngt) { const int pos = i >> 6, k = i & 63; double inv = 1.0;
        for (int q = 0; q < k; ++q) inv *= 0.86596432336006535;
        const double a = (double)pos * inv; C.rope[i] = make_float2((float)cos(a), (float)sin(a)); }
}

template <int MODE, bool ADDY, bool OUT8 = false>
__device__ __forceinline__ void norm_phase(const Ctx& C, const float* gain, const float* W8, int ldw, int moe_layer, const float* aux0 = nullptr, const float* aux1 = nullptr) {
    const bf16* Y0 = (const bf16*)(C.R + R_Y0); const bf16* Y1 = (const bf16*)(C.R + R_Y1);
    const int lane = C.lane;
    float w8r[4][4][8];
    if (MODE != 3) {
#pragma unroll
        for (int j = 0; j < 4; ++j)
#pragma unroll
            for (int i = 0; i < 4; ++i) { const float* wp = W8 + (size_t)(256 * j + 4 * lane + i) * ldw; const f32x4 w0 = *(const f32x4*)wp, w1 = *(const f32x4*)(wp + 4);
                w8r[j][i][0] = w0[0]; w8r[j][i][1] = w0[1]; w8r[j][i][2] = w0[2]; w8r[j][i][3] = w0[3]; w8r[j][i][4] = w1[0]; w8r[j][i][5] = w1[1]; w8r[j][i][6] = w1[2]; w8r[j][i][7] = w1[3]; }
    }
    f32x4 gv[4];
#pragma unroll
    for (int j = 0; j < 4; ++j) gv[j] = ((const f32x4*)gain)[64 * j + C.lane];
    int prow = -1, pe = 0, pr1 = 0, pr2 = 0; float pg1 = 0.f;
#if H_BF16
    u32x2 hq[4], ya[4], yb[4];
#define NORM_ISSUE(row_) do { const HT* hr_ = C.H + (size_t)(row_) * D; _Pragma("unroll") for (int j = 0; j < 4; ++j) hq[j] = ((const u32x2*)hr_)[64 * j + C.lane]; \
        if (ADDY) { _Pragma("unroll") for (int j = 0; j < 4; ++j) { ya[j] = *(const u32x2*)(Y0 + (size_t)(row_) * D + 256 * j + 4 * C.lane); yb[j] = *(const u32x2*)(Y1 + (size_t)(row_) * D + 256 * j + 4 * C.lane); } } } while (0)
    if (C.gw < NT) NORM_ISSUE(C.gw);
#endif
    for (int row = C.gw; row < NT; row += C.ngw) {
        HT* hrow = C.H + (size_t)row * D;
        f32x4 v[4]; float ss = 0.f;
#if H_BF16
#pragma unroll
        for (int j = 0; j < 4; ++j) { v[j][0] = bflo(hq[j].x); v[j][1] = bfhi(hq[j].x); v[j][2] = bflo(hq[j].y); v[j][3] = bfhi(hq[j].y); }
        if (ADDY) {
#pragma unroll
            for (int j = 0; j < 4; ++j) { const u32x2 a = ya[j], b = yb[j];
                v[j][0] += bflo(a.x) + bflo(b.x); v[j][1] += bfhi(a.x) + bfhi(b.x); v[j][2] += bflo(a.y) + bflo(b.y); v[j][3] += bfhi(a.y) + bfhi(b.y);
                { u32x2 hv; hv.x = pk2(v[j][0], v[j][1]); hv.y = pk2(v[j][2], v[j][3]); ((u32x2*)hrow)[64 * j + C.lane] = hv; } }
        }
        if (row + C.ngw < NT) NORM_ISSUE(row + C.ngw);
#else
#pragma unroll
        for (int j = 0; j < 4; ++j) v[j] = ((const f32x4*)hrow)[64 * j + C.lane];
        if (ADDY) {
#pragma unroll
            for (int j = 0; j < 4; ++j) { const u32x2 a = *(const u32x2*)(Y0 + (size_t)row * D + 256 * j + 4 * C.lane), b = *(const u32x2*)(Y1 + (size_t)row * D + 256 * j + 4 * C.lane);
                v[j][0] += bflo(a.x) + bflo(b.x); v[j][1] += bfhi(a.x) + bfhi(b.x); v[j][2] += bflo(a.y) + bflo(b.y); v[j][3] += bfhi(a.y) + bfhi(b.y);
                ((f32x4*)hrow)[64 * j + C.lane] = v[j]; }
        }
#endif
#pragma unroll
        for (int j = 0; j < 4; ++j) ss += (v[j][0] * v[j][0] + v[j][1] * v[j][1]) + (v[j][2] * v[j][2] + v[j][3] * v[j][3]);
        const float rstd = 1.0f / sqrtf(wave_sum(ss) * (1.0f / D) + RMS_EPS);
#pragma unroll
        for (int j = 0; j < 4; ++j) { const f32x4 g = gv[j]; v[j] = v[j] * rstd * g;
            if (OUT8) *(unsigned*)(C.xn8 + (size_t)row * D + 256 * j + 4 * C.lane) = pg8::cvt4_fp8(v[j][0], v[j][1], v[j][2], v[j][3]);
            else { u32x2 o; o.x = pk2(v[j][0], v[j][1]); o.y = pk2(v[j][2], v[j][3]); *(u32x2*)(C.XN + (size_t)row * D + 256 * j + 4 * C.lane) = o; } }
        if (MODE != 3) {
            float dot[8];
#pragma unroll
            for (int e = 0; e < 8; ++e) dot[e] = 0.f;
#pragma unroll
            for (int j = 0; j < 4; ++j)
#pragma unroll
                for (int i = 0; i < 4; ++i) { const float y = v[j][i];
#pragma unroll
                    for (int e = 0; e < 8; ++e) dot[e] = fmaf(y, w8r[j][i][e], dot[e]); }
            float r4[4], r2[2], r1;
#pragma unroll
            for (int k = 0; k < 4; ++k) { const float send = (lane & 1) ? dot[k] : dot[4 + k], keep = (lane & 1) ? dot[4 + k] : dot[k]; r4[k] = keep + __shfl_xor(send, 1); }
#pragma unroll
            for (int k = 0; k < 2; ++k) { const float send = (lane & 2) ? r4[k] : r4[2 + k], keep = (lane & 2) ? r4[2 + k] : r4[k]; r2[k] = keep + __shfl_xor(send, 2); }
            { const float send = (lane & 4) ? r2[0] : r2[1], keep = (lane & 4) ? r2[1] : r2[0]; r1 = keep + __shfl_xor(send, 4); }
            r1 += __shfl_xor(r1, 8); r1 += __shfl_xor(r1, 16); r1 += __shfl_xor(r1, 32);
            const int ev = 4 * (lane & 1) + 2 * ((lane >> 1) & 1) + ((lane >> 2) & 1);
            if (MODE == 0) { if (lane < 8) C.sm8[(size_t)row * 8 + ev] = r1 * 0.03125f; }
            if (MODE == 1) {
                if (lane < 8) { const int b = row / SL, pos = row % SL, sl_ = pos / 65, si = pos % 65, h = ev & 3;
                    const float z = (r1 + (ev < 4 ? aux0[h] : aux1[h])) * (2.0f / 15.0f);
                    const float x = 15.0f * (1.0f - 2.0f / (1.0f + __expf(z)));
                    float* dst = (ev < 4 ? C.mli : C.mlg) + ((b * 4 + h) * 65 + si) * 64 + sl_;
                    *dst = (ev < 4) ? x : fminf(x, 0.f) - __logf(1.0f + __expf(-fabsf(x))); } }
            if (MODE == 2) {
#pragma unroll
                for (int e = 0; e < 8; ++e) dot[e] = __shfl(r1, (e >> 2) + 2 * ((e >> 1) & 1) + 4 * (e & 1));
                if (lane == 0) {
                    float v1 = dot[0]; int e1 = 0;
#pragma unroll
                    for (int e = 1; e < 8; ++e) if (dot[e] > v1) { v1 = dot[e]; e1 = e; }
                    float v2 = -INFINITY; int e2 = 0;
#pragma unroll
                    for (int e = 0; e < 8; ++e) if (e != e1 && dot[e] > v2) { v2 = dot[e]; e2 = e; }
                    const float g1 = 1.0f / (1.0f + expf(v2 - v1));
                    const int r1i = (int)atomicAdd(C.ctl + CW_CNT + (moe_layer * 8 + e1) * 64, 1u), r2i = (int)atomicAdd(C.ctl + CW_CNT + (moe_layer * 8 + e2) * 64, 1u);
                    if (prow >= 0) { C.route_e[prow] = pe; C.route_r1[prow] = pr1; C.route_r2[prow] = pr2; C.route_g1[prow] = pg1; }
                    prow = row; pe = e1 | (e2 << 8); pr1 = r1i; pr2 = r2i; pg1 = g1;
                }
            }
        }
    }
    if (MODE == 2) { if (lane == 0 && prow >= 0) { C.route_e[prow] = pe; C.route_r1[prow] = pr1; C.route_r2[prow] = pr2; C.route_g1[prow] = pg1; } }
#if H_BF16
#undef NORM_ISSUE
#endif
}

__device__ __forceinline__ void unpack8(const u32x4 w, float (&x)[8]) { x[0] = bflo(w.x); x[1] = bfhi(w.x); x[2] = bflo(w.y); x[3] = bfhi(w.y); x[4] = bflo(w.z); x[5] = bfhi(w.z); x[6] = bflo(w.w); x[7] = bfhi(w.w); }
__device__ __forceinline__ u32x4 pack8(const float (&x)[8]) { u32x4 w; w.x = pk2(x[0], x[1]); w.y = pk2(x[2], x[3]); w.z = pk2(x[4], x[5]); w.w = pk2(x[6], x[7]); return w; }
__device__ __forceinline__ void dsa_post_phase(const Ctx& C, const float* gq, const float* gk) {
    bf16* PROJ = (bf16*)(C.R + R_PROJ);
    for (int row = C.gw; row < NT; row += C.ngw) {
        const int pos = row % SL; bf16* pr = PROJ + (size_t)row * DSA_NP; const float2* rp = C.rope + (size_t)pos * 64;
        const int lane = C.lane;
#pragma unroll
        for (int pass = 0; pass < 2; ++pass) {
            if (pass == 1 && lane >= 16) break;
            const int head = lane >> 2, part = lane & 3; bf16* hp = pr + (pass == 0 ? DQ0 : DK0) + head * 64 + 8 * part; const float* gg = pass == 0 ? gq : gk;
            float x1[8], x2[8]; unpack8(*(const u32x4*)hp, x1); unpack8(*(const u32x4*)(hp + 32), x2);
            float ss = 0.f;
#pragma unroll
            for (int e = 0; e < 8; ++e) ss += x1[e] * x1[e] + x2[e] * x2[e];
            ss += __shfl_xor(ss, 1); ss += __shfl_xor(ss, 2);
            const float rstd = 1.0f / sqrtf(ss * (1.0f / 64.0f) + RMS_EPS), osc = pass == 0 ? 0.125f : 1.0f;
#pragma unroll
            for (int e = 0; e < 8; ++e) { const int i = 8 * part + e; const float2 cs = rp[2 * i];
                const float y1 = x1[e] * rstd * gg[i], y2 = x2[e] * rstd * gg[i + 32];
                x1[e] = (y1 * cs.x - y2 * cs.y) * osc; x2[e] = (y2 * cs.x + y1 * cs.y) * osc; }
            *(u32x4*)hp = pack8(x1); *(u32x4*)(hp + 32) = pack8(x2);
        }
#pragma unroll
        for (int pass = 0; pass < 2; ++pass) {
            if (pass == 1 && lane >= 8) break;
            const int head = lane >> 3, part = lane & 7; bf16* hp = pr + (pass == 0 ? DIQ0 + head * 128 : DIK0) + 8 * part;
            float x1[8], x2[8]; unpack8(*(const u32x4*)hp, x1); unpack8(*(const u32x4*)(hp + 64), x2);
#pragma unroll
            for (int e = 0; e < 8; ++e) { const float2 cs = rp[8 * part + e]; const float y1 = x1[e], y2 = x2[e];
                x1[e] = y1 * cs.x - y2 * cs.y; x2[e] = y2 * cs.x + y1 * cs.y; }
            *(u32x4*)hp = pack8(x1); *(u32x4*)(hp + 64) = pack8(x2);
        }
    }
}
__device__ __forceinline__ void score_phase(const Ctx& C) {
    const bf16* PROJ = (const bf16*)(C.R + R_PROJ); float* SC = (float*)(C.R + R_SC);
    const int lane = C.lane, m31 = lane & 31, hi = lane >> 5, w = C.wave;
    const int aq = 2 * (m31 >> 4) + ((m31 >> 2) & 1), ah = 4 * ((m31 >> 3) & 1) + (m31 & 3);
    constexpr int SCP = 1088, SCB = 8 * SCP;
    LAS unsigned char* ring = C.lds;
    const LAS unsigned char* bfp = ring + (m31 >> 2) * SCP + 64 * hi + 16 * (m31 & 3);
    constexpr int TPB = 65 + 57 + 49 + 41 + 33 + 25 + 17 + 9 + 1;
    for (int t = C.bid; t < BATCH * TPB; t += C.G) {
        const int b = t / TPB, tt = t % TPB;
        const int kc = (tt >= 65) + (tt >= 122) + (tt >= 171) + (tt >= 212) + (tt >= 245) + (tt >= 270) + (tt >= 287) + (tt >= 296);
        const int toff = 65 * kc - 4 * kc * (kc - 1);
        const int qg = 64 * kc + 8 * (tt - toff) + w; const bool act = qg < 514;
        const int qgc = act ? qg : 513, q0 = 8 * qgc, k0 = 512 * kc;
        const int qlast = 64 * kc + 8 * (tt - toff) + 7, qmax = (qlast < 514 ? qlast : 513) * 8 + 8;
        const int kendw = (k0 + 512 < q0 + 8) ? k0 + 512 : q0 + 8;
        const int kendg = (k0 + 512 < qmax) ? k0 + 512 : qmax;
        const int nkt = (kendg - k0 + 31) >> 5, nktw = act ? (kendw - k0 + 31) >> 5 : 0;
        bf16x8 a[2][8]; f32x4 wv[2][4];
#pragma unroll
        for (int rb = 0; rb < 2; ++rb) {
            const bf16* ap = PROJ + (size_t)(b * SL + q0 + 4 * rb + aq) * DSA_NP + DIQ0 + ah * 128 + 8 * hi;
#pragma unroll
            for (int ks = 0; ks < 8; ++ks) a[rb][ks] = *(const bf16x8*)(ap + 16 * ks);
            const float* w0 = C.sm8 + (size_t)(b * SL + q0 + 4 * rb + hi) * 8; const float* w1 = w0 + 16;
            wv[rb][0] = *(const f32x4*)w0; wv[rb][1] = *(const f32x4*)(w0 + 4); wv[rb][2] = *(const f32x4*)w1; wv[rb][3] = *(const f32x4*)(w1 + 4);
        }
        float* sc0 = SC + (size_t)(b * SL + q0 + hi) * SCLD;
        const bf16* ikb = PROJ + (size_t)b * SL * DSA_NP + DIK0 + (lane >> 2) * 8;
        const int kr0 = k0 + 4 * w + (lane & 3);
#define SC_ISSUE(kt_) do { if ((kt_) < nkt) { const int key_ = kr0 + 32 * (kt_), kc_ = key_ < SL ? key_ : SL - 1; \
            __builtin_amdgcn_global_load_lds((const unsigned*)(ikb + (size_t)kc_ * DSA_NP), (LAS unsigned*)(ring + ((kt_) & 3) * SCB + w * SCP), 16, 0, 0); } } while (0)
        asm volatile("s_waitcnt vmcnt(0)" ::: "memory");
#pragma unroll
        for (int rb = 0; rb < 2; ++rb) {
#pragma unroll
            for (int ks = 0; ks < 8; ++ks) asm volatile("" : "+v"(a[rb][ks]));
#pragma unroll
            for (int q = 0; q < 4; ++q) asm volatile("" : "+v"(wv[rb][q])); }
        __builtin_amdgcn_s_barrier();
        SC_ISSUE(0); SC_ISSUE(1); SC_ISSUE(2);
        float* dum = SC + (size_t)NT * SCLD + 4 * C.tid;
        for (int kt = 0; kt < nkt; ++kt) {
            { const int cnt = 4 * (kt < 3 ? kt : 3) + (kt + 1 < nkt) + (kt + 2 < nkt);
              switch (cnt) { case 0: asm volatile("s_waitcnt vmcnt(0)" ::: "memory"); break; case 1: asm volatile("s_waitcnt vmcnt(1)" ::: "memory"); break; case 2: asm volatile("s_waitcnt vmcnt(2)" ::: "memory"); break;
                case 4: asm volatile("s_waitcnt vmcnt(4)" ::: "memory"); break; case 5: asm volatile("s_waitcnt vmcnt(5)" ::: "memory"); break; case 6: asm volatile("s_waitcnt vmcnt(6)" ::: "memory"); break;
                case 8: asm volatile("s_waitcnt vmcnt(8)" ::: "memory"); break; case 9: asm volatile("s_waitcnt vmcnt(9)" ::: "memory"); break; case 10: asm volatile("s_waitcnt vmcnt(10)" ::: "memory"); break;
                case 12: asm volatile("s_waitcnt vmcnt(12)" ::: "memory"); break; case 13: asm volatile("s_waitcnt vmcnt(13)" ::: "memory"); break; default: asm volatile("s_waitcnt vmcnt(14)" ::: "memory"); break; } }
            __builtin_amdgcn_s_barrier();
            asm volatile("" ::: "memory");
            SC_ISSUE(kt + 3);
            asm volatile("" ::: "memory");
            const int key = k0 + 32 * kt + m31;
            float v00 = 0.f, v01 = 0.f, v10 = 0.f, v11 = 0.f;
            if (kt < nktw) {
                const LAS unsigned char* bp = bfp + (kt & 3) * SCB;
                bf16x8 bf_[8];
#pragma unroll
                for (int ks = 0; ks < 8; ++ks) bf_[ks] = *(const LAS bf16x8*)(bp + 128 * ks);
                asm volatile("s_waitcnt lgkmcnt(0)" ::: "memory");
                f32x16 acc0, acc1;
#pragma unroll
                for (int r = 0; r < 16; ++r) { acc0[r] = 0.f; acc1[r] = 0.f; }
#pragma unroll
                for (int ks = 0; ks < 8; ++ks) { acc0 = MFMA32(a[0][ks], bf_[ks], acc0); acc1 = MFMA32(a[1][ks], bf_[ks], acc1); }
#pragma unroll
                for (int e = 0; e < 8; ++e) { v00 = fmaf(fmaxf(acc0[e], 0.f), wv[0][e >> 2][e & 3], v00); v01 = fmaf(fmaxf(acc0[8 + e], 0.f), wv[0][2 + (e >> 2)][e & 3], v01);
                    v10 = fmaf(fmaxf(acc1[e], 0.f), wv[1][e >> 2][e & 3], v10); v11 = fmaf(fmaxf(acc1[8 + e], 0.f), wv[1][2 + (e >> 2)][e & 3], v11); }
            }
            const bool okst = kt < nktw && key < kendw;
            float* p0 = okst ? sc0 + key : dum; float* p1 = okst ? sc0 + (size_t)2 * SCLD + key : dum + 1; float* p2 = okst ? sc0 + (size_t)4 * SCLD + key : dum + 2; float* p3 = okst ? sc0 + (size_t)6 * SCLD + key : dum + 3;
            asm volatile("" ::: "memory");
            __builtin_nontemporal_store(v00, p0); __builtin_nontemporal_store(v01, p1); __builtin_nontemporal_store(v10, p2); __builtin_nontemporal_store(v11, p3);
            asm volatile("" ::: "memory");
        }
#undef SC_ISSUE
    }
}

template <int NR>
__device__ __forceinline__ void topk_keys(const float* sr, unsigned (&k)[NR], int n, int lane) {
    float v[NR];
#pragma unroll
    for (int j = 0; j < NR; ++j) { const int idx = 64 * j + lane; v[j] = __builtin_nontemporal_load(sr + (idx < n ? idx : n - 1)); }
#pragma unroll
    for (int j = 0; j < NR; ++j) { const int idx = 64 * j + lane; const unsigned u = __float_as_uint(v[j] + 0.0f); const unsigned key = (u & 0x80000000u) ? ~u : (u | 0x80000000u);
        k[j] = idx < n ? key : 0u; }
}
constexpr int TOPK_MID_BIT = -1, TOPK_MID_NR = 40;
template <int NR, class Mid>
__device__ __forceinline__ void topk_select(const unsigned (&k)[NR], unsigned short* sel, int lane, Mid mid) {
    unsigned T = 0u; bool exact = false;
    for (int bit = 31; bit >= 0; --bit) {
        if (bit == TOPK_MID_BIT) mid();
        const unsigned cand = T | (1u << bit); int cl = 0;
#define TK_CA(n_) "v_cmp_ge_u32 vcc, %" #n_ ", %1\n\tv_addc_co_u32 %0, vcc, 0, %0, vcc\n\t"
#pragma unroll
        for (int j = 0; j + 8 <= NR; j += 8)
            asm(TK_CA(2) TK_CA(3) TK_CA(4) TK_CA(5) TK_CA(6) TK_CA(7) TK_CA(8) TK_CA(9) : "+v"(cl) : "v"(cand), "v"(k[j]), "v"(k[j + 1]), "v"(k[j + 2]), "v"(k[j + 3]), "v"(k[j + 4]), "v"(k[j + 5]), "v"(k[j + 6]), "v"(k[j + 7]) : "vcc");
#pragma unroll
        for (int j = NR & ~7; j < NR; ++j) asm("v_cmp_ge_u32 vcc, %1, %2\n\tv_addc_co_u32 %0, vcc, 0, %0, vcc" : "+v"(cl) : "v"(k[j]), "v"(cand) : "vcc");
#undef TK_CA
        int cnt = 0;
#pragma unroll
        for (int bb = 0; bb < 7; ++bb) cnt += __popcll(__ballot((cl >> bb) & 1)) << bb;
        if (cnt >= 256) { T = cand; if (cnt == 256) { exact = true; break; } }
    }
    int base = 0;
#pragma unroll
    for (int j = 0; j < NR; ++j) { const bool f = exact ? (k[j] >= T) : (k[j] > T); const unsigned long long mk = __ballot(f);
        if (f) sel[base + __builtin_amdgcn_mbcnt_hi((unsigned)(mk >> 32), __builtin_amdgcn_mbcnt_lo((unsigned)mk, 0u))] = (unsigned short)(64 * j + lane);
        base += __popcll(mk); }
    if (!exact) {
#pragma unroll
        for (int j = 0; j < NR; ++j) { const bool f = (k[j] == T); const unsigned long long mk = __ballot(f);
            const int p = base + (int)__builtin_amdgcn_mbcnt_hi((unsigned)(mk >> 32), __builtin_amdgcn_mbcnt_lo((unsigned)mk, 0u));
            if (f && p < 256) sel[p] = (unsigned short)(64 * j + lane);
            base += __popcll(mk); }
    }
}
__device__ __forceinline__ int conv_m_of(int q, int j) { return q < 3 ? 2 * q + j : q < 11 ? 6 + 8 * j + (q - 3) : q < 19 ? 22 + 8 * j + (q - 11) : 38 + 8 * j + (q - 19); }
template <bool CONV>
__device__ __forceinline__ void topk_phase_t(const Ctx& C, KArgP P, int j) {
    const float* SC = (const float*)(C.R + R_SC);
    LAS unsigned char* tile0 = C.lds + C.wave * (2 * CONV_TILE); LAS unsigned char* tile1 = tile0 + CONV_TILE;
    constexpr int pcount = CONV ? 27 * (CONV_IB / 2) : 0;
    int cit = C.gw; const int cs = C.ngw; bool pend = false;
    auto pair_desc = [&](int p, ConvD& d0, ConvD& d1) -> bool { const int m = conv_m_of(p / (CONV_IB / 2), j), rp = p % (CONV_IB / 2); const bool isdn = (m >= 4 && m < 6) || m >= 38;
        const int nblk = isdn ? D / 32 : FF / 32, kb2 = rp / nblk, nb = rp - kb2 * nblk, r0 = 2 * kb2 * nblk + nb;
        const bool g = conv_desc(C, P, m, r0, d0); conv_desc(C, P, m, r0 + nblk, d1); return g; };
    auto issue = [&](int lane) { if (CONV && cit < pcount) { ConvD d0, d1; const bool g = pair_desc(cit, d0, d1); conv_dma_issue(d0, g, lane, tile0); conv_dma_issue(d1, g, lane, tile1); pend = true; } };
    auto finish = [&](int lane) { if (CONV && pend) { ConvD d0, d1; pair_desc(cit, d0, d1);
                                      asm volatile("s_waitcnt vmcnt(0)" ::: "memory"); conv_dma_finish(d0, tile0, lane); conv_dma_finish(d1, tile1, lane); cit += cs; pend = false; } };
    for (int rr = C.gw; rr < NT; rr += C.ngw) { const int row = NT - 1 - rr;
        int lane = C.lane; asm volatile("" : "+v"(lane));
        const int pos = row % SL, n = pos + 1;
        unsigned short* sel = C.sel + (size_t)row * 256;
        if (n <= 256) {
            u32x2 o; o.x = (unsigned)(4 * lane) | ((unsigned)(4 * lane + 1) << 16); o.y = (unsigned)(4 * lane + 2) | ((unsigned)(4 * lane + 3) << 16);
            *(u32x2*)(sel + 4 * lane) = o;
            continue;
        }
        const float* sr = SC + (size_t)row * SCLD;
        const int nr8 = (n + 511) >> 9;
#define TOPK_CASE(NR) { unsigned k[NR]; topk_keys<NR>(sr, k, n, lane); _Pragma("unroll") for (int q_ = 0; q_ < NR; ++q_) asm volatile("" : "+v"(k[q_]) :: "memory");   \
            issue(lane); topk_select<NR>(k, sel, lane, [&]() { if (NR >= TOPK_MID_NR) { finish(lane); issue(lane); } }); }
        switch (nr8) {
            case 1: TOPK_CASE(8) break;   case 2: TOPK_CASE(16) break; case 3: TOPK_CASE(24) break;
            case 4: TOPK_CASE(32) break;  case 5: TOPK_CASE(40) break; case 6: TOPK_CASE(48) break;
            case 7: TOPK_CASE(56) break;  case 8: TOPK_CASE(64) break; default: TOPK_CASE(65) break;
        }
#undef TOPK_CASE
        finish(lane);
    }
    while (CONV && cit < pcount) { int lane = C.lane; asm volatile("" : "+v"(lane)); issue(lane); finish(lane); }
}
__device__ __forceinline__ void topk_phase(const Ctx& C, KArgP P, int j) {
    if (CONV_IN_PROLOGUE) topk_phase_t<false>(C, P, j); else topk_phase_t<true>(C, P, j);
}

constexpr int ATT_VROW = 544, ATT_WAVE_LDS = 32 * ATT_VROW + 512;
__device__ __forceinline__ s16x4 tr16(const LAS unsigned char* p) { return __builtin_bit_cast(s16x4, __builtin_amdgcn_ds_read_tr16_b64_v4i16((LAS s16x4*)p)); }
constexpr int AT_PITCH = 1088, AT_BUF = 8 * AT_PITCH;
template <bool OUT8>
__device__ __forceinline__ void attn2b_phase(const Ctx& C, bf16* OUT) {
    const bf16* PROJ = (const bf16*)(C.R + R_PROJ);
    const int lane = C.lane, n15 = lane & 15, kq = lane >> 4, g = n15 >> 2, oo = lane & 1, chh = lane >> 1;
    LAS unsigned char* wb = C.lds + C.wave * ATT_WAVE_LDS;
    LAS unsigned short* selE = (LAS unsigned short*)(wb + 2 * AT_BUF); LAS unsigned short* selO = selE + 128;
    static_assert(2 * AT_BUF + 512 <= ATT_WAVE_LDS, "attention LDS");
    int b0, nbat, wv, nwv;
    if ((C.G & 7) == 0) { b0 = (C.bid & 7) >> 1; nbat = 1; wv = ((C.bid >> 3) * 2 + (C.bid & 1)) * NWAVES + C.wave; nwv = (C.G >> 2) * NWAVES; }
    else { b0 = 0; nbat = BATCH; wv = C.gw; nwv = C.ngw; }
    for (int bi = 0; bi < nbat; ++bi) { const int b = b0 + bi;
    for (int pos = wv; pos < SL; pos += nwv) {
        const int row = b * SL + pos, nk = pos + 1 < 256 ? pos + 1 : 256, ng = (nk + 15) >> 4, ntile = 2 * ng;
        const bf16* kvb = PROJ + (size_t)b * SL * DSA_NP;
        { const u32x2 sv = *(const u32x2*)(C.sel + (size_t)row * 256 + 4 * lane);
          const unsigned s0 = (4 * lane < nk) ? (sv.x & 0xffffu) : 0u, s1 = (4 * lane + 1 < nk) ? (sv.x >> 16) : 0u, s2 = (4 * lane + 2 < nk) ? (sv.y & 0xffffu) : 0u, s3 = (4 * lane + 3 < nk) ? (sv.y >> 16) : 0u;
          asm volatile("" ::: "memory");
          selE[2 * lane] = (unsigned short)s0; selE[2 * lane + 1] = (unsigned short)s2; selO[2 * lane] = (unsigned short)s1; selO[2 * lane + 1] = (unsigned short)s3; }
        bf16x8 qf[8];
        { const bf16* qp = PROJ + (size_t)row * DSA_NP + DQ0 + n15 * 64 + 8 * kq; const bf16x8 q0 = *(const bf16x8*)qp, q1 = *(const bf16x8*)(qp + 32);
          const bf16x8 z = (bf16x8){0, 0, 0, 0, 0, 0, 0, 0};
#pragma unroll
          for (int ks = 0; ks < 8; ++ks) qf[ks] = ((ks >> 1) == g) ? ((ks & 1) ? q1 : q0) : z; }
        asm volatile("s_waitcnt vmcnt(0) lgkmcnt(0)" ::: "memory");
#pragma unroll
        for (int ks = 0; ks < 8; ++ks) asm volatile("" : "+v"(qf[ks]));
#define AT_ISSUE(i_, bo_) do { const int ii_ = (i_); const int gi_ = ii_ < ng ? ii_ : ii_ - ng; const int c0_ = ii_ < ng ? DK0 : DV0; \
            const u32x4 k8_ = *(const LAS u32x4*)((oo ? selO : selE) + 8 * gi_); const bf16* gb_ = kvb + c0_ + chh * 8; LAS unsigned char* db_ = wb + (bo_); \
            __builtin_amdgcn_global_load_lds((const unsigned*)(gb_ + (size_t)(k8_.x & 0xffffu) * DSA_NP), (LAS unsigned*)(db_ + 0 * AT_PITCH), 16, 0, 0); \
            __builtin_amdgcn_global_load_lds((const unsigned*)(gb_ + (size_t)(k8_.x >> 16) * DSA_NP), (LAS unsigned*)(db_ + 1 * AT_PITCH), 16, 0, 0); \
            __builtin_amdgcn_global_load_lds((const unsigned*)(gb_ + (size_t)(k8_.y & 0xffffu) * DSA_NP), (LAS unsigned*)(db_ + 2 * AT_PITCH), 16, 0, 0); \
            __builtin_amdgcn_global_load_lds((const unsigned*)(gb_ + (size_t)(k8_.y >> 16) * DSA_NP), (LAS unsigned*)(db_ + 3 * AT_PITCH), 16, 0, 0); \
            __builtin_amdgcn_global_load_lds((const unsigned*)(gb_ + (size_t)(k8_.z & 0xffffu) * DSA_NP), (LAS unsigned*)(db_ + 4 * AT_PITCH), 16, 0, 0); \
            __builtin_amdgcn_global_load_lds((const unsigned*)(gb_ + (size_t)(k8_.z >> 16) * DSA_NP), (LAS unsigned*)(db_ + 5 * AT_PITCH), 16, 0, 0); \
            __builtin_amdgcn_global_load_lds((const unsigned*)(gb_ + (size_t)(k8_.w & 0xffffu) * DSA_NP), (LAS unsigned*)(db_ + 6 * AT_PITCH), 16, 0, 0); \
            __builtin_amdgcn_global_load_lds((const unsigned*)(gb_ + (size_t)(k8_.w >> 16) * DSA_NP), (LAS unsigned*)(db_ + 7 * AT_PITCH), 16, 0, 0); } while (0)
#define AT_WAIT(i_) do { if ((i_) + 1 < ntile) asm volatile("s_waitcnt vmcnt(8)" ::: "memory"); else asm volatile("s_waitcnt vmcnt(0)" ::: "memory"); } while (0)
        AT_ISSUE(0, 0); AT_ISSUE(1, AT_BUF);
        f32x4 lg[16];
        const LAS unsigned char* kfp = wb + (n15 >> 1) * AT_PITCH + 32 * kq + 16 * (n15 & 1);
#pragma unroll
        for (int G = 0; G < 16; ++G) {
            f32x4 acc = (f32x4){0.f, 0.f, 0.f, 0.f};
            if (G < ng) {
                AT_WAIT(G);
                bf16x8 af[8];
#pragma unroll
                for (int ks = 0; ks < 8; ++ks) af[ks] = *(const LAS bf16x8*)(kfp + (G & 1) * AT_BUF + 128 * ks);
                asm volatile("s_waitcnt lgkmcnt(0)" ::: "memory");
                if (G + 2 < ntile) AT_ISSUE(G + 2, (G & 1) * AT_BUF);
#pragma unroll
                for (int ks = 0; ks < 8; ++ks) acc = MFMA16(af[ks], qf[ks], acc);
            }
#pragma unroll
            for (int i = 0; i < 4; ++i) lg[G][i] = (16 * G + 4 * kq + i < nk) ? acc[i] : -INFINITY;
        }
        float mx = -INFINITY;
#pragma unroll
        for (int G = 0; G < 16; ++G) mx = fmaxf(fmaxf(fmaxf(lg[G][0], lg[G][1]), fmaxf(lg[G][2], lg[G][3])), mx);
        mx = fmaxf(mx, __shfl_xor(mx, 16)); mx = fmaxf(mx, __shfl_xor(mx, 32));
        float sum = 0.f;
#pragma unroll
        for (int G = 0; G < 16; ++G)
#pragma unroll
            for (int i = 0; i < 4; ++i) { const float p = __expf(lg[G][i] - mx); lg[G][i] = p; sum += p; }
        sum += __shfl_xor(sum, 16); sum += __shfl_xor(sum, 32);
        f32x4 O[16];
#pragma unroll
        for (int nb = 0; nb < 16; ++nb) O[nb] = (f32x4){0.f, 0.f, 0.f, 0.f};
        const int vr = 4 * kq + (n15 >> 2);
        const LAS unsigned char* vfp = wb + (vr >> 1) * AT_PITCH + 16 * (vr & 1) + 32 * ((lane & 3) >> 1) + 8 * (lane & 1);
#pragma unroll
        for (int G = 0; G < 16; ++G) {
            if (G < ng) {
                const int ti = ng + G, bo = (ti & 1) * AT_BUF;
                AT_WAIT(ti);
                u32x2 pw; pw.x = pk2(lg[G][0], lg[G][1]); pw.y = pk2(lg[G][2], lg[G][3]);
                const s16x4 pa = __builtin_bit_cast(s16x4, pw);
                s16x4 vf[16];
#pragma unroll
                for (int nb = 0; nb < 16; ++nb) vf[nb] = tr16(vfp + bo + 64 * nb);
                asm volatile("s_waitcnt lgkmcnt(0)" ::: "memory");
                if (ti + 2 < ntile) AT_ISSUE(ti + 2, bo);
#pragma unroll
                for (int nb = 0; nb < 16; ++nb) O[nb] = __builtin_amdgcn_mfma_f32_16x16x16bf16_1k(pa, vf[nb], O[nb], 0, 0, 0);
            }
        }
#undef AT_ISSUE
#undef AT_WAIT
        bf16* orow = OUT + (size_t)row * D; unsigned char* orow8 = (unsigned char*)OUT + (size_t)row * D;
        float inv[4];
#pragma unroll
        for (int i = 0; i < 4; ++i) inv[i] = 1.0f / __shfl(sum, 4 * kq + i);
#pragma unroll
        for (int x = 0; x < 4; ++x) {
            const f32x4 o = (kq == 0) ? O[x] : (kq == 1) ? O[4 + x] : (kq == 2) ? O[8 + x] : O[12 + x];
#pragma unroll
            for (int i = 0; i < 4; ++i) { if (OUT8) orow8[(4 * kq + i) * 64 + 16 * x + n15] = (unsigned char)(pg8::cvt4_fp8(o[i] * inv[i] * SA_ATT, 0.f, 0.f, 0.f) & 0xffu);
                                          else orow[(4 * kq + i) * 64 + 16 * x + n15] = (bf16)(pk2(o[i] * inv[i], 0.f) & 0xffffu); }
        }
    } }
}
__device__ __forceinline__ int ml_start(int c) { return c == 0 ? 0 : 16 + 256 * (c - 1); }
__device__ __forceinline__ int ml_len(int c) { return c == 0 ? 16 : 256; }
template <bool ISMAX> __device__ __forceinline__ float wave_scan_incl(float v, int lane) {
#pragma unroll
    for (int d = 1; d < 64; d <<= 1) { const float t = __shfl_up(v, d); if (lane >= d) v = ISMAX ? fmaxf(v, t) : v + t; }
    return v; }
__device__ __forceinline__ void ml_scan_phase(const Ctx& C) {
    if (C.gw >= 16) return;
    const int bh = C.gw, lane = C.lane, p0 = 65 * lane;
    float* F = C.mlf + bh * SL; float* Cc = C.mlc + bh * SL; float* Pp = C.mlp + bh * SL;
    float li[65], lf[65];
#pragma unroll
    for (int i = 0; i < 65; ++i) { const bool ok = p0 + i < SL; li[i] = ok ? C.mli[(bh * 65 + i) * 64 + lane] : -INFINITY; lf[i] = ok ? C.mlg[(bh * 65 + i) * 64 + lane] : 0.f; }
    float s = 0.f;
#pragma unroll
    for (int i = 0; i < 65; ++i) s += lf[i];
    float run = wave_scan_incl<false>(s, lane) - s, mx = -INFINITY;
#pragma unroll
    for (int i = 0; i < 65; ++i) { run += lf[i]; lf[i] = run; li[i] = li[i] - run; mx = fmaxf(mx, li[i]); }
    const float inc = wave_scan_incl<true>(mx, lane); float pm = __shfl_up(inc, 1); if (lane == 0) pm = -INFINITY;
    LAS float* T = (LAS float*)(C.lds + C.wave * 16640);
#define ML_SCAN_OUT(dst_) do { asm volatile("s_waitcnt lgkmcnt(0)" ::: "memory"); \
        _Pragma("unroll") for (int t = 0; t < 65; ++t) { const float x_ = T[64 * t + lane]; if (64 * t + lane < SL) (dst_)[64 * t + lane] = x_; } \
        asm volatile("s_waitcnt lgkmcnt(0)" ::: "memory"); } while (0)
#pragma unroll
    for (int i = 0; i < 65; ++i) T[p0 + i] = lf[i];
    ML_SCAN_OUT(F);
#pragma unroll
    for (int i = 0; i < 65; ++i) T[p0 + i] = li[i];
    ML_SCAN_OUT(Cc);
#pragma unroll
    for (int i = 0; i < 65; ++i) { pm = fmaxf(pm, li[i]); T[p0 + i] = pm; }
    ML_SCAN_OUT(Pp);
#undef ML_SCAN_OUT
}
constexpr int TP = 40;
__device__ __forceinline__ void stage_T(const Ctx& C, LAS bf16* T, const bf16* src, int ld, int ncol, int row0tok, int s0, int nvalid, const float* cvals, float pend, float kscale) {
    const int nchunk = 32 * (ncol / 8);
    for (int id = C.tid; id < nchunk; id += NTHREADS) {
        const int s = id & 31, dc = id >> 5; const int sl_ = s0 + s; const bool ok = sl_ < nvalid; const int sc = ok ? sl_ : nvalid - 1;
        float x[8]; unpack8(*(const u32x4*)(src + (size_t)(row0tok + sc) * ld + 8 * dc), x);
        float w = ok ? 1.0f : 0.0f; if (cvals) w = ok ? __expf(cvals[sc] - pend) * kscale : 0.0f;
#pragma unroll
        for (int e = 0; e < 8; ++e) T[(8 * dc + e) * TP + s] = (bf16)(pk2(x[e] * w, 0.f) & 0xffffu);
    }
}
__device__ __forceinline__ void ml_dc_phase(const Ctx& C) {
    const bf16* PROJ = (const bf16*)(C.R + R_PROJ); float* DC = (float*)(C.R + R_DC);
    LAS bf16* KT = (LAS bf16*)C.lds; LAS bf16* VT = KT + 128 * TP;
    const int lane = C.lane, m31 = lane & 31, hi = lane >> 5, w = C.wave;
    for (int task = C.bid; task < 256; task += C.G) {
        const int bh = task >> 4, c = task & 15, b = bh >> 2, h = bh & 3, start = ml_start(c), n = ml_len(c), tok0 = b * SL + start;
        const float pend = C.mlp[bh * SL + start + n - 1];
        f32x16 acc[4];
#pragma unroll
        for (int nb = 0; nb < 4; ++nb)
#pragma unroll
            for (int r = 0; r < 16; ++r) acc[nb][r] = 0.f;
        float dn = 0.f;
        for (int s0 = 0; s0 < n; s0 += 32) {
            stage_T(C, KT, PROJ + MK0 + h * 128, ML_NP, 128, tok0, s0, n, C.mlc + bh * SL + start, pend, 0.08838834764831845f);
            stage_T(C, VT, PROJ + MV0 + h * 256, ML_NP, 256, tok0, s0, n, nullptr, 0.f, 1.f);
            __syncthreads();
#pragma unroll
            for (int ks = 0; ks < 2; ++ks) { const bf16x8 a = *(const LAS bf16x8*)(VT + (32 * w + m31) * TP + 16 * ks + 8 * hi);
#pragma unroll
                for (int nb = 0; nb < 4; ++nb) acc[nb] = MFMA32(a, *(const LAS bf16x8*)(KT + (32 * nb + m31) * TP + 16 * ks + 8 * hi), acc[nb]); }
            if (C.tid < 128) {
#pragma unroll
                for (int q = 0; q < 4; ++q) { float x[8]; unpack8(*(const LAS u32x4*)(KT + C.tid * TP + 8 * q), x);
#pragma unroll
                    for (int e = 0; e < 8; ++e) dn += x[e]; } }
            __syncthreads();
        }
        float* dc = DC + (size_t)(bh * 16 + c) * 256 * 128;
#pragma unroll
        for (int nb = 0; nb < 4; ++nb)
#pragma unroll
            for (int r = 0; r < 16; ++r) dc[(size_t)(32 * w + crow(r, hi)) * 128 + 32 * nb + m31] = acc[nb][r];
        if (C.tid < 128) C.dn[(bh * 16 + c) * 128 + C.tid] = dn;
    }
}
__device__ __forceinline__ void ml_state_phase(const Ctx& C) {
    const float* DC = (const float*)(C.R + R_DC); bf16* CH = (bf16*)(C.R + R_CH);
    const int gt = C.bid * NTHREADS + C.tid, ngt = C.G * NTHREADS;
    for (int i = gt; i < 16 * 8192 + 16 * 128; i += ngt) {
        const bool isn = i >= 16 * 8192; const int ii = isn ? i - 16 * 8192 : i; const int bh = isn ? ii >> 7 : ii >> 13, off = isn ? (ii & 127) : 4 * (ii & 8191);
        f32x4 dcv[16]; float pe[16];
#pragma unroll
        for (int c = 0; c < 16; ++c) { pe[c] = C.mlp[bh * SL + ml_start(c) + ml_len(c) - 1];
            if (isn) { dcv[c] = (f32x4){C.dn[(bh * 16 + c) * 128 + off], 0.f, 0.f, 0.f}; } else dcv[c] = *(const f32x4*)(DC + (size_t)(bh * 16 + c) * 32768 + off); }
        f32x4 st = (f32x4){0.f, 0.f, 0.f, 0.f}; float pprev = 0.f;
#pragma unroll
        for (int c = 0; c < 16; ++c) {
            const float pend = pe[c];
            const float decay = (c == 0) ? 0.f : __expf(pprev - pend); pprev = pend;
            st = decay * st + dcv[c];
            if (isn) C.nh[(bh * 16 + c) * 128 + off] = st[0];
            else { u32x2 o; o.x = pk2(st[0], st[1]); o.y = pk2(st[2], st[3]); *(u32x2*)(CH + (size_t)(bh * 16 + c) * 32768 + off) = o; }
        }
    }
}
constexpr int MLP_ = 136;
__device__ __forceinline__ void ml_out_phase(const Ctx& C, const float* gout) {
    const bf16* PROJ = (const bf16*)(C.R + R_PROJ); const bf16* CH = (const bf16*)(C.R + R_CH);
    LAS bf16* VT = (LAS bf16*)C.lds; LAS bf16* KL = VT + 256 * TP; LAS float* CV = (LAS float*)(KL + 32 * MLP_); LAS bf16* CHL = (LAS bf16*)(CV + 32);
    const int w = C.wave;
    for (int task = C.bid; task < 272; task += C.G) {
        int lane = C.lane, tid = C.tid; asm volatile("" : "+v"(lane), "+v"(tid));
        const int m31 = lane & 31, hi = lane >> 5;
        const int bh = task < 256 ? task >> 4 : task - 256, c = task < 256 ? 1 + (task & 15) : 0;
        const int b = bh >> 2, h = bh & 3, start = ml_start(c), n = ml_len(c), tok0 = b * SL + start;
        const int tl = 32 * w + m31, tlc = tl < n ? tl : n - 1; const bool wact = 32 * w < n;
        const float Pt = C.mlp[bh * SL + start + tlc];
        const bf16* qp = PROJ + (size_t)(tok0 + tlc) * ML_NP + MQ0 + h * 128 + 8 * hi;
        const int nst = (n + 31) >> 5;
        const int vs = tid & 31, vd0 = tid >> 5, ks_ = tid >> 4, kc_ = tid & 15;
        u32x4 rv0, rv1, rk; float rc = 0.f;
#define ML_LOAD(st_) do { const int s0_ = 32 * (st_); const int a_ = s0_ + vs < n ? s0_ + vs : n - 1, k_ = s0_ + ks_ < n ? s0_ + ks_ : n - 1; \
            const bf16* vp_ = PROJ + (size_t)(tok0 + a_) * ML_NP + MV0 + h * 256 + 8 * vd0; rv0 = *(const u32x4*)vp_; rv1 = *(const u32x4*)(vp_ + 128); \
            rk = *(const u32x4*)(PROJ + (size_t)(tok0 + k_) * ML_NP + MK0 + h * 128 + 8 * kc_); \
            if (tid < 32) rc = C.mlc[bh * SL + start + (s0_ + tid < n ? s0_ + tid : n - 1)]; } while (0)
#define ML_WRITE(st_) do { const int s0_ = 32 * (st_); const bool ok_ = s0_ + vs < n; float x_[8]; unpack8(rv0, x_); \
            _Pragma("unroll") for (int e = 0; e < 8; ++e) VT[(8 * vd0 + e) * TP + vs] = ok_ ? (bf16)(pk2(x_[e], 0.f) & 0xffffu) : (bf16)0; \
            unpack8(rv1, x_); _Pragma("unroll") for (int e = 0; e < 8; ++e) VT[(8 * (vd0 + 16) + e) * TP + vs] = ok_ ? (bf16)(pk2(x_[e], 0.f) & 0xffffu) : (bf16)0; \
            *(LAS u32x4*)(KL + ks_ * MLP_ + 8 * kc_) = rk; if (tid < 32) CV[tid] = rc; } while (0)
        float den = 0.f;
        f32x16 acc[8];
#pragma unroll
        for (int mb = 0; mb < 8; ++mb)
#pragma unroll
            for (int r = 0; r < 16; ++r) acc[mb][r] = 0.f;
        if (c >= 1 && wact) {
            const bf16* ch = CH + (size_t)(bh * 16 + c - 1) * 32768;
            bf16x8 qf[8];
#pragma unroll
            for (int ks = 0; ks < 8; ++ks) qf[ks] = *(const bf16x8*)(qp + 16 * ks);
#pragma unroll
            for (int mb = 0; mb < 8; ++mb)
#pragma unroll
                for (int ks = 0; ks < 8; ++ks) acc[mb] = MFMA32(*(const bf16x8*)(ch + (size_t)(32 * mb + m31) * 128 + 16 * ks + 8 * hi), qf[ks], acc[mb]);
            const float sc = __expf(C.mlp[bh * SL + start - 1] - Pt);
#pragma unroll
            for (int mb = 0; mb < 8; ++mb)
#pragma unroll
                for (int r = 0; r < 16; ++r) acc[mb][r] *= sc;
            const float* nh = C.nh + (bh * 16 + c - 1) * 128 + 8 * hi; float d = 0.f;
#pragma unroll
            for (int ks = 0; ks < 8; ++ks) { const f32x4 n0 = *(const f32x4*)(nh + 16 * ks), n1 = *(const f32x4*)(nh + 16 * ks + 4); float q[8]; unpack8(__builtin_bit_cast(u32x4, qf[ks]), q);
                d += (n0[0] * q[0] + n0[1] * q[1]) + (n0[2] * q[2] + n0[3] * q[3]) + (n1[0] * q[4] + n1[1] * q[5]) + (n1[2] * q[6] + n1[3] * q[7]); }
            d += __shfl_xor(d, 32); den = sc * d;
        }
        float den_in = 0.f;
        ML_LOAD(0);
        for (int st = 0; st < nst; ++st) {
            ML_WRITE(st);
            __syncthreads();
            const bool act = st <= w && wact;
            if (!act && st + 1 < nst) ML_LOAD(st + 1);
            if (act) {
                f32x16 X;
#pragma unroll
                for (int r = 0; r < 16; ++r) X[r] = 0.f;
                bf16x8 qf[8];
#pragma unroll
                for (int ks = 0; ks < 8; ++ks) qf[ks] = *(const bf16x8*)(qp + 16 * ks);
#pragma unroll
                for (int ks = 0; ks < 8; ++ks) X = MFMA32(*(const LAS bf16x8*)(KL + m31 * MLP_ + 16 * ks + 8 * hi), qf[ks], X);
                asm volatile("" ::: "memory");
                if (st + 1 < nst) ML_LOAD(st + 1);
                float Wt[16];
#pragma unroll
                for (int q4 = 0; q4 < 4; ++q4) { const int sb = 32 * st + 8 * q4 + 4 * hi;
                    const f32x4 cv = *(const LAS f32x4*)(CV + 8 * q4 + 4 * hi);
#pragma unroll
                    for (int e = 0; e < 4; ++e) { const int sl_ = sb + e; const bool ok = sl_ < n && sl_ <= tl;
                        const float wgt = ok ? X[4 * q4 + e] * 0.08838834764831845f * __expf(cv[e] - Pt) : 0.f; Wt[4 * q4 + e] = wgt; den_in += wgt; } }
#pragma unroll
                for (int s2 = 0; s2 < 2; ++s2) {
                    u32x4 pw; pw.x = pk2(Wt[8 * s2], Wt[8 * s2 + 1]); pw.y = pk2(Wt[8 * s2 + 2], Wt[8 * s2 + 3]); pw.z = pk2(Wt[8 * s2 + 4], Wt[8 * s2 + 5]); pw.w = pk2(Wt[8 * s2 + 6], Wt[8 * s2 + 7]);
                    const bf16x8 wf = __builtin_bit_cast(bf16x8, pw);
#pragma unroll
                    for (int mb = 0; mb < 8; ++mb) { const LAS bf16* vp = VT + (32 * mb + m31) * TP + 16 * s2 + 4 * hi;
                        const u32x2 lo = *(const LAS u32x2*)vp, hi2 = *(const LAS u32x2*)(vp + 8);
                        const u32x4 av = (u32x4){lo.x, lo.y, hi2.x, hi2.y};
                        acc[mb] = MFMA32(__builtin_bit_cast(bf16x8, av), wf, acc[mb]); }
                }
            }
            __syncthreads();
        }
#undef ML_LOAD
#undef ML_WRITE
        if (wact) {
            den += den_in + __shfl_xor(den_in, 32);
            const float Ft = C.mlf[bh * SL + start + tlc];
            const float dnm = fmaxf(fabsf(den), __expf(-(Ft + Pt))), invd = 1.0f / dnm;
            float ss = 0.f;
#pragma unroll
            for (int mb = 0; mb < 8; ++mb)
#pragma unroll
                for (int r = 0; r < 16; ++r) { const float hv = acc[mb][r] * invd; acc[mb][r] = hv; ss += hv * hv; }
            ss += __shfl_xor(ss, 32);
            const float rstd = 1.0f / sqrtf(ss * (1.0f / 256.0f) + RMS_EPS);
            LAS bf16* Yt = (LAS bf16*)(C.lds + w * 16896);
#pragma unroll
            for (int mb = 0; mb < 8; ++mb)
#pragma unroll
                for (int q4 = 0; q4 < 4; ++q4) { const int dv0 = 32 * mb + 8 * q4 + 4 * hi;
                    u32x2 o; o.x = pk2(acc[mb][4 * q4] * rstd, acc[mb][4 * q4 + 1] * rstd); o.y = pk2(acc[mb][4 * q4 + 2] * rstd, acc[mb][4 * q4 + 3] * rstd);
                    *(LAS u32x2*)(Yt + m31 * 264 + dv0) = o; }
            asm volatile("s_waitcnt lgkmcnt(0)" ::: "memory");
            const f32x4 gg = *(const f32x4*)(gout + h * 256 + 4 * lane);
            const int nrow = n - 32 * w < 32 ? n - 32 * w : 32;
            const bf16* obase = PROJ + (size_t)(tok0 + 32 * w) * ML_NP + MO0 + h * 256 + 4 * lane; bf16* ybase = C.XN + (size_t)(tok0 + 32 * w) * D + h * 256 + 4 * lane;
#pragma unroll
            for (int r0 = 0; r0 < 32; r0 += 8) {
                if (r0 >= nrow) break;
                u32x2 ow[8], yv[8];
#pragma unroll
                for (int q = 0; q < 8; ++q) { const int rr = r0 + q < nrow ? r0 + q : nrow - 1; ow[q] = *(const u32x2*)(obase + (size_t)rr * ML_NP); yv[q] = *(const LAS u32x2*)(Yt + (r0 + q) * 264 + 4 * lane); }
#pragma unroll
                for (int q = 0; q < 8; ++q) {
                    const float y0 = bflo(yv[q].x) * gg[0] / (1.0f + __expf(-bflo(ow[q].x))), y1 = bfhi(yv[q].x) * gg[1] / (1.0f + __expf(-bfhi(ow[q].x)));
                    const float y2 = bflo(yv[q].y) * gg[2] / (1.0f + __expf(-bflo(ow[q].y))), y3 = bfhi(yv[q].y) * gg[3] / (1.0f + __expf(-bfhi(ow[q].y)));
                    u32x2 o; o.x = pk2(y0, y1); o.y = pk2(y2, y3); if (r0 + q < nrow) *(u32x2*)(ybase + (size_t)(r0 + q) * D) = o; }
            }
        }
        __syncthreads();
    }
}

__device__ __forceinline__ void moe_bases(const Ctx& C, int layer, int (&pb)[9]) {
    pb[0] = 0;
#pragma unroll
    for (int e = 0; e < 8; ++e) { const int ne = (int)__hip_atomic_load(C.ctl + CW_CNT + (layer * 8 + e) * 64, __ATOMIC_RELAXED, __HIP_MEMORY_SCOPE_AGENT); pb[e + 1] = pb[e] + ((ne + 255) >> 8); }
}
__device__ __forceinline__ void moe_gather_phase(const Ctx& C, int layer) {
    bf16* AS = (bf16*)(C.R + R_AS);
    LAS int* lb = (LAS int*)C.lds;
    if (C.tid == 0) { int pb[9]; moe_bases(C, layer, pb);
#pragma unroll
        for (int e = 0; e < 8; ++e) { lb[e] = pb[e] * 256; lb[8 + e] = (int)__hip_atomic_load(C.ctl + CW_CNT + (layer * 8 + e) * 64, __ATOMIC_RELAXED, __HIP_MEMORY_SCOPE_AGENT); } }
    __syncthreads();
    for (int row = C.gw; row < NT; row += C.ngw) {
        const int ee = C.route_e[row]; const float g1 = C.route_g1[row];
        u32x4 x0, x1 = (u32x4){0u, 0u, 0u, 0u};
        if (FP8_MOE) x0 = *(const u32x4*)(C.xn8 + (size_t)row * D + 16 * C.lane);
        else { x0 = *(const u32x4*)(C.XN + (size_t)row * D + 8 * C.lane); x1 = *(const u32x4*)(C.XN + (size_t)row * D + 512 + 8 * C.lane); }
#pragma unroll
        for (int wh = 0; wh < 2; ++wh) { const int e = wh ? (ee >> 8) : (ee & 0xff), r = wh ? C.route_r2[row] : C.route_r1[row]; const int slot = lb[e] + r;
            if (FP8_MOE) *(u32x4*)((unsigned char*)AS + (size_t)slot * D + 16 * C.lane) = x0;
            else { *(u32x4*)(AS + (size_t)slot * D + 8 * C.lane) = x0; *(u32x4*)(AS + (size_t)slot * D + 512 + 8 * C.lane) = x1; }
            if (C.lane == 0) { C.slot_tok[slot] = row | (wh << 16); C.slot_g[slot] = wh ? 1.0f - g1 : g1; } }
    }
    u32x4 zero4 = (u32x4){0u, 0u, 0u, 0u}; asm volatile("" : "+v"(zero4));
    for (int e = 0; e < 8; ++e) { const int ne = lb[8 + e], first = lb[e] + ne, last = lb[e] + ((ne + 255) & ~255);
        for (int slot = first + C.gw; slot < last; slot += C.ngw) {
            if (FP8_MOE) *(u32x4*)((unsigned char*)AS + (size_t)slot * D + 16 * C.lane) = zero4;
            else { *(u32x4*)(AS + (size_t)slot * D + 8 * C.lane) = zero4; *(u32x4*)(AS + (size_t)slot * D + 512 + 8 * C.lane) = zero4; }
            if (C.lane == 0) { C.slot_tok[slot] = -1; C.slot_g[slot] = 0.f; } } }
    __syncthreads();
}
__device__ __forceinline__ void final_phase(const Ctx& C, float* out) {
    const bf16* Y0 = (const bf16*)(C.R + R_Y0); const bf16* Y1 = (const bf16*)(C.R + R_Y1);
    const int gt = C.bid * NTHREADS + C.tid, ngt = C.G * NTHREADS;
    for (int i = gt; i < BATCH * SEQ * (D / 4); i += ngt) { const int orow = i >> 8, c4 = i & 255, b = orow >> 12, s = orow & 4095; const size_t row = (size_t)b * SL + NMETA + s;
#if H_BF16
        f32x4 v; { const u32x2 hq = *(const u32x2*)(C.H + row * D + 4 * c4); v[0] = bflo(hq.x); v[1] = bfhi(hq.x); v[2] = bflo(hq.y); v[3] = bfhi(hq.y); }
#else
        f32x4 v = *(const f32x4*)(C.H + row * D + 4 * c4);
#endif
        const u32x2 a = *(const u32x2*)(Y0 + row * D + 4 * c4), bb = *(const u32x2*)(Y1 + row * D + 4 * c4);
        v[0] += bflo(a.x) + bflo(bb.x); v[1] += bfhi(a.x) + bfhi(bb.x); v[2] += bflo(a.y) + bflo(bb.y); v[3] += bfhi(a.y) + bfhi(bb.y);
        *(f32x4*)(out + (size_t)orow * D + 4 * c4) = v; }
}
template <int MODE, int KSW  , bool FP8 = false>
__device__ __forceinline__ void skinny_phase(const Ctx& C, const bf16* A16, const bf16* Bt, int N, int K, bf16* O, int ldo, HT* H, float sa = 1.0f, float so = 1.0f) {
    const int lane = C.lane, n15 = lane & 15, kq = lane >> 4, w = C.wave;
    LAS f32x4* red = (LAS f32x4*)C.lds;
    const int nblk = (MODE == 2) ? N / 32 : N / 16;
    for (int cb = C.bid; cb < nblk; cb += C.G) {
        int rowB0 = 16 * cb, rowB1 = 0;
        if (MODE == 2) { const int c0 = 16 * cb; rowB0 = 256 * (c0 >> 7) + (c0 & 127); rowB1 = rowB0 + 128; }
        f32x4 acc0 = (f32x4){0.f, 0.f, 0.f, 0.f}, acc1 = (f32x4){0.f, 0.f, 0.f, 0.f};
        const bf16* ap = A16 + (size_t)n15 * K + 8 * kq; const bf16* bp0 = Bt + (size_t)(rowB0 + n15) * K + 8 * kq; const bf16* bp1 = Bt + (size_t)(rowB1 + n15) * K + 8 * kq;
        if constexpr (FP8) {
            const unsigned char* ap8 = (const unsigned char*)A16 + (size_t)n15 * K + 8 * kq; const unsigned char* bq0 = (const unsigned char*)Bt + (size_t)(rowB0 + n15) * K + 8 * kq; const unsigned char* bq1 = (const unsigned char*)Bt + (size_t)(rowB1 + n15) * K + 8 * kq;
            long af[KSW], b0f[KSW], b1f[MODE == 2 ? KSW : 1];
#pragma unroll
            for (int i = 0; i < KSW; ++i) { const int ks = w + NWAVES * i; af[i] = *(const long*)(ap8 + 32 * ks); b0f[i] = *(const long*)(bq0 + 32 * ks); if (MODE == 2) b1f[i] = *(const long*)(bq1 + 32 * ks); }
#pragma unroll
            for (int i = 0; i < KSW; ++i) { acc0 = __builtin_amdgcn_mfma_f32_16x16x32_fp8_fp8(af[i], b0f[i], acc0, 0, 0, 0); if (MODE == 2) acc1 = __builtin_amdgcn_mfma_f32_16x16x32_fp8_fp8(af[i], b1f[i], acc1, 0, 0, 0); }
        } else {
            bf16x8 af[KSW], b0f[KSW], b1f[MODE == 2 ? KSW : 1];
#pragma unroll
            for (int i = 0; i < KSW; ++i) { const int ks = w + NWAVES * i; af[i] = *(const bf16x8*)(ap + 32 * ks); b0f[i] = *(const bf16x8*)(bp0 + 32 * ks); if (MODE == 2) b1f[i] = *(const bf16x8*)(bp1 + 32 * ks); }
#pragma unroll
            for (int i = 0; i < KSW; ++i) { acc0 = MFMA16(af[i], b0f[i], acc0); if (MODE == 2) acc1 = MFMA16(af[i], b1f[i], acc1); }
        }
        red[w * 64 + lane] = acc0; if (MODE == 2) red[512 + w * 64 + lane] = acc1;
        __syncthreads();
        if (w == 0) {
            f32x4 s0 = red[lane], s1 = (f32x4){0.f, 0.f, 0.f, 0.f};
#pragma unroll
            for (int ww = 1; ww < NWAVES; ++ww) s0 += red[ww * 64 + lane];
            if (MODE == 2) { s1 = red[512 + lane];
#pragma unroll
                for (int ww = 1; ww < NWAVES; ++ww) s1 += red[512 + ww * 64 + lane]; }
            const int col = 16 * cb + n15;
#pragma unroll
            for (int i = 0; i < 4; ++i) { const int m = 4 * kq + i;
                if (MODE == 0) { const bf16 v = (bf16)(pk2(s0[i] * sa, 0.f) & 0xffffu);
#pragma unroll
                    for (int b = 0; b < BATCH; ++b) O[(size_t)(b * SL + m) * ldo + col] = v; }
                if (MODE == 1) {
#pragma unroll
#if H_BF16
                    for (int b = 0; b < BATCH; ++b) { HT* hp = H + (size_t)(b * SL + m) * D + col; *hp = (HT)(pk2(bf2f(*hp) + s0[i] * sa, 0.f) & 0xffffu); } }
#else
                    for (int b = 0; b < BATCH; ++b) H[(size_t)(b * SL + m) * D + col] += s0[i] * sa; }
#endif
                if (MODE == 2) { if (FP8) ((unsigned char*)O)[(size_t)m * ldo + col] = (unsigned char)(pg8::cvt4_fp8(pg8::silu_mul(s0[i] * sa, s1[i] * sa) * so, 0.f, 0.f, 0.f) & 0xffu);
                                 else O[(size_t)m * ldo + col] = (bf16)(pk2(pg8::silu_mul(s0[i], s1[i]), 0.f) & 0xffffu); }
            }
        }
        __syncthreads();
    }
}
typedef const __attribute__((address_space(4))) Params* KArg;
__device__ __forceinline__ KArg karg() { KArg p = (KArg)__builtin_amdgcn_kernarg_segment_ptr(); asm volatile("" : "+s"(p)); return p; }
__device__ __forceinline__ void ctx_init(Ctx& C, KArg P, LAS unsigned char* lds_, int wv0) {
    C.lds = lds_;
    { int t_ = wv0 * 64 + hw_lane(); asm volatile("" : "+v"(t_)); C.tid = t_; } C.lane = C.tid & 63; C.wave = __builtin_amdgcn_readfirstlane(C.tid >> 6); C.G = gridDim.x; C.bid = blockIdx.x;
    C.gw = C.bid * NWAVES + C.wave; C.ngw = C.G * NWAVES;
    unsigned char* ws = P->ws;
    C.ctl = (unsigned*)(ws + WS_CTL);
    C.rope = (float2*)(ws + WS_ROPE); C.sm8 = (float*)(ws + WS_SM8);
    C.route_e = (int*)(ws + WS_ROUTE); C.route_r1 = C.route_e + NT; C.route_r2 = C.route_r1 + NT; C.route_g1 = (float*)(C.route_r2 + NT);
    C.mlf = (float*)(ws + WS_MLG); C.mlc = C.mlf + 16 * SL; C.mlp = C.mlc + 16 * SL; C.mli = (float*)(ws + WS_MLI); C.mlg = C.mli + 16 * 65 * 64;
    C.dn = (float*)(ws + WS_NH); C.nh = C.dn + 16 * 16 * 128;
    C.slot_tok = (int*)(ws + WS_SLOT); C.slot_g = (float*)(C.slot_tok + MOE_ROWS); C.sel = (unsigned short*)(ws + WS_SEL);
    C.wdsa_in = (bf16*)(ws + WS_WDSA_IN); C.wdsa_out = (bf16*)(ws + WS_WDSA_OUT); C.wml_in = (bf16*)(ws + WS_WML_IN); C.wml_out = (bf16*)(ws + WS_WML_OUT);
    C.wffn_gu = (bf16*)(ws + WS_WFFN_GU); C.wffn_dn = (bf16*)(ws + WS_WFFN_DN); C.wmoe_gu = (bf16*)(ws + WS_WMOE_GU); C.wmoe_dn = (bf16*)(ws + WS_WMOE_DN);
    C.H = (HT*)(ws + WS_H); C.XN = (bf16*)(ws + WS_XN); C.R = ws + WS_R; C.xn8 = ws + WS_XN8;
}
constexpr int N_PHASES = 44;
#if H_BF16
typedef pg8::EpiResAddB EpiResAddH;
#else
typedef pg8::EpiResAdd EpiResAddH;
#endif
template <int SITE> __global__ void __launch_bounds__(NTHREADS, 2) fwd(Params Pval) {
    extern __shared__ __attribute__((aligned(16))) unsigned char lds_raw[];
    LAS unsigned char* const lds_base = (LAS unsigned char*)lds_raw;
    unsigned* ctl0; int lo, hi; { KArg P0 = karg(); ctl0 = (unsigned*)(P0->ws + WS_CTL); lo = P0->ph_lo; hi = P0->ph_hi; }
    volatile LAS unsigned* MISC = (volatile LAS unsigned*)(lds_base + MISC_OFF);
    int wv0 = __builtin_amdgcn_readfirstlane((int)threadIdx.x >> 6); asm volatile("" : "+s"(wv0));
    if (threadIdx.x < 64) MISC[threadIdx.x] = 0u;
    __syncthreads();
    XcdBarrier bar; bar.bar = ctl0 + CW_BAR; bar.x = 0; bar.st = MISC + 8;
    if (hi - lo > 1) bar = xcd_barrier_post(ctl0 + CW_BAR, MISC + 8, wv0);
    int ph = 0;
#ifndef SKIP_SITE
#define SKIP_SITE -5
#endif
#ifndef REPEAT_MASK
#define REPEAT_MASK 0u
#endif
#define PH_BEGIN_(id) if ((SITE < 0 || SITE == (id)) && SKIP_SITE != (id) && ph >= lo && ph < hi) { for (int rep = 0; rep < (((REPEAT_MASK >> (id)) & 1u) ? 2 : 1); ++rep) { KArg P = karg(); Ctx C; ctx_init(C, P, lds_base, wv0); HT* Hres = rep ? (HT*)(C.R + 160 * MiB) : C.H; (void)Hres; bf16* PROJ = (bf16*)(C.R + R_PROJ); bf16* ACT = (bf16*)(C.R + R_ACT); bf16* AS = (bf16*)(C.R + R_AS); (void)PROJ; (void)ACT; (void)AS;
#define PH_END } if (ph + 1 < hi) xcd_barrier(bar); } ++ph;
    using namespace pg8;

    PH_BEGIN_(0) prologue_phase(C, P); PH_END

    for (int j = 0; j < 2; ++j) {
        PH_BEGIN_(1)
            const float* gain = P->in[2] + (size_t)(2 * j) * D; const float* w8 = P->in[4] + (size_t)j * D * DSA_LDW + DIW0;
            if (j == 0) norm_phase<0, false, FP8_DSA_IN != 0>(C, gain, w8, DSA_LDW, 0); else norm_phase<0, true, FP8_DSA_IN != 0>(C, gain, w8, DSA_LDW, 0);
        PH_END
        PH_BEGIN_(2) {
#if FP8_DSA_IN
                   const bf16* w8 = (const bf16*)((const unsigned char*)C.wdsa_in + (size_t)j * DSA_NP * D);
                   Gemm g{(const bf16*)C.xn8, w8, 16384, DSA_NP, D / 2}; StaticOrder S; S.init(16384, DSA_NP, C.G, C.bid, 1); EpiStoreBf16 E{PROJ, DSA_NP, 1.0f / SW_DIN};
                   gemm_phase<EpiStoreBf16, StaticOrder, true, true, true>(C.lds, g, S, E, C.tid); skinny_phase<0, 4, true>(C, (const bf16*)C.xn8, w8, DSA_NP, D, PROJ, DSA_NP, nullptr, 1.0f / SW_DIN);
#else
                   Gemm g{C.XN, C.wdsa_in + (size_t)j * DSA_NP * D, 16384, DSA_NP, D}; StaticOrder S; S.init(16384, DSA_NP, C.G, C.bid, 1); EpiStoreBf16 E{PROJ, DSA_NP, 1.0f};
                   gemm_phase<EpiStoreBf16, StaticOrder, true, true>(C.lds, g, S, E, C.tid); skinny_phase<0, 4>(C, C.XN, C.wdsa_in + (size_t)j * DSA_NP * D, DSA_NP, D, PROJ, DSA_NP, nullptr);
#endif
                   } PH_END
        PH_BEGIN_(3) dsa_post_phase(C, P->in[5] + j * 64, P->in[6] + j * 64); PH_END
        PH_BEGIN_(4) score_phase(C); PH_END
        PH_BEGIN_(5) topk_phase(C, P, j); PH_END
        PH_BEGIN_(6) if (FP8_DSA) attn2b_phase<true>(C, (bf16*)C.xn8); else attn2b_phase<false>(C, C.XN); PH_END
        PH_BEGIN_(7) {
#if FP8_DSA
                   const bf16* w8 = (const bf16*)((const unsigned char*)C.wdsa_out + (size_t)j * D * D);
                   Gemm g{(const bf16*)C.xn8, w8, 16384, D, D / 2}; StaticOrder S; S.init(16384, D, C.G, C.bid, 1); EpiResAddH E{Hres, D, 1.0f / (SW_DOUT * SA_ATT)};
                   gemm_phase<EpiResAddH, StaticOrder, true, true, true>(C.lds, g, S, E, C.tid); skinny_phase<1, 4, true>(C, (const bf16*)C.xn8, w8, D, D, nullptr, 0, Hres, 1.0f / (SW_DOUT * SA_ATT));
#else
                   Gemm g{C.XN, C.wdsa_out + (size_t)j * D * D, 16384, D, D}; StaticOrder S; S.init(16384, D, C.G, C.bid, 1); EpiResAddH E{Hres, D, 1.0f};
                   gemm_phase<EpiResAddH, StaticOrder, true, true>(C.lds, g, S, E, C.tid); skinny_phase<1, 4>(C, C.XN, C.wdsa_out + (size_t)j * D * D, D, D, nullptr, 0, Hres);
#endif
                   } PH_END
        PH_BEGIN_(8) norm_phase<3, false, FP8_DENSE != 0>(C, P->in[3] + (size_t)(2 * j) * D, nullptr, 0, 0); PH_END
        PH_BEGIN_(9) {
#if FP8_DENSE
                   const bf16* w8 = (const bf16*)((const unsigned char*)C.wffn_gu + (size_t)j * GU * D);
                   Gemm g{(const bf16*)C.xn8, w8, 16384, GU, D / 2}; StaticOrder S; S.init(16384, GU, C.G, C.bid, 1); EpiSwiGLU8 E{(unsigned char*)ACT, FF, 1.0f / SW_GU, SA_ACT};
                   gemm_phase<EpiSwiGLU8, StaticOrder, true, true, true>(C.lds, g, S, E, C.tid); skinny_phase<2, 4, true>(C, (const bf16*)C.xn8, w8, GU, D, ACT, FF, nullptr, 1.0f / SW_GU, SA_ACT);
#else
                   Gemm g{C.XN, C.wffn_gu + (size_t)j * GU * D, 16384, GU, D}; StaticOrder S; S.init(16384, GU, C.G, C.bid, 1); EpiSwiGLU E{ACT, FF};
                   gemm_phase<EpiSwiGLU, StaticOrder, true, true>(C.lds, g, S, E, C.tid); skinny_phase<2, 4>(C, C.XN, C.wffn_gu + (size_t)j * GU * D, GU, D, ACT, FF, nullptr);
#endif
                   } PH_END
        PH_BEGIN_(10) {
#if FP8_DENSE
                   const bf16* w8 = (const bf16*)((const unsigned char*)C.wffn_dn + (size_t)j * D * FF);
                   Gemm g{ACT, w8, 16384, D, FF / 2}; StaticOrder S; S.init(16384, D, C.G, C.bid, 1); EpiResAddH E{Hres, D, 1.0f / (SW_DN * SA_ACT)};
                   gemm_phase<EpiResAddH, StaticOrder, true, true, true>(C.lds, g, S, E, C.tid); skinny_phase<1, 14, true>(C, ACT, w8, D, FF, nullptr, 0, Hres, 1.0f / (SW_DN * SA_ACT));
#else
                   Gemm g{ACT, C.wffn_dn + (size_t)j * D * FF, 16384, D, FF}; StaticOrder S; S.init(16384, D, C.G, C.bid, 1); EpiResAddH E{Hres, D, 1.0f};
                   gemm_phase<EpiResAddH, StaticOrder, true, true>(C.lds, g, S, E, C.tid); skinny_phase<1, 14>(C, ACT, C.wffn_dn + (size_t)j * D * FF, D, FF, nullptr, 0, Hres);
#endif
                   } PH_END
        PH_BEGIN_(11) norm_phase<1, false>(C, P->in[2] + (size_t)(2 * j + 1) * D, P->in[8] + (size_t)j * D * ML_LDW + MG0, ML_LDW, 0, P->in[9] + j * 4, P->in[10] + j * 4); PH_END
        PH_BEGIN_(12) { Gemm g{C.XN, C.wml_in + (size_t)j * ML_NP * D, 16384, ML_NP, D}; StaticOrder S; S.init(16384, ML_NP, C.G, C.bid, 1); EpiStoreBf16 E{PROJ, ML_NP, 1.0f};
                   gemm_phase<EpiStoreBf16, StaticOrder, true, true>(C.lds, g, S, E, C.tid); skinny_phase<0, 4>(C, C.XN, C.wml_in + (size_t)j * ML_NP * D, ML_NP, D, PROJ, ML_NP, nullptr); } PH_END
        PH_BEGIN_(13) ml_scan_phase(C); PH_END
        PH_BEGIN_(14) ml_dc_phase(C); PH_END
        PH_BEGIN_(15) ml_state_phase(C); PH_END
        PH_BEGIN_(16) ml_out_phase(C, P->in[11] + (size_t)j * D); PH_END
        PH_BEGIN_(17) { Gemm g{C.XN, C.wml_out + (size_t)j * D * D, 16384, D, D}; StaticOrder S; S.init(16384, D, C.G, C.bid, 1); EpiResAddH E{Hres, D, 1.0f};
                   gemm_phase<EpiResAddH, StaticOrder, true, true>(C.lds, g, S, E, C.tid); skinny_phase<1, 4>(C, C.XN, C.wml_out + (size_t)j * D * D, D, D, nullptr, 0, Hres); } PH_END
        PH_BEGIN_(18) norm_phase<2, false, FP8_MOE != 0>(C, P->in[3] + (size_t)(2 * j + 1) * D, P->in[16] + (size_t)j * D * 8, 8, j); PH_END
        PH_BEGIN_(19) moe_gather_phase(C, j); PH_END
        PH_BEGIN_(20) { int pb[9]; moe_bases(C, j, pb);
                   GroupedOrder S; S.nM = pb[8]; S.nN = GU / 256; S.nwg = S.nM * S.nN; S.G = C.G; S.c = C.bid; S.p1 = pb[1]; S.p2 = pb[2]; S.p3 = pb[3]; S.p4 = pb[4]; S.p5 = pb[5]; S.p6 = pb[6]; S.p7 = pb[7]; S.bmajor = MOE_GU_BMAJOR;
#if FP8_MOE
                   Gemm g{AS, (const bf16*)((const unsigned char*)C.wmoe_gu + (size_t)j * NE * GU * D), pb[8] * 256, GU, D / 2}; S.estride = (size_t)GU * D;
                   EpiSwiGLU8 E{(unsigned char*)ACT, FF, 1.0f / SW_GU, SA_ACT};
                   gemm_phase<EpiSwiGLU8, GroupedOrder, true, true, true>(C.lds, g, S, E, C.tid);
#else
                   Gemm g{AS, C.wmoe_gu + (size_t)j * NE * GU * D, pb[8] * 256, GU, D}; S.estride = (size_t)GU * D * 2;
                   EpiSwiGLU E{ACT, FF};
                   gemm_phase<EpiSwiGLU, GroupedOrder, true, true>(C.lds, g, S, E, C.tid);
#endif
                   } PH_END
        PH_BEGIN_(21) { int pb[9]; moe_bases(C, j, pb);
                   GroupedOrder S; S.nM = pb[8]; S.nN = D / 256; S.nwg = S.nM * S.nN; S.G = C.G; S.c = C.bid; S.p1 = pb[1]; S.p2 = pb[2]; S.p3 = pb[3]; S.p4 = pb[4]; S.p5 = pb[5]; S.p6 = pb[6]; S.p7 = pb[7]; S.bmajor = 0;
#if FP8_MOE
                   Gemm g{ACT, (const bf16*)((const unsigned char*)C.wmoe_dn + (size_t)j * NE * D * FF), pb[8] * 256, D, FF / 2}; S.estride = (size_t)D * FF;
                   EpiMoeDown E{(bf16*)(C.R + R_Y0), (bf16*)(C.R + R_Y1), C.slot_tok, C.slot_g, D, 1.0f / (SW_DN * SA_ACT)};
                   gemm_phase<EpiMoeDown, GroupedOrder, true, true, true>(C.lds, g, S, E, C.tid);
#else
                   Gemm g{ACT, C.wmoe_dn + (size_t)j * NE * D * FF, pb[8] * 256, D, FF}; S.estride = (size_t)D * FF * 2;
                   EpiMoeDown E{(bf16*)(C.R + R_Y0), (bf16*)(C.R + R_Y1), C.slot_tok, C.slot_g, D, 1.0f};
                   gemm_phase<EpiMoeDown, GroupedOrder, true, true>(C.lds, g, S, E, C.tid);
#endif
                   } PH_END
    }
#ifdef PROBE_BAR
    for (int q_ = 0; q_ < PROBE_BAR; ++q_) xcd_barrier(bar);
#endif
    PH_BEGIN_(22) final_phase(C, P->out); PH_END
#undef PH_BEGIN_
#undef PH_END
}

constexpr int NSITES = 24;
template <int S> struct SiteTab { static const void* get(int s) { return s == S ? (const void*)fwd<S> : SiteTab<S - 1>::get(s); } };
template <> struct SiteTab<-1> { static const void* get(int) { return nullptr; } };
#if N_LAUNCH_SPLIT
static const void* site_fn(int s) { return s >= 23 ? (const void*)fwd<22> : SiteTab<22>::get(s); }
#else
static const void* site_fn(int) { return (const void*)fwd<-1>; }
#endif
extern "C" void kernel_launch(void* const* d_in, const int* in_sizes, int n_in, void* d_out, int out_size, void* d_ws, size_t ws_size, hipStream_t stream) {
    static int grid = 0;
    if (grid == 0) {
        if (n_in != 20 || ws_size < WS_END) { fprintf(stderr, "kernel_launch: need 20 inputs and %zu bytes of workspace; got %d, %zu\n", (size_t)WS_END, n_in, ws_size); grid = -1; return; }
        int dev = 0, cus = 0, per_cu = 0;
        if (hipGetDevice(&dev) != hipSuccess || hipDeviceGetAttribute(&cus, hipDeviceAttributeMultiprocessorCount, dev) != hipSuccess) { grid = -1; return; }
        for (int s = 0; s < NSITES; ++s) if (hipFuncSetAttribute(site_fn(s), hipFuncAttributeMaxDynamicSharedMemorySize, LDS_BYTES) != hipSuccess) { fprintf(stderr, "kernel_launch: hipFuncSetAttribute failed\n"); grid = -1; return; }
        if (hipOccupancyMaxActiveBlocksPerMultiprocessor(&per_cu, site_fn(N_LAUNCH_SPLIT ? 1 : NSITES - 1), NTHREADS, LDS_BYTES) != hipSuccess || per_cu < 1) fprintf(stderr, "kernel_launch: occupancy query says %d\n", per_cu);
        (void)hipGetLastError();
        grid = cus;
    }
    if (grid < 0) return;
    (void)hipMemsetAsync((char*)d_ws + WS_CTL, 0, CTL_ZERO_BYTES, stream);
    Params p{};
    for (int i = 0; i < 20; ++i) p.in[i] = (const float*)d_in[i];
    p.out = (float*)d_out; p.ws = (unsigned char*)d_ws;
#if N_LAUNCH_SPLIT
    for (int ph = 0; ph < N_PHASES; ++ph) { p.ph_lo = ph; p.ph_hi = ph + 1; const int site = ph == 0 ? 0 : ph == N_PHASES - 1 ? 22 : 1 + (ph - 1) % 21; void* args[] = {&p};
        (void)hipLaunchKernel(site_fn(site), dim3(grid), dim3(NTHREADS), args, LDS_BYTES, stream); }
#else
    p.ph_lo = 0; p.ph_hi = N_PHASES; { void* args[] = {&p}; (void)hipLaunchKernel(site_fn(NSITES - 1), dim3(grid), dim3(NTHREADS), args, LDS_BYTES, stream); }
#endif
}
```

```cpp
#include <hip/hip_runtime.h>
#include <cstdio>
#include <cstdint>
#ifndef N_LAUNCH_SPLIT
#define N_LAUNCH_SPLIT 0
#endif
namespace pg8 {
#define PG8_LAS __attribute__((address_space(3)))
typedef unsigned short bf16_t;
typedef short bf16x8 __attribute__((ext_vector_type(8)));
typedef float f32x4 __attribute__((ext_vector_type(4)));
typedef unsigned u32x4 __attribute__((ext_vector_type(4)));
constexpr int BM = 256, BK = 64, HALF = 128, HTB = HALF * BK * 2  , STAGE_BYTES = 8 * HTB, NXCD = 8, WGM = 8;

__host__ __device__ __forceinline__ int lds_byte(int r, int c) { const int st = (r >> 4) * 2 + (c >> 5), rr = r & 15, cc = c & 31, ob = rr * 64 + cc * 2; return st * 1024 + (ob ^ (((ob >> 9) & 1) << 5)); }
__host__ __device__ __forceinline__ void stage_rc(int b, int& R, int& C) { const int st = b / 1024, sb = b % 1024, swz = sb ^ (((sb >> 9) & 1) << 5); R = (st >> 1) * 16 + swz / 64; C = (st & 1) * 32 + (swz % 64) / 2; }
__host__ __device__ __forceinline__ int perm32(int rho) { const int n = rho >> 4, i = rho & 15; return 8 * (i >> 2) + 4 * n + (i & 3); }

struct Unit { int pm, pn, r0; };
struct Gemm { const bf16_t* A; const bf16_t* Bt; int M, N, K; };

struct StaticOrder {
    int nM, nN, nwg, G, c, tokmap;
    __host__ __device__ void init(int M, int N, int G_, int c_, int tokmap_ = 0) { nM = M / BM; nN = N / BM; nwg = nM * nN; G = G_; c = c_; tokmap = tokmap_; }
    __host__ __device__ bool next(int i, Unit& u) const {
        const long L = (long)i * G + c; if (L >= nwg) return false;
        int wgid = (int)L; { const int q = nwg / NXCD, r = nwg % NXCD, xcd = wgid % NXCD, off = wgid / NXCD; wgid = (xcd < r ? xcd * (q + 1) : r * (q + 1) + (xcd - r) * q) + off; }
        const int nig = WGM * nN, gid = wgid / nig, fm = gid * WGM, gsz = (nM - fm) < WGM ? (nM - fm) : WGM;
        u.pm = fm + ((wgid % nig) % gsz); u.pn = (wgid % nig) / gsz; u.r0 = tokmap ? 4112 * (u.pm >> 4) + 16 + 256 * (u.pm & 15) : 256 * u.pm; return true;
    }
    __device__ __forceinline__ const char* b_base(const Gemm& g, const Unit& u, size_t tstep) const { return (const char*)g.Bt + (size_t)u.pn * tstep; }
    __device__ __forceinline__ void a_ready(const Unit&) const {}
    __device__ __forceinline__ void done(const Unit&) const {}
};
__device__ __forceinline__ unsigned cvt_pk_bf16(float lo, float hi) { unsigned r; asm volatile("v_cvt_pk_bf16_f32 %0, %1, %2" : "=v"(r) : "v"(lo), "v"(hi)); return r; }
typedef int i32x8 __attribute__((ext_vector_type(8)));
typedef int i32x4v __attribute__((ext_vector_type(4)));
__device__ __forceinline__ i32x8 cat8(bf16x8 a, bf16x8 b) { const i32x4v x = __builtin_bit_cast(i32x4v, a), y = __builtin_bit_cast(i32x4v, b); return __builtin_shufflevector(x, y, 0, 1, 2, 3, 4, 5, 6, 7); }
__device__ __forceinline__ float clamp448(float x) { return __builtin_amdgcn_fmed3f(x, -448.0f, 448.0f); }
__device__ __forceinline__ unsigned cvt4_fp8(float a, float b, float c, float d) { int w = 0; w = __builtin_amdgcn_cvt_pk_fp8_f32(clamp448(a), clamp448(b), w, false); w = __builtin_amdgcn_cvt_pk_fp8_f32(clamp448(c), clamp448(d), w, true); return (unsigned)w; }
typedef unsigned u32x2v __attribute__((ext_vector_type(2)));
struct EpiStoreBf16 {
    static constexpr bool PERM = true, AFTER_DRAIN = false;
    bf16_t* O; int ldc; float s;
    __device__ __forceinline__ void operator()(const f32x4 (&acc)[2][2][4][2], const Unit& u, int wr, int wc, int fr, int fq) const {
        const int row0 = u.r0 + wr * 64 + fr, col0 = u.pn * BM + wc * 32 + 8 * fq;
#pragma unroll
        for (int ai = 0; ai < 2; ++ai)
#pragma unroll
            for (int m = 0; m < 4; ++m) { bf16_t* rowp = O + (size_t)(row0 + ai * HALF + m * 16) * ldc + col0;
#pragma unroll
                for (int bj = 0; bj < 2; ++bj) { const f32x4 v0 = acc[ai][bj][m][0] * s, v1 = acc[ai][bj][m][1] * s;
                    u32x4 w; w.x = cvt_pk_bf16(v0[0], v0[1]); w.y = cvt_pk_bf16(v0[2], v0[3]); w.z = cvt_pk_bf16(v1[0], v1[1]); w.w = cvt_pk_bf16(v1[2], v1[3]);
                    *(u32x4*)(rowp + bj * HALF) = w; } }
    }
};
struct EpiResAdd {
    static constexpr bool PERM = false, AFTER_DRAIN = false;
    float* H; int ldc; float s;
    __device__ __forceinline__ void operator()(const f32x4 (&acc)[2][2][4][2], const Unit& u, int wr, int wc, int fr, int fq) const {
        const int row0 = u.r0 + wr * 64 + fr, col0 = u.pn * BM + wc * 32 + 4 * fq;
#pragma unroll
        for (int ai = 0; ai < 2; ++ai)
#pragma unroll
            for (int m = 0; m < 4; ++m) { float* rowp = H + (size_t)(row0 + ai * HALF + m * 16) * ldc + col0;
                f32x4 h[2][2];
#pragma unroll
                for (int bj = 0; bj < 2; ++bj)
#pragma unroll
                    for (int n = 0; n < 2; ++n) h[bj][n] = *(const f32x4*)(rowp + bj * HALF + n * 16);
#pragma unroll
                for (int bj = 0; bj < 2; ++bj)
#pragma unroll
                    for (int n = 0; n < 2; ++n) *(f32x4*)(rowp + bj * HALF + n * 16) = h[bj][n] + acc[ai][bj][m][n] * s;
                if (m & 1) asm volatile("" ::: "memory"); }
    }
};
struct EpiResAddB {
    static constexpr bool PERM = true, AFTER_DRAIN = false;
    bf16_t* H; int ldc; float s;
    __device__ __forceinline__ void operator()(const f32x4 (&acc)[2][2][4][2], const Unit& u, int wr, int wc, int fr, int fq) const {
        const int row0 = u.r0 + wr * 64 + fr, col0 = u.pn * BM + wc * 32 + 8 * fq;
#pragma unroll
        for (int ai = 0; ai < 2; ++ai)
#pragma unroll
            for (int m = 0; m < 4; ++m) { bf16_t* rowp = H + (size_t)(row0 + ai * HALF + m * 16) * ldc + col0;
                u32x4 h[2];
#pragma unroll
                for (int bj = 0; bj < 2; ++bj) h[bj] = *(const u32x4*)(rowp + bj * HALF);
#pragma unroll
                for (int bj = 0; bj < 2; ++bj) { const f32x4 v0 = acc[ai][bj][m][0] * s, v1 = acc[ai][bj][m][1] * s; const u32x4 q = h[bj];
                    u32x4 w; w.x = cvt_pk_bf16(__uint_as_float(q.x << 16) + v0[0], __uint_as_float(q.x & 0xffff0000u) + v0[1]); w.y = cvt_pk_bf16(__uint_as_float(q.y << 16) + v0[2], __uint_as_float(q.y & 0xffff0000u) + v0[3]);
                    w.z = cvt_pk_bf16(__uint_as_float(q.z << 16) + v1[0], __uint_as_float(q.z & 0xffff0000u) + v1[1]); w.w = cvt_pk_bf16(__uint_as_float(q.w << 16) + v1[2], __uint_as_float(q.w & 0xffff0000u) + v1[3]);
                    *(u32x4*)(rowp + bj * HALF) = w; }
                if (m & 1) asm volatile("" ::: "memory"); }
    }
};
__device__ __forceinline__ float silu_mul(float g, float u) { return g * __builtin_amdgcn_rcpf(1.0f + __expf(-g)) * u; }
struct EpiSwiGLU {
    static constexpr bool PERM = true, AFTER_DRAIN = false;
    bf16_t* O; int ldc;
    __device__ __forceinline__ void operator()(const f32x4 (&acc)[2][2][4][2], const Unit& u, int wr, int wc, int fr, int fq) const {
        const int row0 = u.r0 + wr * 64 + fr, col0 = u.pn * HALF + wc * 32 + 8 * fq;
#pragma unroll
        for (int ai = 0; ai < 2; ++ai)
#pragma unroll
            for (int m = 0; m < 4; ++m) { bf16_t* rowp = O + (size_t)(row0 + ai * HALF + m * 16) * ldc + col0;
                const f32x4 g0 = acc[ai][0][m][0], g1 = acc[ai][0][m][1], u0 = acc[ai][1][m][0], u1 = acc[ai][1][m][1];
                u32x4 w; w.x = cvt_pk_bf16(silu_mul(g0[0], u0[0]), silu_mul(g0[1], u0[1])); w.y = cvt_pk_bf16(silu_mul(g0[2], u0[2]), silu_mul(g0[3], u0[3]));
                w.z = cvt_pk_bf16(silu_mul(g1[0], u1[0]), silu_mul(g1[1], u1[1])); w.w = cvt_pk_bf16(silu_mul(g1[2], u1[2]), silu_mul(g1[3], u1[3]));
                *(u32x4*)rowp = w; }
    }
};
struct EpiSwiGLU8 {
    static constexpr bool PERM = true, AFTER_DRAIN = false;
    unsigned char* O; int ldc; float sg, so;
    __device__ __forceinline__ void operator()(const f32x4 (&acc)[2][2][4][2], const Unit& u, int wr, int wc, int fr, int fq) const {
        const int row0 = u.r0 + wr * 64 + fr, col0 = u.pn * HALF + wc * 32 + 8 * fq;
        const float ss = sg * sg * so;
#pragma unroll
        for (int ai = 0; ai < 2; ++ai)
#pragma unroll
            for (int m = 0; m < 4; ++m) { unsigned char* rowp = O + (size_t)(row0 + ai * HALF + m * 16) * ldc + col0;
                const f32x4 g0 = acc[ai][0][m][0], g1 = acc[ai][0][m][1], u0 = acc[ai][1][m][0], u1 = acc[ai][1][m][1];
                float a[8];
#pragma unroll
                for (int i = 0; i < 4; ++i) { a[i] = g0[i] * __builtin_amdgcn_rcpf(1.0f + __expf(-sg * g0[i])) * u0[i] * ss; a[4 + i] = g1[i] * __builtin_amdgcn_rcpf(1.0f + __expf(-sg * g1[i])) * u1[i] * ss; }
                u32x2v w; w.x = cvt4_fp8(a[0], a[1], a[2], a[3]); w.y = cvt4_fp8(a[4], a[5], a[6], a[7]);
                *(u32x2v*)rowp = w; }
    }
};
struct EpiMoeDown {
    static constexpr bool PERM = true, AFTER_DRAIN = false;
    bf16_t* Y0; bf16_t* Y1; const int* slot_tok; const float* slot_g; int ldc; float s;
    __device__ __forceinline__ void operator()(const f32x4 (&acc)[2][2][4][2], const Unit& u, int wr, int wc, int fr, int fq) const {
        const int row0 = u.r0 + wr * 64 + fr, col0 = u.pn * BM + wc * 32 + 8 * fq;
#pragma unroll
        for (int ai = 0; ai < 2; ++ai)
#pragma unroll
            for (int m = 0; m < 4; ++m) { const int slot = row0 + ai * HALF + m * 16; const int ti = slot_tok[slot]; const float g = slot_g[slot] * s;
                if (ti >= 0) { bf16_t* rowp = ((ti >> 16) ? Y1 : Y0) + (size_t)(ti & 0xffff) * ldc + col0;
#pragma unroll
                    for (int bj = 0; bj < 2; ++bj) { const f32x4 v0 = acc[ai][bj][m][0] * g, v1 = acc[ai][bj][m][1] * g;
                        u32x4 w; w.x = cvt_pk_bf16(v0[0], v0[1]); w.y = cvt_pk_bf16(v0[2], v0[3]); w.z = cvt_pk_bf16(v1[0], v1[1]); w.w = cvt_pk_bf16(v1[2], v1[3]);
                        *(u32x4*)(rowp + bj * HALF) = w; } } }
    }
};
struct GroupedOrder {
    int nM, nN, nwg, G, c; int p1, p2, p3, p4, p5, p6, p7; size_t estride; int bmajor;
    __device__ __forceinline__ bool next(int i, Unit& u) const {
        const long L = (long)i * G + c; if (L >= nwg) return false;
        int wgid = (int)L; { const int q = nwg / NXCD, r = nwg % NXCD, xcd = wgid % NXCD, off = wgid / NXCD; wgid = (xcd < r ? xcd * (q + 1) : r * (q + 1) + (xcd - r) * q) + off; }
        if (bmajor) {
            const int e = (wgid >= nN * p1) + (wgid >= nN * p2) + (wgid >= nN * p3) + (wgid >= nN * p4) + (wgid >= nN * p5) + (wgid >= nN * p6) + (wgid >= nN * p7);
            const int pe = e == 0 ? 0 : e == 1 ? p1 : e == 2 ? p2 : e == 3 ? p3 : e == 4 ? p4 : e == 5 ? p5 : e == 6 ? p6 : p7;
            const int pe1 = e == 0 ? p1 : e == 1 ? p2 : e == 2 ? p3 : e == 3 ? p4 : e == 4 ? p5 : e == 5 ? p6 : e == 6 ? p7 : nM;
            const int np = pe1 - pe, local = wgid - nN * pe, gsz = np * 7, pg = local / gsz, rem = local - pg * gsz, pmo = rem / 7;
            u.pm = pe + pmo; u.pn = pg * 7 + (rem - pmo * 7); u.r0 = 256 * u.pm; return true;
        }
        const int nig = WGM * nN, gid = wgid / nig, fm = gid * WGM, gsz = (nM - fm) < WGM ? (nM - fm) : WGM;
        u.pm = fm + ((wgid % nig) % gsz); u.pn = (wgid % nig) / gsz; u.r0 = 256 * u.pm; return true;
    }
    __device__ __forceinline__ const char* b_base(const Gemm& g, const Unit& u, size_t tstep) const {
        const int e = (u.pm >= p1) + (u.pm >= p2) + (u.pm >= p3) + (u.pm >= p4) + (u.pm >= p5) + (u.pm >= p6) + (u.pm >= p7);
        return (const char*)g.Bt + (size_t)e * estride + (size_t)u.pn * tstep; }
    __device__ __forceinline__ void a_ready(const Unit&) const {}
    __device__ __forceinline__ void done(const Unit&) const {}
};
template <class Epi, class Sched, bool ALIGN_EPI = false, bool SP2 = false, bool FP8 = false>
__device__ __forceinline__ void gemm_phase(PG8_LAS unsigned char* lds, const Gemm g, const Sched& S, const Epi& E, int tid_in) {
    int tid_ = tid_in; asm volatile("" : "+v"(tid_));
    const int tid = tid_, wid = __builtin_amdgcn_readfirstlane(tid >> 6), lane = tid & 63, wr = wid >> 2, wc = wid & 3, fr = lane & 15, fq = lane >> 4;
    const int K = g.K, nt = K / BK;
    unsigned voffA[2], voffB[2];
#pragma unroll
    for (int i = 0; i < 2; ++i) { int R, C; stage_rc(tid * 16 + i * 8192, R, C); const int Rb = Epi::PERM ? ((R & ~31) + perm32(R & 31)) : R;
        voffA[i] = (unsigned)(R * K + C) * 2u; voffB[i] = (unsigned)(Rb * K + C) * 2u; }
    const size_t kstep = (size_t)(BK * 2);
    const size_t hstep = (size_t)HALF * K * 2;
    const size_t tstep = 2 * hstep;
    const unsigned ldsw = (unsigned)wid * 1024u;
    const int aoff = lds_byte(wr * 64 + fr, fq * 8), boff = lds_byte(wc * 32 + fr, fq * 8);
#define PG8_SA(b, h) (((b) * 2 + (h)) * HTB)
#define PG8_SB(b, h) ((4 + (b) * 2 + (h)) * HTB)
#define PG8_STAGE(bufoff, gbase, voff) do { _Pragma("unroll") for (int _i = 0; _i < 2; ++_i) \
        __builtin_amdgcn_global_load_lds((const unsigned*)((const char*)(gbase) + (voff)[_i]), (PG8_LAS unsigned*)(lds + (bufoff) + ldsw + _i * 8192), 16, 0, 0); } while (0)
#define PG8_LDA(dst, b, h) do { _Pragma("unroll") for (int m = 0; m < 4; ++m) _Pragma("unroll") for (int k = 0; k < 2; ++k) { \
        if constexpr (FP8) { const i32x4v v_ = *(const PG8_LAS i32x4v*)(lds + PG8_SA(b, h) + aoff + m * 2048 + k * 1024); if (k == 0) dst##8[m].lo = v_; else dst##8[m].hi = v_; } \
        else dst[m][k] = *(const PG8_LAS bf16x8*)(lds + PG8_SA(b, h) + aoff + m * 2048 + k * 1024); } } while (0)
#define PG8_LDB(dst, b, h) do { _Pragma("unroll") for (int n = 0; n < 2; ++n) _Pragma("unroll") for (int k = 0; k < 2; ++k) { \
        if constexpr (FP8) { const i32x4v v_ = *(const PG8_LAS i32x4v*)(lds + PG8_SB(b, h) + boff + n * 2048 + k * 1024); if (k == 0) dst##8[n].lo = v_; else dst##8[n].hi = v_; } \
        else dst[n][k] = *(const PG8_LAS bf16x8*)(lds + PG8_SB(b, h) + boff + n * 2048 + k * 1024); } } while (0)
#define PG8_MMA(ai, bj, At, Bt) do { __builtin_amdgcn_s_setprio(1); _Pragma("unroll") for (int m = 0; m < 4; ++m) _Pragma("unroll") for (int n = 0; n < 2; ++n) { \
        if constexpr (FP8) asm volatile("v_mfma_scale_f32_16x16x128_f8f6f4 %0, %1, %2, %0, %3, %3 op_sel_hi:[0,0,0]" : "+v"(acc[ai][bj][m][n]) : "v"(Bt##8[n]), "v"(At##8[m]), "v"(sc7f));   \
        else { _Pragma("unroll") for (int k = 0; k < 2; ++k) acc[ai][bj][m][n] = __builtin_amdgcn_mfma_f32_16x16x32_bf16(Bt[n][k], At[m][k], acc[ai][bj][m][n], 0, 0, 0); } } \
        __builtin_amdgcn_s_setprio(0); } while (0)
#define PG8_WAIT_V(n) asm volatile("s_waitcnt vmcnt(" #n ")" ::: "memory")
#define PG8_WAIT_L(n) asm volatile("s_waitcnt lgkmcnt(" #n ")" ::: "memory")
#define PG8_BAR __builtin_amdgcn_s_barrier()
#define PG8_SCHED __builtin_amdgcn_sched_barrier(0)
    Unit cur, nxt; int ui = 0;
    if (!S.next(0, cur)) return;
    f32x4 acc[2][2][4][2];
#pragma unroll
    for (int a = 0; a < 2; ++a)
#pragma unroll
        for (int b = 0; b < 2; ++b)
#pragma unroll
            for (int m = 0; m < 4; ++m)
#pragma unroll
                for (int n = 0; n < 2; ++n) acc[a][b][m][n] = (f32x4){0.f, 0.f, 0.f, 0.f};
    int sc7f = 0x7f; asm volatile("" : "+v"(sc7f));
    bf16x8 At[4][2], B0[2][2], B1[2][2]; i32x8 At8[4], B08[2], B18[2];
    const char* cA = (const char*)g.A + (size_t)cur.r0 * K * 2; const char* cB = S.b_base(g, cur, tstep);
    S.a_ready(cur);
    if constexpr (SP2) {
        PG8_STAGE(PG8_SB(0, 0), cB, voffB); PG8_STAGE(PG8_SB(0, 1), cB + hstep, voffB); PG8_STAGE(PG8_SA(0, 0), cA, voffA); PG8_STAGE(PG8_SA(0, 1), cA + hstep, voffA);
        if (wr == 1) PG8_BAR;
        PG8_WAIT_V(2); PG8_BAR;
        PG8_STAGE(PG8_SB(1, 0), cB + kstep, voffB); PG8_STAGE(PG8_SA(1, 0), cA + kstep, voffA); PG8_STAGE(PG8_SB(1, 1), cB + hstep + kstep, voffB);
        PG8_WAIT_V(6); PG8_BAR;
    } else {
        PG8_STAGE(PG8_SB(0, 0), cB, voffB); PG8_STAGE(PG8_SA(0, 0), cA, voffA); PG8_STAGE(PG8_SB(0, 1), cB + hstep, voffB); PG8_STAGE(PG8_SA(0, 1), cA + hstep, voffA);
        if (wr == 1) PG8_BAR;
        PG8_WAIT_V(4); PG8_BAR;
        PG8_STAGE(PG8_SB(1, 0), cB + kstep, voffB); PG8_STAGE(PG8_SA(1, 0), cA + kstep, voffA); PG8_STAGE(PG8_SB(1, 1), cB + hstep + kstep, voffB);
        PG8_WAIT_V(6); PG8_BAR;
    }
    for (;;) {
        const bool has_next = S.next(ui + 1, nxt);
        const char* nA = has_next ? (const char*)g.A + (size_t)nxt.r0 * K * 2 : cA; const char* nB = has_next ? S.b_base(g, nxt, tstep) : cB;
        for (int t = 0; t < nt; t += 2) {
            const bool last = (t == nt - 2);
            const char* a1 = cA + (size_t)(t + 1) * kstep;
            const char* a2 = last ? nA : cA + (size_t)(t + 2) * kstep; const char* b2 = last ? nB : cB + (size_t)(t + 2) * kstep;
            const char* a3 = a2 + kstep; const char* b3 = b2 + kstep;
            if (last && has_next) S.a_ready(nxt);
            if constexpr (SP2) {
            PG8_LDB(B0, 0, 0); PG8_LDB(B1, 0, 1); PG8_SCHED; PG8_LDA(At, 0, 0); PG8_STAGE(PG8_SA(1, 1), a1 + hstep, voffA);
            PG8_WAIT_V(8); PG8_WAIT_L(0); PG8_BAR; PG8_MMA(0, 0, At, B0); PG8_MMA(0, 1, At, B1); PG8_BAR; PG8_SCHED;
            PG8_LDA(At, 0, 1); PG8_STAGE(PG8_SB(0, 0), b2, voffB); PG8_STAGE(PG8_SB(0, 1), b2 + hstep, voffB); PG8_STAGE(PG8_SA(0, 0), a2, voffA);
            PG8_WAIT_V(8); PG8_WAIT_L(0); PG8_BAR; PG8_MMA(1, 0, At, B0); PG8_MMA(1, 1, At, B1); PG8_BAR; PG8_SCHED;
            PG8_LDB(B0, 1, 0); PG8_LDB(B1, 1, 1); PG8_SCHED; PG8_LDA(At, 1, 0); PG8_STAGE(PG8_SA(0, 1), a2 + hstep, voffA);
            PG8_WAIT_V(8); PG8_WAIT_L(0); PG8_BAR; PG8_MMA(0, 0, At, B0); PG8_MMA(0, 1, At, B1); PG8_BAR; PG8_SCHED;
            PG8_LDA(At, 1, 1); PG8_STAGE(PG8_SB(1, 0), b3, voffB); PG8_STAGE(PG8_SB(1, 1), b3 + hstep, voffB); PG8_STAGE(PG8_SA(1, 0), a3, voffA);
            PG8_WAIT_V(8); PG8_WAIT_L(0); PG8_BAR; PG8_MMA(1, 0, At, B0); PG8_MMA(1, 1, At, B1); PG8_BAR; PG8_SCHED;
            } else {
            PG8_LDB(B0, 0, 0); PG8_SCHED; PG8_LDA(At, 0, 0); PG8_STAGE(PG8_SA(1, 1), a1 + hstep, voffA);
            PG8_WAIT_L(8); PG8_BAR; PG8_WAIT_L(0); PG8_MMA(0, 0, At, B0); PG8_BAR; PG8_SCHED;
            PG8_LDB(B1, 0, 1); PG8_STAGE(PG8_SB(0, 0), b2, voffB);
            PG8_BAR; PG8_WAIT_L(0); PG8_MMA(0, 1, At, B1); PG8_BAR;
            PG8_LDA(At, 0, 1); PG8_STAGE(PG8_SA(0, 0), a2, voffA);
            PG8_BAR; PG8_WAIT_L(0); PG8_MMA(1, 0, At, B0); PG8_BAR; PG8_SCHED;
            PG8_STAGE(PG8_SB(0, 1), b2 + hstep, voffB);
            PG8_WAIT_V(6); PG8_BAR; PG8_MMA(1, 1, At, B1); PG8_BAR;
            PG8_LDB(B0, 1, 0); PG8_SCHED; PG8_LDA(At, 1, 0); PG8_STAGE(PG8_SA(0, 1), a2 + hstep, voffA);
            PG8_WAIT_L(8); PG8_BAR; PG8_WAIT_L(0); PG8_MMA(0, 0, At, B0); PG8_BAR; PG8_SCHED;
            PG8_LDB(B1, 1, 1); PG8_STAGE(PG8_SB(1, 0), b3, voffB);
            PG8_BAR; PG8_WAIT_L(0); PG8_MMA(0, 1, At, B1); PG8_BAR;
            PG8_LDA(At, 1, 1); PG8_STAGE(PG8_SA(1, 0), a3, voffA);
            PG8_BAR; PG8_WAIT_L(0); PG8_MMA(1, 0, At, B0); PG8_BAR; PG8_SCHED;
            PG8_STAGE(PG8_SB(1, 1), b3 + hstep, voffB);
            PG8_WAIT_V(6); PG8_BAR; PG8_MMA(1, 1, At, B1); PG8_BAR;
            }
        }
        if constexpr (FP8) asm volatile("s_nop 15\n\ts_nop 15" ::: "memory");
        if constexpr (ALIGN_EPI) { if (wr == 0) PG8_BAR; }
        if constexpr (!Epi::AFTER_DRAIN) { E(acc, cur, wr, wc, fr, fq); S.done(cur); }
        if (!has_next) break;
#pragma unroll
        for (int a = 0; a < 2; ++a)
#pragma unroll
            for (int b = 0; b < 2; ++b)
#pragma unroll
                for (int m = 0; m < 4; ++m)
#pragma unroll
                    for (int n = 0; n < 2; ++n) acc[a][b][m][n] = (f32x4){0.f, 0.f, 0.f, 0.f};
        cur = nxt; cA = nA; cB = nB; ++ui;
        if constexpr (ALIGN_EPI) { if (wr == 1) PG8_BAR; }
    }
    PG8_WAIT_V(0);
    if constexpr (!ALIGN_EPI) { if (wr == 0) PG8_BAR; }
    PG8_BAR;
    if constexpr (Epi::AFTER_DRAIN) { E.fused(acc, cur, wr, wc, fr, fq, lds, wid, lane); S.done(cur); }
#undef PG8_SA
#undef PG8_SB
#undef PG8_STAGE
#undef PG8_LDA
#undef PG8_LDB
#undef PG8_MMA
#undef PG8_WAIT_V
#undef PG8_WAIT_L
#undef PG8_BAR
#undef PG8_SCHED
}
}
constexpr int BATCH = 4, SEQ = 4096, NMETA = 16, SL = SEQ + NMETA  , NT = BATCH * SL  , MP = 16640  , D = 1024;
constexpr int DSA_LDW = 2696, DSA_NP = 2816, DQ0 = 0, DK0 = 1024, DV0 = 1280, DIQ0 = 1536, DIK0 = 2560, DIW0 = 2688;
constexpr int ML_LDW = 3080, ML_NP = 3072, MQ0 = 0, MK0 = 512, MV0 = 1024, MO0 = 2048, MG0 = 3072;
constexpr int FF = 3584, GU = 7168, NE = 8;
constexpr int MOE_ROWS = 35072;
constexpr int NWAVES = 8, NTHREADS = 512;
#ifndef FP8_DENSE
#define FP8_DENSE 1
#endif
#ifndef FP8_MOE
#define FP8_MOE 1
#endif
constexpr float SW_GU = 32.0f, SW_DN = 128.0f, SA_ACT = 4.0f;
#ifndef CONV_IN_PROLOGUE
#define CONV_IN_PROLOGUE 0
#endif
#ifndef H_BF16
#define H_BF16 1
#endif
#ifndef MOE_GU_BMAJOR
#define MOE_GU_BMAJOR 0
#endif
#ifndef FP8_DSA
#define FP8_DSA 0
#endif
#ifndef FP8_DSA_IN
#define FP8_DSA_IN 0
#endif
constexpr float SW_DIN = 32.0f, SW_DOUT = 64.0f, SA_ATT = 16.0f;
constexpr int SCLD = 4128;
constexpr float RMS_EPS = 1e-6f;
constexpr size_t MiB = 1u << 20;
constexpr size_t WS_CTL = 0, CTL_ZERO_BYTES = 1 * MiB;
constexpr size_t WS_ROPE = 1 * MiB;
constexpr size_t WS_SM8 = 4 * MiB;
constexpr size_t WS_ROUTE = 5 * MiB;
constexpr size_t WS_MLG = 6 * MiB;
constexpr size_t WS_MLI = 17 * MiB + 256 * 1024;
constexpr size_t WS_NH = 7 * MiB;
constexpr size_t WS_SLOT = 8 * MiB;
constexpr size_t WS_SEL = 9 * MiB;
constexpr size_t WS_WDSA_IN = 18 * MiB, WS_WDSA_OUT = 29 * MiB, WS_WML_IN = 33 * MiB, WS_WML_OUT = 45 * MiB, WS_WFFN_GU = 49 * MiB, WS_WFFN_DN = 77 * MiB;
constexpr size_t WS_WMOE_GU = 91 * MiB, WS_WMOE_DN = 315 * MiB;
constexpr size_t WS_H = 427 * MiB;
constexpr size_t WS_XN = 492 * MiB;
constexpr size_t WS_R = 525 * MiB, WS_K8 = 875 * MiB, WS_XN8 = 875 * MiB, WS_END = 892 * MiB;
constexpr size_t R_PROJ = 0, R_SC = 90 * MiB, R_ACT = 0, R_DC = 98 * MiB, R_CH = 130 * MiB, R_AS = 240 * MiB, R_Y0 = 240 * MiB, R_Y1 = 274 * MiB;
static_assert(R_SC + (size_t)NT * SCLD * 4 + 16384 <= WS_K8 - WS_R, "score matrix (+ 8 KiB of never-read store slots behind it) fits");
static_assert((size_t)MOE_ROWS * FF * 2 <= R_AS && R_AS + (size_t)MOE_ROWS * D * 2 <= WS_K8 - WS_R, "moe buffers fit");
static_assert((size_t)MP * DSA_NP * 2 <= R_SC && (size_t)MP * ML_NP * 2 <= R_DC, "proj fits");
constexpr int CW_BAR = 4096;
constexpr int CW_CNT = 8192;
constexpr int LDS_BYTES = 151552;
constexpr int MISC_OFF = LDS_BYTES - 256;

#define GAS __attribute__((address_space(1)))
#define LAS __attribute__((address_space(3)))
typedef unsigned short bf16;
#if H_BF16
typedef unsigned short HT;
#else
typedef float HT;
#endif
typedef float f32x4 __attribute__((ext_vector_type(4)));
typedef float f32x2 __attribute__((ext_vector_type(2)));
typedef float f32x16 __attribute__((ext_vector_type(16)));
typedef short bf16x8 __attribute__((ext_vector_type(8)));
typedef short s16x4 __attribute__((ext_vector_type(4)));
typedef unsigned u32x4 __attribute__((ext_vector_type(4)));
typedef unsigned u32x2 __attribute__((ext_vector_type(2)));
#define MFMA32(a, b, c) __builtin_amdgcn_mfma_f32_32x32x16_bf16((a), (b), (c), 0, 0, 0)
#define MFMA16(a, b, c) __builtin_amdgcn_mfma_f32_16x16x32_bf16((a), (b), (c), 0, 0, 0)
__device__ __forceinline__ float bf2f(unsigned short b) { return __uint_as_float(((unsigned)b) << 16); }
__device__ __forceinline__ float bflo(unsigned w) { return __uint_as_float(w << 16); }
__device__ __forceinline__ float bfhi(unsigned w) { return __uint_as_float(w & 0xffff0000u); }
__device__ __forceinline__ unsigned pk2(float lo, float hi) { return pg8::cvt_pk_bf16(lo, hi); }
__device__ __forceinline__ float wave_sum(float v) {
#pragma unroll
    for (int o = 1; o < 64; o <<= 1) v += __shfl_xor(v, o);
    return v; }
__device__ __forceinline__ int crow(int r, int hi) { return (r & 3) + 8 * (r >> 2) + 4 * hi; }

#define XB_TMO      128
#define XB_XCNT(j)  (256  + 64 * (j))
#define XB_XSUB(j)  (1280 + 64 * (j))
#define XB_XGEN(j)  (2304 + 64 * (j))
#define XB_TOP      3328
#define XB_TOPGEN   3392
#define XCD_BAR_WORDS 3456
#define XB_SPIN_CAP (1u << 18)
__device__ __forceinline__ unsigned xb_ld(unsigned* p)              { return __hip_atomic_load(p, __ATOMIC_RELAXED, __HIP_MEMORY_SCOPE_AGENT); }
__device__ __forceinline__ unsigned xb_add(unsigned* p, unsigned v) { return __hip_atomic_fetch_add(p, v, __ATOMIC_RELAXED, __HIP_MEMORY_SCOPE_AGENT); }
__device__ __forceinline__ unsigned xb_xcc_id() { return (unsigned)__builtin_amdgcn_s_getreg((3 << 11) | 20) & 0xFu; }
#define XB_SPIN(cond, bar) do { unsigned _sp = 0; while (cond) { __builtin_amdgcn_s_sleep(1); \
    if ((++_sp & 255u) == 0u) { if (xb_ld(&(bar)[XB_TMO])) break; if (_sp > XB_SPIN_CAP) { atomicAdd(&(bar)[XB_TMO], 1u); break; } } } } while (0)
__device__ __forceinline__ int hw_lane() { int l; asm volatile("v_mbcnt_lo_u32_b32 %0, -1, 0\n\tv_mbcnt_hi_u32_b32 %0, -1, %0" : "=v"(l)); return l; }
struct XcdBarrier { unsigned* bar; unsigned x; volatile LAS unsigned* st; int wave; };
__device__ __forceinline__ XcdBarrier xcd_barrier_post(unsigned* bar, volatile LAS unsigned* st, int wave) {
    XcdBarrier b; b.bar = bar; b.x = xb_xcc_id(); b.st = st; b.wave = wave;
    if (wave == 0 && hw_lane() == 0) (void)xb_add(&bar[XB_XCNT(b.x)], 1u);
    return b;
}
__device__ __forceinline__ void xcd_barrier_complete(unsigned* bar, unsigned x, unsigned& nloc, unsigned& nx) {
    const unsigned G = gridDim.x * gridDim.y * gridDim.z;
    unsigned sum, cnt, mine, sp = 0u;
    for (;;) {
        sum = 0u; cnt = 0u; mine = 0u;
#pragma unroll
        for (unsigned j = 0; j < 16; ++j) { const unsigned c = xb_ld(&bar[XB_XCNT(j)]); sum += c; cnt += (c > 0u) ? 1u : 0u; mine = (j == x) ? c : mine; }
        if (sum == G) break;
        __builtin_amdgcn_s_sleep(1);
        if ((++sp & 255u) == 0u) { if (xb_ld(&bar[XB_TMO])) break; if (sp > XB_SPIN_CAP) { atomicAdd(&bar[XB_TMO], 1u); break; } }
    }
    nloc = mine > 0u ? mine : 1u; nx = cnt > 0u ? cnt : 1u;
}
__device__ __forceinline__ void xcd_barrier(const XcdBarrier& b) {
    asm volatile("s_waitcnt vmcnt(0)" ::: "memory");
    __syncthreads();
    if (b.wave == 0 && hw_lane() == 0) {
        unsigned* bar = b.bar;
        __builtin_amdgcn_s_waitcnt(0);
        unsigned nloc = b.st[0], nx = b.st[1];
        if (nloc == 0u) { xcd_barrier_complete(bar, b.x, nloc, nx); b.st[0] = nloc; b.st[1] = nx; }
        const unsigned old = xb_add(&bar[XB_XSUB(b.x)], 1u);
        const unsigned gen = old / nloc;
        if (old + 1u == (gen + 1u) * nloc) {
            __builtin_amdgcn_fence(__ATOMIC_RELEASE, "agent");
            asm volatile("s_waitcnt vmcnt(0)" ::: "memory");
            (void)xb_add(&bar[XB_TOP], 1u);
        }
        const unsigned target = (gen + 1u) * nx;
        XB_SPIN(xb_ld(&bar[XB_TOP]) < target, bar);
        __builtin_amdgcn_fence(__ATOMIC_ACQUIRE, "agent");
        asm volatile("s_waitcnt vmcnt(0)" ::: "memory");
    }
    __syncthreads();
}

struct Params { const float* in[20]; float* out; unsigned char* ws; int ph_lo, ph_hi; };
struct Ctx {
    LAS unsigned char* lds; int tid, lane, wave, G, bid, gw, ngw;
    unsigned* ctl;
    float2* rope; float* sm8; int* route_e; int* route_r1; int* route_r2; float* route_g1;
    float* mlf; float* mlc; float* mlp; float* mli; float* mlg; float* dn; float* nh; int* slot_tok; float* slot_g; unsigned short* sel;
    bf16 *wdsa_in, *wdsa_out, *wml_in, *wml_out, *wffn_gu, *wffn_dn, *wmoe_gu, *wmoe_dn;
    HT* H; bf16* XN; unsigned char* R; unsigned char* xn8;
};
__device__ __forceinline__ void conv_item(const float* W, int K, int ld, int n0, int k0, bf16* WT, int drow0, LAS float* scr, int lane) {
#pragma unroll 8
    for (int i = 0; i < 32; ++i) { const int kk = 2 * i + (lane >> 5); scr[kk * 33 + (lane & 31)] = W[(size_t)(k0 + kk) * ld + n0 + (lane & 31)]; }
    asm volatile("s_waitcnt lgkmcnt(0)" ::: "memory");
    const int c = lane & 7;
#pragma unroll
    for (int j = 0; j < 4; ++j) { const int n = (lane >> 3) + 8 * j; const LAS float* s = scr + (8 * c) * 33 + n;
        u32x4 o; o.x = pk2(s[0 * 33], s[1 * 33]); o.y = pk2(s[2 * 33], s[3 * 33]); o.z = pk2(s[4 * 33], s[5 * 33]); o.w = pk2(s[6 * 33], s[7 * 33]);
        *(u32x4*)(WT + (size_t)(drow0 + n) * K + k0 + 8 * c) = o; }
    asm volatile("s_waitcnt lgkmcnt(0)" ::: "memory");
}
__device__ __forceinline__ void conv_item8(const float* W, int K, int ld, int n0, int k0, unsigned char* WT, int drow0, LAS float* scr, int lane, float scale) {
#pragma unroll 8
    for (int i = 0; i < 32; ++i) { const int kk = 2 * i + (lane >> 5); scr[kk * 33 + (lane & 31)] = W[(size_t)(k0 + kk) * ld + n0 + (lane & 31)]; }
    asm volatile("s_waitcnt lgkmcnt(0)" ::: "memory");
    const int c = lane & 7;
#pragma unroll
    for (int j = 0; j < 4; ++j) { const int n = (lane >> 3) + 8 * j; const LAS float* s = scr + (8 * c) * 33 + n;
        u32x2 o; o.x = pg8::cvt4_fp8(s[0 * 33] * scale, s[1 * 33] * scale, s[2 * 33] * scale, s[3 * 33] * scale); o.y = pg8::cvt4_fp8(s[4 * 33] * scale, s[5 * 33] * scale, s[6 * 33] * scale, s[7 * 33] * scale);
        *(u32x2*)(WT + (size_t)(drow0 + n) * K + k0 + 8 * c) = o; }
    asm volatile("s_waitcnt lgkmcnt(0)" ::: "memory");
}
__device__ __forceinline__ void conv_plain8(const float* W, int K, int N, int ld, unsigned char* WT, int item, LAS float* scr, int lane, float scale) {
    const int nblk = N / 32, kb = item / nblk, nb = item % nblk;
    conv_item8(W, K, ld, 32 * nb, 64 * kb, WT, 32 * nb, scr, lane, scale);
}
__device__ __forceinline__ void conv_gu8(const float* W, int isup, unsigned char* WT, int item, LAS float* scr, int lane, float scale) {
    const int nblk = FF / 32, kb = item / nblk, nb = item % nblk, n0 = 32 * nb;
    conv_item8(W, D, FF, n0, 64 * kb, WT, 256 * (n0 >> 7) + 128 * isup + (n0 & 127), scr, lane, scale);
}
__device__ __forceinline__ void conv_plain(const float* W, int K, int N, int ld, bf16* WT, int item, LAS float* scr, int lane) {
    const int nblk = N / 32, kb = item / nblk, nb = item % nblk;
    conv_item(W, K, ld, 32 * nb, 64 * kb, WT, 32 * nb, scr, lane);
}
__device__ __forceinline__ void conv_gu(const float* W, int isup, bf16* WT, int item, LAS float* scr, int lane) {
    const int nblk = FF / 32, kb = item / nblk, nb = item % nblk, n0 = 32 * nb;
    conv_item(W, D, FF, n0, 64 * kb, WT, 256 * (n0 >> 7) + 128 * isup + (n0 & 127), scr, lane);
}
typedef const __attribute__((address_space(4))) Params* KArgP;
__device__ __forceinline__ void conv_big(const Ctx& C, KArgP P, int m, int r, LAS float* scr) {
    unsigned char* gu8d = (unsigned char*)C.wffn_gu; unsigned char* dn8d = (unsigned char*)C.wffn_dn; unsigned char* gu8m = (unsigned char*)C.wmoe_gu; unsigned char* dn8m = (unsigned char*)C.wmoe_dn;
    if (m < 2) { if (FP8_DENSE) conv_gu8(P->in[13] + (size_t)m * D * FF, 0, gu8d + (size_t)m * GU * D, r, scr, C.lane, SW_GU); else conv_gu(P->in[13] + (size_t)m * D * FF, 0, C.wffn_gu + (size_t)m * GU * D, r, scr, C.lane); }
    else if (m < 4) { if (FP8_DENSE) conv_gu8(P->in[14] + (size_t)(m - 2) * D * FF, 1, gu8d + (size_t)(m - 2) * GU * D, r, scr, C.lane, SW_GU); else conv_gu(P->in[14] + (size_t)(m - 2) * D * FF, 1, C.wffn_gu + (size_t)(m - 2) * GU * D, r, scr, C.lane); }
    else if (m < 6) { if (FP8_DENSE) conv_plain8(P->in[15] + (size_t)(m - 4) * FF * D, FF, D, D, dn8d + (size_t)(m - 4) * D * FF, r, scr, C.lane, SW_DN); else conv_plain(P->in[15] + (size_t)(m - 4) * FF * D, FF, D, D, C.wffn_dn + (size_t)(m - 4) * D * FF, r, scr, C.lane); }
    else if (m < 22) { if (FP8_MOE) conv_gu8(P->in[17] + (size_t)(m - 6) * D * FF, 0, gu8m + (size_t)(m - 6) * GU * D, r, scr, C.lane, SW_GU); else conv_gu(P->in[17] + (size_t)(m - 6) * D * FF, 0, C.wmoe_gu + (size_t)(m - 6) * GU * D, r, scr, C.lane); }
    else if (m < 38) { if (FP8_MOE) conv_gu8(P->in[18] + (size_t)(m - 22) * D * FF, 1, gu8m + (size_t)(m - 22) * GU * D, r, scr, C.lane, SW_GU); else conv_gu(P->in[18] + (size_t)(m - 22) * D * FF, 1, C.wmoe_gu + (size_t)(m - 22) * GU * D, r, scr, C.lane); }
    else { if (FP8_MOE) conv_plain8(P->in[19] + (size_t)(m - 38) * FF * D, FF, D, D, dn8m + (size_t)(m - 38) * D * FF, r, scr, C.lane, SW_DN); else conv_plain(P->in[19] + (size_t)(m - 38) * FF * D, FF, D, D, C.wmoe_dn + (size_t)(m - 38) * D * FF, r, scr, C.lane); }
}
struct ConvD { const float* src; unsigned char* dst; int K; float scale; };
template <int LD>
__device__ __forceinline__ void conv_ld32(const float* src, int lane, float (&v)[32]) {
    const float* p = src + (size_t)(lane >> 5) * LD + (lane & 31);
#pragma unroll
    for (int i = 0; i < 32; ++i) v[i] = p[(size_t)(2 * i) * LD];
}
__device__ __forceinline__ void conv_st8(const ConvD& d, const float (&v)[32], LAS float* scr, int lane) {
#pragma unroll
    for (int i = 0; i < 32; ++i) scr[(2 * i + (lane >> 5)) * 33 + (lane & 31)] = v[i];
    asm volatile("s_waitcnt lgkmcnt(0)" ::: "memory");
    const int c = lane & 7; const float scale = d.scale;
#pragma unroll
    for (int j = 0; j < 4; ++j) { const int n = (lane >> 3) + 8 * j; const LAS float* s = scr + (8 * c) * 33 + n;
        u32x2 o; o.x = pg8::cvt4_fp8(s[0 * 33] * scale, s[1 * 33] * scale, s[2 * 33] * scale, s[3 * 33] * scale); o.y = pg8::cvt4_fp8(s[4 * 33] * scale, s[5 * 33] * scale, s[6 * 33] * scale, s[7 * 33] * scale);
        *(u32x2*)(d.dst + (size_t)n * d.K + 8 * c) = o; }
    asm volatile("s_waitcnt lgkmcnt(0)" ::: "memory");
}
__device__ __forceinline__ bool conv_desc(const Ctx& C, KArgP P, int m, int r, ConvD& d) {
    unsigned char* gu8d = (unsigned char*)C.wffn_gu; unsigned char* dn8d = (unsigned char*)C.wffn_dn; unsigned char* gu8m = (unsigned char*)C.wmoe_gu; unsigned char* dn8m = (unsigned char*)C.wmoe_dn;
    const bool isdn = (m >= 4 && m < 6) || m >= 38;
    if (!isdn) {
        const int isup = (m >= 2 && m < 4) || (m >= 22); const int mm = m < 2 ? m : m < 4 ? m - 2 : m < 22 ? m - 6 : m - 22;
        const float* W = (m < 2 ? P->in[13] : m < 4 ? P->in[14] : m < 22 ? P->in[17] : P->in[18]) + (size_t)mm * D * FF;
        unsigned char* WT = (m < 4 ? gu8d : gu8m) + (size_t)mm * GU * D;
        const int nblk = FF / 32, kb = r / nblk, nb = r % nblk, n0 = 32 * nb, drow0 = 256 * (n0 >> 7) + 128 * isup + (n0 & 127);
        d.src = W + (size_t)(64 * kb) * FF + n0; d.dst = WT + (size_t)drow0 * D + 64 * kb; d.K = D; d.scale = SW_GU; return true;
    } else {
        const int mm = m < 6 ? m - 4 : m - 38;
        const float* W = (m < 6 ? P->in[15] : P->in[19]) + (size_t)mm * FF * D; unsigned char* WT = (m < 6 ? dn8d : dn8m) + (size_t)mm * D * FF;
        const int nblk = D / 32, kb = r / nblk, nb = r % nblk, n0 = 32 * nb;
        d.src = W + (size_t)(64 * kb) * D + n0; d.dst = WT + (size_t)n0 * FF + 64 * kb; d.K = FF; d.scale = SW_DN; return false;
    }
}
constexpr int CONV_TILE = 8 * (256 + 8) * 4;
__device__ __forceinline__ void conv_dma_issue(const ConvD& d, bool pitch_ff, int lane, LAS unsigned char* tile) {
    const unsigned ld = pitch_ff ? FF : D;
    const unsigned voff = ((unsigned)(lane >> 3) * ld + (unsigned)(lane & 7) * 4u) * 4u;
    const char* sb = (const char*)d.src;
#pragma unroll
    for (int t = 0; t < 8; ++t) { __builtin_amdgcn_global_load_lds((const unsigned*)(sb + voff), (LAS unsigned*)(tile + t * 1056), 16, 0, 0); sb += (size_t)ld * 32; }
}
__device__ __forceinline__ void conv_dma_finish(const ConvD& d, const LAS unsigned char* tile, int lane) {
    const int c = lane & 7; const float scale = d.scale;
#pragma unroll
    for (int j = 0; j < 4; ++j) { const int n = (lane >> 3) + 8 * j; const LAS float* s = (const LAS float*)tile + c * 264 + n;
        u32x2 o; o.x = pg8::cvt4_fp8(s[0 * 32] * scale, s[1 * 32] * scale, s[2 * 32] * scale, s[3 * 32] * scale); o.y = pg8::cvt4_fp8(s[4 * 32] * scale, s[5 * 32] * scale, s[6 * 32] * scale, s[7 * 32] * scale);
        *(u32x2*)(d.dst + (size_t)n * d.K + 8 * c) = o; }
    asm volatile("s_waitcnt lgkmcnt(0)" ::: "memory");
}
template <class MOf>
__device__ __forceinline__ void conv_stream(const Ctx& C, KArgP P, int first, int stride, int count, MOf m_of, int scr_pitch = 8448) {
    LAS float* scr = (LAS float*)(C.lds + C.wave * scr_pitch);
    int it = first; if (it >= count) return;
    ConvD da, db; float va[32], vb[32];
#define CONV_LOAD(d, v, i_) do { const bool g_ = conv_desc(C, P, m_of((i_) / 1792), (i_) % 1792, d); if (g_) conv_ld32<FF>(d.src, C.lane, v); else conv_ld32<D>(d.src, C.lane, v); } while (0)
    CONV_LOAD(da, va, it);
    for (;;) {
        const bool hb = it + stride < count;
        if (hb) CONV_LOAD(db, vb, it + stride);
        conv_st8(da, va, scr, C.lane);
        if (!hb) break;
        it += 2 * stride; const bool ha = it < count;
        if (ha) CONV_LOAD(da, va, it);
        conv_st8(db, vb, scr, C.lane);
        if (!ha) break;
    }
#undef CONV_LOAD
}
constexpr int CONV_IB = 1792;
__device__ __forceinline__ void conv_pair(const Ctx& C, KArgP P, int j) {
    conv_stream(C, P, C.gw, C.ngw, 27 * CONV_IB, [j](int q) { return q < 3 ? 2 * q + j : q < 11 ? 6 + 8 * j + (q - 3) : q < 19 ? 22 + 8 * j + (q - 11) : 38 + 8 * j + (q - 19); });
}
__device__ __forceinline__ void prologue_phase(const Ctx& C, KArgP P) {
    LAS float* scr = (LAS float*)(C.lds + C.wave * 8448);
    constexpr int IB = CONV_IB;
    constexpr int N_BIG = CONV_IN_PROLOGUE ? 54 * IB : 0;
    constexpr int I_DIN = 16 * 84, I_SQ = 16 * 32, I_MIN = 16 * 96;
    constexpr int N_SMALL = 2 * (I_DIN + I_SQ + I_MIN + I_SQ);
    if (N_BIG) conv_stream(C, P, C.gw, C.ngw, N_BIG, [](int q) { return q; });
    for (int it = C.gw; it < N_SMALL; it += C.ngw) {
        {
            int r = it;
            const int j = r / (N_SMALL / 2); r -= j * (N_SMALL / 2);
            if (r < I_DIN) { if (FP8_DSA_IN) conv_plain8(P->in[4] + (size_t)j * D * DSA_LDW, D, 2688, DSA_LDW, (unsigned char*)C.wdsa_in + (size_t)j * DSA_NP * D, r, scr, C.lane, SW_DIN);
                             else conv_plain(P->in[4] + (size_t)j * D * DSA_LDW, D, 2688, DSA_LDW, C.wdsa_in + (size_t)j * DSA_NP * D, r, scr, C.lane); continue; } r -= I_DIN;
            if (r < I_SQ) { if (FP8_DSA) conv_plain8(P->in[7] + (size_t)j * D * D, D, D, D, (unsigned char*)C.wdsa_out + (size_t)j * D * D, r, scr, C.lane, SW_DOUT);
                            else conv_plain(P->in[7] + (size_t)j * D * D, D, D, D, C.wdsa_out + (size_t)j * D * D, r, scr, C.lane); continue; } r -= I_SQ;
            if (r < I_MIN) { conv_plain(P->in[8] + (size_t)j * D * ML_LDW, D, ML_NP, ML_LDW, C.wml_in + (size_t)j * ML_NP * D, r, scr, C.lane); continue; } r -= I_MIN;
            conv_plain(P->in[12] + (size_t)j * D * D, D, D, D, C.wml_out + (size_t)j * D * D, r, scr, C.lane);
        }
    }
    const int gt = C.bid * NTHREADS + C.tid, ngt = C.G * NTHREADS;
    for (int i = gt; i < 2 * 128 * D / 8; i += ngt) { const int j = i / (128 * D / 8), o = i % (128 * D / 8);
        if (FP8_DSA_IN) { if (o < 128 * D / 16) *(u32x4*)((unsigned char*)C.wdsa_in + (size_t)j * DSA_NP * D + (size_t)2688 * D + (size_t)o * 16) = (u32x4){0u, 0u, 0u, 0u}; }
        else *(u32x4*)(C.wdsa_in + (size_t)j * DSA_NP * D + (size_t)2688 * D + (size_t)o * 8) = (u32x4){0u, 0u, 0u, 0u}; }
    for (int i = gt; i < (MP - NT) * D / 8; i += ngt) *(u32x4*)(C.XN + (size_t)NT * D + (size_t)i * 8) = (u32x4){0u, 0u, 0u, 0u};
    const float* x = P->in[0]; const float* meta = P->in[1];
    for (int i = gt; i < MP * (D / 4); i += ngt) { const int row = i / (D / 4), c4 = i % (D / 4); f32x4 v = (f32x4){0.f, 0.f, 0.f, 0.f};
        if (row < NT) { const int b = row / SL, p = row % SL;
            v = (p < NMETA) ? *(const f32x4*)(meta + (size_t)p * D + c4 * 4) : *(const f32x4*)(x + ((size_t)b * SEQ + (p - NMETA)) * D + c4 * 4); }
#if H_BF16
        u32x2 hv; hv.x = pk2(v[0], v[1]); hv.y = pk2(v[2], v[3]); *(u32x2*)(C.H + (size_t)row * D + c4 * 4) = hv; }
#else
        *(f32x4*)(C.H + (size_t)row * D + c4 * 4) = v; }
#endif
    for (int i = gt; i < SL * 64; i += ngt) { const int pos = i >> 6, k = i & 63; double inv = 1.0;
        for (int q = 0; q < k; ++q) inv *= 0.86596432336006535;
        const double a = (double)pos * inv; C.rope[i] = make_float2((float)cos(a), (float)sin(a)); }
}

template <int MODE, bool ADDY, bool OUT8 = false>
__device__ __forceinline__ void norm_phase(const Ctx& C, const float* gain, const float* W8, int ldw, int moe_layer, const float* aux0 = nullptr, const float* aux1 = nullptr) {
    const bf16* Y0 = (const bf16*)(C.R + R_Y0); const bf16* Y1 = (const bf16*)(C.R + R_Y1);
    const int lane = C.lane;
    float w8r[4][4][8];
    if (MODE != 3) {
#pragma unroll
        for (int j = 0; j < 4; ++j)
#pragma unroll
            for (int i = 0; i < 4; ++i) { const float* wp = W8 + (size_t)(256 * j + 4 * lane + i) * ldw; const f32x4 w0 = *(const f32x4*)wp, w1 = *(const f32x4*)(wp + 4);
                w8r[j][i][0] = w0[0]; w8r[j][i][1] = w0[1]; w8r[j][i][2] = w0[2]; w8r[j][i][3] = w0[3]; w8r[j][i][4] = w1[0]; w8r[j][i][5] = w1[1]; w8r[j][i][6] = w1[2]; w8r[j][i][7] = w1[3]; }
    }
    f32x4 gv[4];
#pragma unroll
    for (int j = 0; j < 4; ++j) gv[j] = ((const f32x4*)gain)[64 * j + C.lane];
    int prow = -1, pe = 0, pr1 = 0, pr2 = 0; float pg1 = 0.f;
#if H_BF16
    u32x2 hq[4], ya[4], yb[4];
#define NORM_ISSUE(row_) do { const HT* hr_ = C.H + (size_t)(row_) * D; _Pragma("unroll") for (int j = 0; j < 4; ++j) hq[j] = ((const u32x2*)hr_)[64 * j + C.lane]; \
        if (ADDY) { _Pragma("unroll") for (int j = 0; j < 4; ++j) { ya[j] = *(const u32x2*)(Y0 + (size_t)(row_) * D + 256 * j + 4 * C.lane); yb[j] = *(const u32x2*)(Y1 + (size_t)(row_) * D + 256 * j + 4 * C.lane); } } } while (0)
    if (C.gw < NT) NORM_ISSUE(C.gw);
#endif
    for (int row = C.gw; row < NT; row += C.ngw) {
        HT* hrow = C.H + (size_t)row * D;
        f32x4 v[4]; float ss = 0.f;
#if H_BF16
#pragma unroll
        for (int j = 0; j < 4; ++j) { v[j][0] = bflo(hq[j].x); v[j][1] = bfhi(hq[j].x); v[j][2] = bflo(hq[j].y); v[j][3] = bfhi(hq[j].y); }
        if (ADDY) {
#pragma unroll
            for (int j = 0; j < 4; ++j) { const u32x2 a = ya[j], b = yb[j];
                v[j][0] += bflo(a.x) + bflo(b.x); v[j][1] += bfhi(a.x) + bfhi(b.x); v[j][2] += bflo(a.y) + bflo(b.y); v[j][3] += bfhi(a.y) + bfhi(b.y);
                { u32x2 hv; hv.x = pk2(v[j][0], v[j][1]); hv.y = pk2(v[j][2], v[j][3]); ((u32x2*)hrow)[64 * j + C.lane] = hv; } }
        }
        if (row + C.ngw < NT) NORM_ISSUE(row + C.ngw);
#else
#pragma unroll
        for (int j = 0; j < 4; ++j) v[j] = ((const f32x4*)hrow)[64 * j + C.lane];
        if (ADDY) {
#pragma unroll
            for (int j = 0; j < 4; ++j) { const u32x2 a = *(const u32x2*)(Y0 + (size_t)row * D + 256 * j + 4 * C.lane), b = *(const u32x2*)(Y1 + (size_t)row * D + 256 * j + 4 * C.lane);
                v[j][0] += bflo(a.x) + bflo(b.x); v[j][1] += bfhi(a.x) + bfhi(b.x); v[j][2] += bflo(a.y) + bflo(b.y); v[j][3] += bfhi(a.y) + bfhi(b.y);
                ((f32x4*)hrow)[64 * j + C.lane] = v[j]; }
        }
#endif
#pragma unroll
        for (int j = 0; j < 4; ++j) ss += (v[j][0] * v[j][0] + v[j][1] * v[j][1]) + (v[j][2] * v[j][2] + v[j][3] * v[j][3]);
        const float rstd = 1.0f / sqrtf(wave_sum(ss) * (1.0f / D) + RMS_EPS);
#pragma unroll
        for (int j = 0; j < 4; ++j) { const f32x4 g = gv[j]; v[j] = v[j] * rstd * g;
            if (OUT8) *(unsigned*)(C.xn8 + (size_t)row * D + 256 * j + 4 * C.lane) = pg8::cvt4_fp8(v[j][0], v[j][1], v[j][2], v[j][3]);
            else { u32x2 o; o.x = pk2(v[j][0], v[j][1]); o.y = pk2(v[j][2], v[j][3]); *(u32x2*)(C.XN + (size_t)row * D + 256 * j + 4 * C.lane) = o; } }
        if (MODE != 3) {
            float dot[8];
#pragma unroll
            for (int e = 0; e < 8; ++e) dot[e] = 0.f;
#pragma unroll
            for (int j = 0; j < 4; ++j)
#pragma unroll
                for (int i = 0; i < 4; ++i) { const float y = v[j][i];
#pragma unroll
                    for (int e = 0; e < 8; ++e) dot[e] = fmaf(y, w8r[j][i][e], dot[e]); }
            float r4[4], r2[2], r1;
#pragma unroll
            for (int k = 0; k < 4; ++k) { const float send = (lane & 1) ? dot[k] : dot[4 + k], keep = (lane & 1) ? dot[4 + k] : dot[k]; r4[k] = keep + __shfl_xor(send, 1); }
#pragma unroll
            for (int k = 0; k < 2; ++k) { const float send = (lane & 2) ? r4[k] : r4[2 + k], keep = (lane & 2) ? r4[2 + k] : r4[k]; r2[k] = keep + __shfl_xor(send, 2); }
            { const float send = (lane & 4) ? r2[0] : r2[1], keep = (lane & 4) ? r2[1] : r2[0]; r1 = keep + __shfl_xor(send, 4); }
            r1 += __shfl_xor(r1, 8); r1 += __shfl_xor(r1, 16); r1 += __shfl_xor(r1, 32);
            const int ev = 4 * (lane & 1) + 2 * ((lane >> 1) & 1) + ((lane >> 2) & 1);
            if (MODE == 0) { if (lane < 8) C.sm8[(size_t)row * 8 + ev] = r1 * 0.03125f; }
            if (MODE == 1) {
                if (lane < 8) { const int b = row / SL, pos = row % SL, sl_ = pos / 65, si = pos % 65, h = ev & 3;
                    const float z = (r1 + (ev < 4 ? aux0[h] : aux1[h])) * (2.0f / 15.0f);
                    const float x = 15.0f * (1.0f - 2.0f / (1.0f + __expf(z)));
                    float* dst = (ev < 4 ? C.mli : C.mlg) + ((b * 4 + h) * 65 + si) * 64 + sl_;
                    *dst = (ev < 4) ? x : fminf(x, 0.f) - __logf(1.0f + __expf(-fabsf(x))); } }
            if (MODE == 2) {
#pragma unroll
                for (int e = 0; e < 8; ++e) dot[e] = __shfl(r1, (e >> 2) + 2 * ((e >> 1) & 1) + 4 * (e & 1));
                if (lane == 0) {
                    float v1 = dot[0]; int e1 = 0;
#pragma unroll
                    for (int e = 1; e < 8; ++e) if (dot[e] > v1) { v1 = dot[e]; e1 = e; }
                    float v2 = -INFINITY; int e2 = 0;
#pragma unroll
                    for (int e = 0; e < 8; ++e) if (e != e1 && dot[e] > v2) { v2 = dot[e]; e2 = e; }
                    const float g1 = 1.0f / (1.0f + expf(v2 - v1));
                    const int r1i = (int)atomicAdd(C.ctl + CW_CNT + (moe_layer * 8 + e1) * 64, 1u), r2i = (int)atomicAdd(C.ctl + CW_CNT + (moe_layer * 8 + e2) * 64, 1u);
                    if (prow >= 0) { C.route_e[prow] = pe; C.route_r1[prow] = pr1; C.route_r2[prow] = pr2; C.route_g1[prow] = pg1; }
                    prow = row; pe = e1 | (e2 << 8); pr1 = r1i; pr2 = r2i; pg1 = g1;
                }
            }
        }
    }
    if (MODE == 2) { if (lane == 0 && prow >= 0) { C.route_e[prow] = pe; C.route_r1[prow] = pr1; C.route_r2[prow] = pr2; C.route_g1[prow] = pg1; } }
#if H_BF16
#undef NORM_ISSUE
#endif
}

__device__ __forceinline__ void unpack8(const u32x4 w, float (&x)[8]) { x[0] = bflo(w.x); x[1] = bfhi(w.x); x[2] = bflo(w.y); x[3] = bfhi(w.y); x[4] = bflo(w.z); x[5] = bfhi(w.z); x[6] = bflo(w.w); x[7] = bfhi(w.w); }
__device__ __forceinline__ u32x4 pack8(const float (&x)[8]) { u32x4 w; w.x = pk2(x[0], x[1]); w.y = pk2(x[2], x[3]); w.z = pk2(x[4], x[5]); w.w = pk2(x[6], x[7]); return w; }
__device__ __forceinline__ void dsa_post_phase(const Ctx& C, const float* gq, const float* gk) {
    bf16* PROJ = (bf16*)(C.R + R_PROJ);
    for (int row = C.gw; row < NT; row += C.ngw) {
        const int pos = row % SL; bf16* pr = PROJ + (size_t)row * DSA_NP; const float2* rp = C.rope + (size_t)pos * 64;
        const int lane = C.lane;
#pragma unroll
        for (int pass = 0; pass < 2; ++pass) {
            if (pass == 1 && lane >= 16) break;
            const int head = lane >> 2, part = lane & 3; bf16* hp = pr + (pass == 0 ? DQ0 : DK0) + head * 64 + 8 * part; const float* gg = pass == 0 ? gq : gk;
            float x1[8], x2[8]; unpack8(*(const u32x4*)hp, x1); unpack8(*(const u32x4*)(hp + 32), x2);
            float ss = 0.f;
#pragma unroll
            for (int e = 0; e < 8; ++e) ss += x1[e] * x1[e] + x2[e] * x2[e];
            ss += __shfl_xor(ss, 1); ss += __shfl_xor(ss, 2);
            const float rstd = 1.0f / sqrtf(ss * (1.0f / 64.0f) + RMS_EPS), osc = pass == 0 ? 0.125f : 1.0f;
#pragma unroll
            for (int e = 0; e < 8; ++e) { const int i = 8 * part + e; const float2 cs = rp[2 * i];
                const float y1 = x1[e] * rstd * gg[i], y2 = x2[e] * rstd * gg[i + 32];
                x1[e] = (y1 * cs.x - y2 * cs.y) * osc; x2[e] = (y2 * cs.x + y1 * cs.y) * osc; }
            *(u32x4*)hp = pack8(x1); *(u32x4*)(hp + 32) = pack8(x2);
        }
#pragma unroll
        for (int pass = 0; pass < 2; ++pass) {
            if (pass == 1 && lane >= 8) break;
            const int head = lane >> 3, part = lane & 7; bf16* hp = pr + (pass == 0 ? DIQ0 + head * 128 : DIK0) + 8 * part;
            float x1[8], x2[8]; unpack8(*(const u32x4*)hp, x1); unpack8(*(const u32x4*)(hp + 64), x2);
#pragma unroll
            for (int e = 0; e < 8; ++e) { const float2 cs = rp[8 * part + e]; const float y1 = x1[e], y2 = x2[e];
                x1[e] = y1 * cs.x - y2 * cs.y; x2[e] = y2 * cs.x + y1 * cs.y; }
            *(u32x4*)hp = pack8(x1); *(u32x4*)(hp + 64) = pack8(x2);
        }
    }
}
__device__ __forceinline__ void score_phase(const Ctx& C) {
    const bf16* PROJ = (const bf16*)(C.R + R_PROJ); float* SC = (float*)(C.R + R_SC);
    const int lane = C.lane, m31 = lane & 31, hi = lane >> 5, w = C.wave;
    const int aq = 2 * (m31 >> 4) + ((m31 >> 2) & 1), ah = 4 * ((m31 >> 3) & 1) + (m31 & 3);
    constexpr int SCP = 1088, SCB = 8 * SCP;
    LAS unsigned char* ring = C.lds;
    const LAS unsigned char* bfp = ring + (m31 >> 2) * SCP + 64 * hi + 16 * (m31 & 3);
    constexpr int TPB = 65 + 57 + 49 + 41 + 33 + 25 + 17 + 9 + 1;
    for (int t = C.bid; t < BATCH * TPB; t += C.G) {
        const int b = t / TPB, tt = t % TPB;
        const int kc = (tt >= 65) + (tt >= 122) + (tt >= 171) + (tt >= 212) + (tt >= 245) + (tt >= 270) + (tt >= 287) + (tt >= 296);
        const int toff = 65 * kc - 4 * kc * (kc - 1);
        const int qg = 64 * kc + 8 * (tt - toff) + w; const bool act = qg < 514;
        const int qgc = act ? qg : 513, q0 = 8 * qgc, k0 = 512 * kc;
        const int qlast = 64 * kc + 8 * (tt - toff) + 7, qmax = (qlast < 514 ? qlast : 513) * 8 + 8;
        const int kendw = (k0 + 512 < q0 + 8) ? k0 + 512 : q0 + 8;
        const int kendg = (k0 + 512 < qmax) ? k0 + 512 : qmax;
        const int nkt = (kendg - k0 + 31) >> 5, nktw = act ? (kendw - k0 + 31) >> 5 : 0;
        bf16x8 a[2][8]; f32x4 wv[2][4];
#pragma unroll
        for (int rb = 0; rb < 2; ++rb) {
            const bf16* ap = PROJ + (size_t)(b * SL + q0 + 4 * rb + aq) * DSA_NP + DIQ0 + ah * 128 + 8 * hi;
#pragma unroll
            for (int ks = 0; ks < 8; ++ks) a[rb][ks] = *(const bf16x8*)(ap + 16 * ks);
            const float* w0 = C.sm8 + (size_t)(b * SL + q0 + 4 * rb + hi) * 8; const float* w1 = w0 + 16;
            wv[rb][0] = *(const f32x4*)w0; wv[rb][1] = *(const f32x4*)(w0 + 4); wv[rb][2] = *(const f32x4*)w1; wv[rb][3] = *(const f32x4*)(w1 + 4);
        }
        float* sc0 = SC + (size_t)(b * SL + q0 + hi) * SCLD;
        const bf16* ikb = PROJ + (size_t)b * SL * DSA_NP + DIK0 + (lane >> 2) * 8;
        const int kr0 = k0 + 4 * w + (lane & 3);
#define SC_ISSUE(kt_) do { if ((kt_) < nkt) { const int key_ = kr0 + 32 * (kt_), kc_ = key_ < SL ? key_ : SL - 1; \
            __builtin_amdgcn_global_load_lds((const unsigned*)(ikb + (size_t)kc_ * DSA_NP), (LAS unsigned*)(ring + ((kt_) & 3) * SCB + w * SCP), 16, 0, 0); } } while (0)
        asm volatile("s_waitcnt vmcnt(0)" ::: "memory");
#pragma unroll
        for (int rb = 0; rb < 2; ++rb) {
#pragma unroll
            for (int ks = 0; ks < 8; ++ks) asm volatile("" : "+v"(a[rb][ks]));
#pragma unroll
            for (int q = 0; q < 4; ++q) asm volatile("" : "+v"(wv[rb][q])); }
        __builtin_amdgcn_s_barrier();
        SC_ISSUE(0); SC_ISSUE(1); SC_ISSUE(2);
        float* dum = SC + (size_t)NT * SCLD + 4 * C.tid;
        for (int kt = 0; kt < nkt; ++kt) {
            { const int cnt = 4 * (kt < 3 ? kt : 3) + (kt + 1 < nkt) + (kt + 2 < nkt);
              switch (cnt) { case 0: asm volatile("s_waitcnt vmcnt(0)" ::: "memory"); break; case 1: asm volatile("s_waitcnt vmcnt(1)" ::: "memory"); break; case 2: asm volatile("s_waitcnt vmcnt(2)" ::: "memory"); break;
                case 4: asm volatile("s_waitcnt vmcnt(4)" ::: "memory"); break; case 5: asm volatile("s_waitcnt vmcnt(5)" ::: "memory"); break; case 6: asm volatile("s_waitcnt vmcnt(6)" ::: "memory"); break;
                case 8: asm volatile("s_waitcnt vmcnt(8)" ::: "memory"); break; case 9: asm volatile("s_waitcnt vmcnt(9)" ::: "memory"); break; case 10: asm volatile("s_waitcnt vmcnt(10)" ::: "memory"); break;
                case 12: asm volatile("s_waitcnt vmcnt(12)" ::: "memory"); break; case 13: asm volatile("s_waitcnt vmcnt(13)" ::: "memory"); break; default: asm volatile("s_waitcnt vmcnt(14)" ::: "memory"); break; } }
            __builtin_amdgcn_s_barrier();
            asm volatile("" ::: "memory");
            SC_ISSUE(kt + 3);
            asm volatile("" ::: "memory");
            const int key = k0 + 32 * kt + m31;
            float v00 = 0.f, v01 = 0.f, v10 = 0.f, v11 = 0.f;
            if (kt < nktw) {
                const LAS unsigned char* bp = bfp + (kt & 3) * SCB;
                bf16x8 bf_[8];
#pragma unroll
                for (int ks = 0; ks < 8; ++ks) bf_[ks] = *(const LAS bf16x8*)(bp + 128 * ks);
                asm volatile("s_waitcnt lgkmcnt(0)" ::: "memory");
                f32x16 acc0, acc1;
#pragma unroll
                for (int r = 0; r < 16; ++r) { acc0[r] = 0.f; acc1[r] = 0.f; }
#pragma unroll
                for (int ks = 0; ks < 8; ++ks) { acc0 = MFMA32(a[0][ks], bf_[ks], acc0); acc1 = MFMA32(a[1][ks], bf_[ks], acc1); }
#pragma unroll
                for (int e = 0; e < 8; ++e) { v00 = fmaf(fmaxf(acc0[e], 0.f), wv[0][e >> 2][e & 3], v00); v01 = fmaf(fmaxf(acc0[8 + e], 0.f), wv[0][2 + (e >> 2)][e & 3], v01);
                    v10 = fmaf(fmaxf(acc1[e], 0.f), wv[1][e >> 2][e & 3], v10); v11 = fmaf(fmaxf(acc1[8 + e], 0.f), wv[1][2 + (e >> 2)][e & 3], v11); }
            }
            const bool okst = kt < nktw && key < kendw;
            float* p0 = okst ? sc0 + key : dum; float* p1 = okst ? sc0 + (size_t)2 * SCLD + key : dum + 1; float* p2 = okst ? sc0 + (size_t)4 * SCLD + key : dum + 2; float* p3 = okst ? sc0 + (size_t)6 * SCLD + key : dum + 3;
            asm volatile("" ::: "memory");
            __builtin_nontemporal_store(v00, p0); __builtin_nontemporal_store(v01, p1); __builtin_nontemporal_store(v10, p2); __builtin_nontemporal_store(v11, p3);
            asm volatile("" ::: "memory");
        }
#undef SC_ISSUE
    }
}

template <int NR>
__device__ __forceinline__ void topk_keys(const float* sr, unsigned (&k)[NR], int n, int lane) {
    float v[NR];
#pragma unroll
    for (int j = 0; j < NR; ++j) { const int idx = 64 * j + lane; v[j] = __builtin_nontemporal_load(sr + (idx < n ? idx : n - 1)); }
#pragma unroll
    for (int j = 0; j < NR; ++j) { const int idx = 64 * j + lane; const unsigned u = __float_as_uint(v[j] + 0.0f); const unsigned key = (u & 0x80000000u) ? ~u : (u | 0x80000000u);
        k[j] = idx < n ? key : 0u; }
}
constexpr int TOPK_MID_BIT = -1, TOPK_MID_NR = 40;
template <int NR, class Mid>
__device__ __forceinline__ void topk_select(const unsigned (&k)[NR], unsigned short* sel, int lane, Mid mid) {
    unsigned T = 0u; bool exact = false;
    for (int bit = 31; bit >= 0; --bit) {
        if (bit == TOPK_MID_BIT) mid();
        const unsigned cand = T | (1u << bit); int cl = 0;
#define TK_CA(n_) "v_cmp_ge_u32 vcc, %" #n_ ", %1\n\tv_addc_co_u32 %0, vcc, 0, %0, vcc\n\t"
#pragma unroll
        for (int j = 0; j + 8 <= NR; j += 8)
            asm(TK_CA(2) TK_CA(3) TK_CA(4) TK_CA(5) TK_CA(6) TK_CA(7) TK_CA(8) TK_CA(9) : "+v"(cl) : "v"(cand), "v"(k[j]), "v"(k[j + 1]), "v"(k[j + 2]), "v"(k[j + 3]), "v"(k[j + 4]), "v"(k[j + 5]), "v"(k[j + 6]), "v"(k[j + 7]) : "vcc");
#pragma unroll
        for (int j = NR & ~7; j < NR; ++j) asm("v_cmp_ge_u32 vcc, %1, %2\n\tv_addc_co_u32 %0, vcc, 0, %0, vcc" : "+v"(cl) : "v"(k[j]), "v"(cand) : "vcc");
#undef TK_CA
        int cnt = 0;
#pragma unroll
        for (int bb = 0; bb < 7; ++bb) cnt += __popcll(__ballot((cl >> bb) & 1)) << bb;
        if (cnt >= 256) { T = cand; if (cnt == 256) { exact = true; break; } }
    }
    int base = 0;
#pragma unroll
    for (int j = 0; j < NR; ++j) { const bool f = exact ? (k[j] >= T) : (k[j] > T); const unsigned long long mk = __ballot(f);
        if (f) sel[base + __builtin_amdgcn_mbcnt_hi((unsigned)(mk >> 32), __builtin_amdgcn_mbcnt_lo((unsigned)mk, 0u))] = (unsigned short)(64 * j + lane);
        base += __popcll(mk); }
    if (!exact) {
#pragma unroll
        for (int j = 0; j < NR; ++j) { const bool f = (k[j] == T); const unsigned long long mk = __ballot(f);
            const int p = base + (int)__builtin_amdgcn_mbcnt_hi((unsigned)(mk >> 32), __builtin_amdgcn_mbcnt_lo((unsigned)mk, 0u));
            if (f && p < 256) sel[p] = (unsigned short)(64 * j + lane);
            base += __popcll(mk); }
    }
}
__device__ __forceinline__ int conv_m_of(int q, int j) { return q < 3 ? 2 * q + j : q < 11 ? 6 + 8 * j + (q - 3) : q < 19 ? 22 + 8 * j + (q - 11) : 38 + 8 * j + (q - 19); }
template <bool CONV>
__device__ __forceinline__ void topk_phase_t(const Ctx& C, KArgP P, int j) {
    const float* SC = (const float*)(C.R + R_SC);
    LAS unsigned char* tile0 = C.lds + C.wave * (2 * CONV_TILE); LAS unsigned char* tile1 = tile0 + CONV_TILE;
    constexpr int pcount = CONV ? 27 * (CONV_IB / 2) : 0;
    int cit = C.gw; const int cs = C.ngw; bool pend = false;
    auto pair_desc = [&](int p, ConvD& d0, ConvD& d1) -> bool { const int m = conv_m_of(p / (CONV_IB / 2), j), rp = p % (CONV_IB / 2); const bool isdn = (m >= 4 && m < 6) || m >= 38;
        const int nblk = isdn ? D / 32 : FF / 32, kb2 = rp / nblk, nb = rp - kb2 * nblk, r0 = 2 * kb2 * nblk + nb;
        const bool g = conv_desc(C, P, m, r0, d0); conv_desc(C, P, m, r0 + nblk, d1); return g; };
    auto issue = [&](int lane) { if (CONV && cit < pcount) { ConvD d0, d1; const bool g = pair_desc(cit, d0, d1); conv_dma_issue(d0, g, lane, tile0); conv_dma_issue(d1, g, lane, tile1); pend = true; } };
    auto finish = [&](int lane) { if (CONV && pend) { ConvD d0, d1; pair_desc(cit, d0, d1);
                                      asm volatile("s_waitcnt vmcnt(0)" ::: "memory"); conv_dma_finish(d0, tile0, lane); conv_dma_finish(d1, tile1, lane); cit += cs; pend = false; } };
    for (int rr = C.gw; rr < NT; rr += C.ngw) { const int row = NT - 1 - rr;
        int lane = C.lane; asm volatile("" : "+v"(lane));
        const int pos = row % SL, n = pos + 1;
        unsigned short* sel = C.sel + (size_t)row * 256;
        if (n <= 256) {
            u32x2 o; o.x = (unsigned)(4 * lane) | ((unsigned)(4 * lane + 1) << 16); o.y = (unsigned)(4 * lane + 2) | ((unsigned)(4 * lane + 3) << 16);
            *(u32x2*)(sel + 4 * lane) = o;
            continue;
        }
        const float* sr = SC + (size_t)row * SCLD;
        const int nr8 = (n + 511) >> 9;
#define TOPK_CASE(NR) { unsigned k[NR]; topk_keys<NR>(sr, k, n, lane); _Pragma("unroll") for (int q_ = 0; q_ < NR; ++q_) asm volatile("" : "+v"(k[q_]) :: "memory");   \
            issue(lane); topk_select<NR>(k, sel, lane, [&]() { if (NR >= TOPK_MID_NR) { finish(lane); issue(lane); } }); }
        switch (nr8) {
            case 1: TOPK_CASE(8) break;   case 2: TOPK_CASE(16) break; case 3: TOPK_CASE(24) break;
            case 4: TOPK_CASE(32) break;  case 5: TOPK_CASE(40) break; case 6: TOPK_CASE(48) break;
            case 7: TOPK_CASE(56) break;  case 8: TOPK_CASE(64) break; default: TOPK_CASE(65) break;
        }
#undef TOPK_CASE
        finish(lane);
    }
    while (CONV && cit < pcount) { int lane = C.lane; asm volatile("" : "+v"(lane)); issue(lane); finish(lane); }
}
__device__ __forceinline__ void topk_phase(const Ctx& C, KArgP P, int j) {
    if (CONV_IN_PROLOGUE) topk_phase_t<false>(C, P, j); else topk_phase_t<true>(C, P, j);
}

constexpr int ATT_VROW = 544, ATT_WAVE_LDS = 32 * ATT_VROW + 512;
__device__ __forceinline__ s16x4 tr16(const LAS unsigned char* p) { return __builtin_bit_cast(s16x4, __builtin_amdgcn_ds_read_tr16_b64_v4i16((LAS s16x4*)p)); }
constexpr int AT_PITCH = 1088, AT_BUF = 8 * AT_PITCH;
template <bool OUT8>
__device__ __forceinline__ void attn2b_phase(const Ctx& C, bf16* OUT) {
    const bf16* PROJ = (const bf16*)(C.R + R_PROJ);
    const int lane = C.lane, n15 = lane & 15, kq = lane >> 4, g = n15 >> 2, oo = lane & 1, chh = lane >> 1;
    LAS unsigned char* wb = C.lds + C.wave * ATT_WAVE_LDS;
    LAS unsigned short* selE = (LAS unsigned short*)(wb + 2 * AT_BUF); LAS unsigned short* selO = selE + 128;
    static_assert(2 * AT_BUF + 512 <= ATT_WAVE_LDS, "attention LDS");
    int b0, nbat, wv, nwv;
    if ((C.G & 7) == 0) { b0 = (C.bid & 7) >> 1; nbat = 1; wv = ((C.bid >> 3) * 2 + (C.bid & 1)) * NWAVES + C.wave; nwv = (C.G >> 2) * NWAVES; }
    else { b0 = 0; nbat = BATCH; wv = C.gw; nwv = C.ngw; }
    for (int bi = 0; bi < nbat; ++bi) { const int b = b0 + bi;
    for (int pos = wv; pos < SL; pos += nwv) {
        const int row = b * SL + pos, nk = pos + 1 < 256 ? pos + 1 : 256, ng = (nk + 15) >> 4, ntile = 2 * ng;
        const bf16* kvb = PROJ + (size_t)b * SL * DSA_NP;
        { const u32x2 sv = *(const u32x2*)(C.sel + (size_t)row * 256 + 4 * lane);
          const unsigned s0 = (4 * lane < nk) ? (sv.x & 0xffffu) : 0u, s1 = (4 * lane + 1 < nk) ? (sv.x >> 16) : 0u, s2 = (4 * lane + 2 < nk) ? (sv.y & 0xffffu) : 0u, s3 = (4 * lane + 3 < nk) ? (sv.y >> 16) : 0u;
          asm volatile("" ::: "memory");
          selE[2 * lane] = (unsigned short)s0; selE[2 * lane + 1] = (unsigned short)s2; selO[2 * lane] = (unsigned short)s1; selO[2 * lane + 1] = (unsigned short)s3; }
        bf16x8 qf[8];
        { const bf16* qp = PROJ + (size_t)row * DSA_NP + DQ0 + n15 * 64 + 8 * kq; const bf16x8 q0 = *(const bf16x8*)qp, q1 = *(const bf16x8*)(qp + 32);
          const bf16x8 z = (bf16x8){0, 0, 0, 0, 0, 0, 0, 0};
#pragma unroll
          for (int ks = 0; ks < 8; ++ks) qf[ks] = ((ks >> 1) == g) ? ((ks & 1) ? q1 : q0) : z; }
        asm volatile("s_waitcnt vmcnt(0) lgkmcnt(0)" ::: "memory");
#pragma unroll
        for (int ks = 0; ks < 8; ++ks) asm volatile("" : "+v"(qf[ks]));
#define AT_ISSUE(i_, bo_) do { const int ii_ = (i_); const int gi_ = ii_ < ng ? ii_ : ii_ - ng; const int c0_ = ii_ < ng ? DK0 : DV0; \
            const u32x4 k8_ = *(const LAS u32x4*)((oo ? selO : selE) + 8 * gi_); const bf16* gb_ = kvb + c0_ + chh * 8; LAS unsigned char* db_ = wb + (bo_); \
            __builtin_amdgcn_global_load_lds((const unsigned*)(gb_ + (size_t)(k8_.x & 0xffffu) * DSA_NP), (LAS unsigned*)(db_ + 0 * AT_PITCH), 16, 0, 0); \
            __builtin_amdgcn_global_load_lds((const unsigned*)(gb_ + (size_t)(k8_.x >> 16) * DSA_NP), (LAS unsigned*)(db_ + 1 * AT_PITCH), 16, 0, 0); \
            __builtin_amdgcn_global_load_lds((const unsigned*)(gb_ + (size_t)(k8_.y & 0xffffu) * DSA_NP), (LAS unsigned*)(db_ + 2 * AT_PITCH), 16, 0, 0); \
            __builtin_amdgcn_global_load_lds((const unsigned*)(gb_ + (size_t)(k8_.y >> 16) * DSA_NP), (LAS unsigned*)(db_ + 3 * AT_PITCH), 16, 0, 0); \
            __builtin_amdgcn_global_load_lds((const unsigned*)(gb_ + (size_t)(k8_.z & 0xffffu) * DSA_NP), (LAS unsigned*)(db_ + 4 * AT_PITCH), 16, 0, 0); \
            __builtin_amdgcn_global_load_lds((const unsigned*)(gb_ + (size_t)(k8_.z >> 16) * DSA_NP), (LAS unsigned*)(db_ + 5 * AT_PITCH), 16, 0, 0); \
            __builtin_amdgcn_global_load_lds((const unsigned*)(gb_ + (size_t)(k8_.w & 0xffffu) * DSA_NP), (LAS unsigned*)(db_ + 6 * AT_PITCH), 16, 0, 0); \
            __builtin_amdgcn_global_load_lds((const unsigned*)(gb_ + (size_t)(k8_.w >> 16) * DSA_NP), (LAS unsigned*)(db_ + 7 * AT_PITCH), 16, 0, 0); } while (0)
#define AT_WAIT(i_) do { if ((i_) + 1 < ntile) asm volatile("s_waitcnt vmcnt(8)" ::: "memory"); else asm volatile("s_waitcnt vmcnt(0)" ::: "memory"); } while (0)
        AT_ISSUE(0, 0); AT_ISSUE(1, AT_BUF);
        f32x4 lg[16];
        const LAS unsigned char* kfp = wb + (n15 >> 1) * AT_PITCH + 32 * kq + 16 * (n15 & 1);
#pragma unroll
        for (int G = 0; G < 16; ++G) {
            f32x4 acc = (f32x4){0.f, 0.f, 0.f, 0.f};
            if (G < ng) {
                AT_WAIT(G);
                bf16x8 af[8];
#pragma unroll
                for (int ks = 0; ks < 8; ++ks) af[ks] = *(const LAS bf16x8*)(kfp + (G & 1) * AT_BUF + 128 * ks);
                asm volatile("s_waitcnt lgkmcnt(0)" ::: "memory");
                if (G + 2 < ntile) AT_ISSUE(G + 2, (G & 1) * AT_BUF);
#pragma unroll
                for (int ks = 0; ks < 8; ++ks) acc = MFMA16(af[ks], qf[ks], acc);
            }
#pragma unroll
            for (int i = 0; i < 4; ++i) lg[G][i] = (16 * G + 4 * kq + i < nk) ? acc[i] : -INFINITY;
        }
        float mx = -INFINITY;
#pragma unroll
        for (int G = 0; G < 16; ++G) mx = fmaxf(fmaxf(fmaxf(lg[G][0], lg[G][1]), fmaxf(lg[G][2], lg[G][3])), mx);
        mx = fmaxf(mx, __shfl_xor(mx, 16)); mx = fmaxf(mx, __shfl_xor(mx, 32));
        float sum = 0.f;
#pragma unroll
        for (int G = 0; G < 16; ++G)
#pragma unroll
            for (int i = 0; i < 4; ++i) { const float p = __expf(lg[G][i] - mx); lg[G][i] = p; sum += p; }
        sum += __shfl_xor(sum, 16); sum += __shfl_xor(sum, 32);
        f32x4 O[16];
#pragma unroll
        for (int nb = 0; nb < 16; ++nb) O[nb] = (f32x4){0.f, 0.f, 0.f, 0.f};
        const int vr = 4 * kq + (n15 >> 2);
        const LAS unsigned char* vfp = wb + (vr >> 1) * AT_PITCH + 16 * (vr & 1) + 32 * ((lane & 3) >> 1) + 8 * (lane & 1);
#pragma unroll
        for (int G = 0; G < 16; ++G) {
            if (G < ng) {
                const int ti = ng + G, bo = (ti & 1) * AT_BUF;
                AT_WAIT(ti);
                u32x2 pw; pw.x = pk2(lg[G][0], lg[G][1]); pw.y = pk2(lg[G][2], lg[G][3]);
                const s16x4 pa = __builtin_bit_cast(s16x4, pw);
                s16x4 vf[16];
#pragma unroll
                for (int nb = 0; nb < 16; ++nb) vf[nb] = tr16(vfp + bo + 64 * nb);
                asm volatile("s_waitcnt lgkmcnt(0)" ::: "memory");
                if (ti + 2 < ntile) AT_ISSUE(ti + 2, bo);
#pragma unroll
                for (int nb = 0; nb < 16; ++nb) O[nb] = __builtin_amdgcn_mfma_f32_16x16x16bf16_1k(pa, vf[nb], O[nb], 0, 0, 0);
            }
        }
#undef AT_ISSUE
#undef AT_WAIT
        bf16* orow = OUT + (size_t)row * D; unsigned char* orow8 = (unsigned char*)OUT + (size_t)row * D;
        float inv[4];
#pragma unroll
        for (int i = 0; i < 4; ++i) inv[i] = 1.0f / __shfl(sum, 4 * kq + i);
#pragma unroll
        for (int x = 0; x < 4; ++x) {
            const f32x4 o = (kq == 0) ? O[x] : (kq == 1) ? O[4 + x] : (kq == 2) ? O[8 + x] : O[12 + x];
#pragma unroll
            for (int i = 0; i < 4; ++i) { if (OUT8) orow8[(4 * kq + i) * 64 + 16 * x + n15] = (unsigned char)(pg8::cvt4_fp8(o[i] * inv[i] * SA_ATT, 0.f, 0.f, 0.f) & 0xffu);
                                          else orow[(4 * kq + i) * 64 + 16 * x + n15] = (bf16)(pk2(o[i] * inv[i], 0.f) & 0xffffu); }
        }
    } }
}
__device__ __forceinline__ int ml_start(int c) { return c == 0 ? 0 : 16 + 256 * (c - 1); }
__device__ __forceinline__ int ml_len(int c) { return c == 0 ? 16 : 256; }
template <bool ISMAX> __device__ __forceinline__ float wave_scan_incl(float v, int lane) {
#pragma unroll
    for (int d = 1; d < 64; d <<= 1) { const float t = __shfl_up(v, d); if (lane >= d) v = ISMAX ? fmaxf(v, t) : v + t; }
    return v; }
__device__ __forceinline__ void ml_scan_phase(const Ctx& C) {
    if (C.gw >= 16) return;
    const int bh = C.gw, lane = C.lane, p0 = 65 * lane;
    float* F = C.mlf + bh * SL; float* Cc = C.mlc + bh * SL; float* Pp = C.mlp + bh * SL;
    float li[65], lf[65];
#pragma unroll
    for (int i = 0; i < 65; ++i) { const bool ok = p0 + i < SL; li[i] = ok ? C.mli[(bh * 65 + i) * 64 + lane] : -INFINITY; lf[i] = ok ? C.mlg[(bh * 65 + i) * 64 + lane] : 0.f; }
    float s = 0.f;
#pragma unroll
    for (int i = 0; i < 65; ++i) s += lf[i];
    float run = wave_scan_incl<false>(s, lane) - s, mx = -INFINITY;
#pragma unroll
    for (int i = 0; i < 65; ++i) { run += lf[i]; lf[i] = run; li[i] = li[i] - run; mx = fmaxf(mx, li[i]); }
    const float inc = wave_scan_incl<true>(mx, lane); float pm = __shfl_up(inc, 1); if (lane == 0) pm = -INFINITY;
    LAS float* T = (LAS float*)(C.lds + C.wave * 16640);
#define ML_SCAN_OUT(dst_) do { asm volatile("s_waitcnt lgkmcnt(0)" ::: "memory"); \
        _Pragma("unroll") for (int t = 0; t < 65; ++t) { const float x_ = T[64 * t + lane]; if (64 * t + lane < SL) (dst_)[64 * t + lane] = x_; } \
        asm volatile("s_waitcnt lgkmcnt(0)" ::: "memory"); } while (0)
#pragma unroll
    for (int i = 0; i < 65; ++i) T[p0 + i] = lf[i];
    ML_SCAN_OUT(F);
#pragma unroll
    for (int i = 0; i < 65; ++i) T[p0 + i] = li[i];
    ML_SCAN_OUT(Cc);
#pragma unroll
    for (int i = 0; i < 65; ++i) { pm = fmaxf(pm, li[i]); T[p0 + i] = pm; }
    ML_SCAN_OUT(Pp);
#undef ML_SCAN_OUT
}
constexpr int TP = 40;
__device__ __forceinline__ void stage_T(const Ctx& C, LAS bf16* T, const bf16* src, int ld, int ncol, int row0tok, int s0, int nvalid, const float* cvals, float pend, float kscale) {
    const int nchunk = 32 * (ncol / 8);
    for (int id = C.tid; id < nchunk; id += NTHREADS) {
        const int s = id & 31, dc = id >> 5; const int sl_ = s0 + s; const bool ok = sl_ < nvalid; const int sc = ok ? sl_ : nvalid - 1;
        float x[8]; unpack8(*(const u32x4*)(src + (size_t)(row0tok + sc) * ld + 8 * dc), x);
        float w = ok ? 1.0f : 0.0f; if (cvals) w = ok ? __expf(cvals[sc] - pend) * kscale : 0.0f;
#pragma unroll
        for (int e = 0; e < 8; ++e) T[(8 * dc + e) * TP + s] = (bf16)(pk2(x[e] * w, 0.f) & 0xffffu);
    }
}
__device__ __forceinline__ void ml_dc_phase(const Ctx& C) {
    const bf16* PROJ = (const bf16*)(C.R + R_PROJ); float* DC = (float*)(C.R + R_DC);
    LAS bf16* KT = (LAS bf16*)C.lds; LAS bf16* VT = KT + 128 * TP;
    const int lane = C.lane, m31 = lane & 31, hi = lane >> 5, w = C.wave;
    for (int task = C.bid; task < 256; task += C.G) {
        const int bh = task >> 4, c = task & 15, b = bh >> 2, h = bh & 3, start = ml_start(c), n = ml_len(c), tok0 = b * SL + start;
        const float pend = C.mlp[bh * SL + start + n - 1];
        f32x16 acc[4];
#pragma unroll
        for (int nb = 0; nb < 4; ++nb)
#pragma unroll
            for (int r = 0; r < 16; ++r) acc[nb][r] = 0.f;
        float dn = 0.f;
        for (int s0 = 0; s0 < n; s0 += 32) {
            stage_T(C, KT, PROJ + MK0 + h * 128, ML_NP, 128, tok0, s0, n, C.mlc + bh * SL + start, pend, 0.08838834764831845f);
            stage_T(C, VT, PROJ + MV0 + h * 256, ML_NP, 256, tok0, s0, n, nullptr, 0.f, 1.f);
            __syncthreads();
#pragma unroll
            for (int ks = 0; ks < 2; ++ks) { const bf16x8 a = *(const LAS bf16x8*)(VT + (32 * w + m31) * TP + 16 * ks + 8 * hi);
#pragma unroll
                for (int nb = 0; nb < 4; ++nb) acc[nb] = MFMA32(a, *(const LAS bf16x8*)(KT + (32 * nb + m31) * TP + 16 * ks + 8 * hi), acc[nb]); }
            if (C.tid < 128) {
#pragma unroll
                for (int q = 0; q < 4; ++q) { float x[8]; unpack8(*(const LAS u32x4*)(KT + C.tid * TP + 8 * q), x);
#pragma unroll
                    for (int e = 0; e < 8; ++e) dn += x[e]; } }
            __syncthreads();
        }
        float* dc = DC + (size_t)(bh * 16 + c) * 256 * 128;
#pragma unroll
        for (int nb = 0; nb < 4; ++nb)
#pragma unroll
            for (int r = 0; r < 16; ++r) dc[(size_t)(32 * w + crow(r, hi)) * 128 + 32 * nb + m31] = acc[nb][r];
        if (C.tid < 128) C.dn[(bh * 16 + c) * 128 + C.tid] = dn;
    }
}
__device__ __forceinline__ void ml_state_phase(const Ctx& C) {
    const float* DC = (const float*)(C.R + R_DC); bf16* CH = (bf16*)(C.R + R_CH);
    const int gt = C.bid * NTHREADS + C.tid, ngt = C.G * NTHREADS;
    for (int i = gt; i < 16 * 8192 + 16 * 128; i += ngt) {
        const bool isn = i >= 16 * 8192; const int ii = isn ? i - 16 * 8192 : i; const int bh = isn ? ii >> 7 : ii >> 13, off = isn ? (ii & 127) : 4 * (ii & 8191);
        f32x4 dcv[16]; float pe[16];
#pragma unroll
        for (int c = 0; c < 16; ++c) { pe[c] = C.mlp[bh * SL + ml_start(c) + ml_len(c) - 1];
            if (isn) { dcv[c] = (f32x4){C.dn[(bh * 16 + c) * 128 + off], 0.f, 0.f, 0.f}; } else dcv[c] = *(const f32x4*)(DC + (size_t)(bh * 16 + c) * 32768 + off); }
        f32x4 st = (f32x4){0.f, 0.f, 0.f, 0.f}; float pprev = 0.f;
#pragma unroll
        for (int c = 0; c < 16; ++c) {
            const float pend = pe[c];
            const float decay = (c == 0) ? 0.f : __expf(pprev - pend); pprev = pend;
            st = decay * st + dcv[c];
            if (isn) C.nh[(bh * 16 + c) * 128 + off] = st[0];
            else { u32x2 o; o.x = pk2(st[0], st[1]); o.y = pk2(st[2], st[3]); *(u32x2*)(CH + (size_t)(bh * 16 + c) * 32768 + off) = o; }
        }
    }
}
constexpr int MLP_ = 136;
__device__ __forceinline__ void ml_out_phase(const Ctx& C, const float* gout) {
    const bf16* PROJ = (const bf16*)(C.R + R_PROJ); const bf16* CH = (const bf16*)(C.R + R_CH);
    LAS bf16* VT = (LAS bf16*)C.lds; LAS bf16* KL = VT + 256 * TP; LAS float* CV = (LAS float*)(KL + 32 * MLP_); LAS bf16* CHL = (LAS bf16*)(CV + 32);
    const int w = C.wave;
    for (int task = C.bid; task < 272; task += C.G) {
        int lane = C.lane, tid = C.tid; asm volatile("" : "+v"(lane), "+v"(tid));
        const int m31 = lane & 31, hi = lane >> 5;
        const int bh = task < 256 ? task >> 4 : task - 256, c = task < 256 ? 1 + (task & 15) : 0;
        const int b = bh >> 2, h = bh & 3, start = ml_start(c), n = ml_len(c), tok0 = b * SL + start;
        const int tl = 32 * w + m31, tlc = tl < n ? tl : n - 1; const bool wact = 32 * w < n;
        const float Pt = C.mlp[bh * SL + start + tlc];
        const bf16* qp = PROJ + (size_t)(tok0 + tlc) * ML_NP + MQ0 + h * 128 + 8 * hi;
        const int nst = (n + 31) >> 5;
        const int vs = tid & 31, vd0 = tid >> 5, ks_ = tid >> 4, kc_ = tid & 15;
        u32x4 rv0, rv1, rk; float rc = 0.f;
#define ML_LOAD(st_) do { const int s0_ = 32 * (st_); const int a_ = s0_ + vs < n ? s0_ + vs : n - 1, k_ = s0_ + ks_ < n ? s0_ + ks_ : n - 1; \
            const bf16* vp_ = PROJ + (size_t)(tok0 + a_) * ML_NP + MV0 + h * 256 + 8 * vd0; rv0 = *(const u32x4*)vp_; rv1 = *(const u32x4*)(vp_ + 128); \
            rk = *(const u32x4*)(PROJ + (size_t)(tok0 + k_) * ML_NP + MK0 + h * 128 + 8 * kc_); \
            if (tid < 32) rc = C.mlc[bh * SL + start + (s0_ + tid < n ? s0_ + tid : n - 1)]; } while (0)
#define ML_WRITE(st_) do { const int s0_ = 32 * (st_); const bool ok_ = s0_ + vs < n; float x_[8]; unpack8(rv0, x_); \
            _Pragma("unroll") for (int e = 0; e < 8; ++e) VT[(8 * vd0 + e) * TP + vs] = ok_ ? (bf16)(pk2(x_[e], 0.f) & 0xffffu) : (bf16)0; \
            unpack8(rv1, x_); _Pragma("unroll") for (int e = 0; e < 8; ++e) VT[(8 * (vd0 + 16) + e) * TP + vs] = ok_ ? (bf16)(pk2(x_[e], 0.f) & 0xffffu) : (bf16)0; \
            *(LAS u32x4*)(KL + ks_ * MLP_ + 8 * kc_) = rk; if (tid < 32) CV[tid] = rc; } while (0)
        float den = 0.f;
        f32x16 acc[8];
#pragma unroll
        for (int mb = 0; mb < 8; ++mb)
#pragma unroll
            for (int r = 0; r < 16; ++r) acc[mb][r] = 0.f;
        if (c >= 1) {
            const bf16* ch = CH + (size_t)(bh * 16 + c - 1) * 32768; LAS bf16* CHs = (LAS bf16*)C.lds;
            u32x4 cr[8];
#pragma unroll
            for (int i = 0; i < 8; ++i) { const int id = tid + 512 * i; cr[i] = *(const u32x4*)(ch + (size_t)(id >> 4) * 128 + 8 * (id & 15)); }
#pragma unroll
            for (int i = 0; i < 8; ++i) { const int id = tid + 512 * i; *(LAS u32x4*)(CHs + (id >> 4) * 136 + 8 * (id & 15)) = cr[i]; }
            __syncthreads();
        }
        if (c >= 1 && wact) {
            const LAS bf16* CHs = (const LAS bf16*)C.lds;
            bf16x8 qf[8];
#pragma unroll
            for (int ks = 0; ks < 8; ++ks) qf[ks] = *(const bf16x8*)(qp + 16 * ks);
#pragma unroll
            for (int mb = 0; mb < 8; ++mb)
#pragma unroll
                for (int ks = 0; ks < 8; ++ks) acc[mb] = MFMA32(*(const LAS bf16x8*)(CHs + (32 * mb + m31) * 136 + 16 * ks + 8 * hi), qf[ks], acc[mb]);
            const float sc = __expf(C.mlp[bh * SL + start - 1] - Pt);
#pragma unroll
            for (int mb = 0; mb < 8; ++mb)
#pragma unroll
                for (int r = 0; r < 16; ++r) acc[mb][r] *= sc;
            const float* nh = C.nh + (bh * 16 + c - 1) * 128 + 8 * hi; float d = 0.f;
#pragma unroll
            for (int ks = 0; ks < 8; ++ks) { const f32x4 n0 = *(const f32x4*)(nh + 16 * ks), n1 = *(const f32x4*)(nh + 16 * ks + 4); float q[8]; unpack8(__builtin_bit_cast(u32x4, qf[ks]), q);
                d += (n0[0] * q[0] + n0[1] * q[1]) + (n0[2] * q[2] + n0[3] * q[3]) + (n1[0] * q[4] + n1[1] * q[5]) + (n1[2] * q[6] + n1[3] * q[7]); }
            d += __shfl_xor(d, 32); den = sc * d;
        }
        if (c >= 1) __syncthreads();
        float den_in = 0.f;
        ML_LOAD(0);
        for (int st = 0; st < nst; ++st) {
            ML_WRITE(st);
            __syncthreads();
            const bool act = st <= w && wact;
            if (!act && st + 1 < nst) ML_LOAD(st + 1);
            if (act) {
                f32x16 X;
#pragma unroll
                for (int r = 0; r < 16; ++r) X[r] = 0.f;
                bf16x8 qf[8];
#pragma unroll
                for (int ks = 0; ks < 8; ++ks) qf[ks] = *(const bf16x8*)(qp + 16 * ks);
#pragma unroll
                for (int ks = 0; ks < 8; ++ks) X = MFMA32(*(const LAS bf16x8*)(KL + m31 * MLP_ + 16 * ks + 8 * hi), qf[ks], X);
                asm volatile("" ::: "memory");
                if (st + 1 < nst) ML_LOAD(st + 1);
                float Wt[16];
#pragma unroll
                for (int q4 = 0; q4 < 4; ++q4) { const int sb = 32 * st + 8 * q4 + 4 * hi;
                    const f32x4 cv = *(const LAS f32x4*)(CV + 8 * q4 + 4 * hi);
#pragma unroll
                    for (int e = 0; e < 4; ++e) { const int sl_ = sb + e; const bool ok = sl_ < n && sl_ <= tl;
                        const float wgt = ok ? X[4 * q4 + e] * 0.08838834764831845f * __expf(cv[e] - Pt) : 0.f; Wt[4 * q4 + e] = wgt; den_in += wgt; } }
#pragma unroll
                for (int s2 = 0; s2 < 2; ++s2) {
                    u32x4 pw; pw.x = pk2(Wt[8 * s2], Wt[8 * s2 + 1]); pw.y = pk2(Wt[8 * s2 + 2], Wt[8 * s2 + 3]); pw.z = pk2(Wt[8 * s2 + 4], Wt[8 * s2 + 5]); pw.w = pk2(Wt[8 * s2 + 6], Wt[8 * s2 + 7]);
                    const bf16x8 wf = __builtin_bit_cast(bf16x8, pw);
#pragma unroll
                    for (int mb = 0; mb < 8; ++mb) { const LAS bf16* vp = VT + (32 * mb + m31) * TP + 16 * s2 + 4 * hi;
                        const u32x2 lo = *(const LAS u32x2*)vp, hi2 = *(const LAS u32x2*)(vp + 8);
                        const u32x4 av = (u32x4){lo.x, lo.y, hi2.x, hi2.y};
                        acc[mb] = MFMA32(__builtin_bit_cast(bf16x8, av), wf, acc[mb]); }
                }
            }
            __syncthreads();
        }
#undef ML_LOAD
#undef ML_WRITE
        if (wact) {
            den += den_in + __shfl_xor(den_in, 32);
            const float Ft = C.mlf[bh * SL + start + tlc];
            const float dnm = fmaxf(fabsf(den), __expf(-(Ft + Pt))), invd = 1.0f / dnm;
            float ss = 0.f;
#pragma unroll
            for (int mb = 0; mb < 8; ++mb)
#pragma unroll
                for (int r = 0; r < 16; ++r) { const float hv = acc[mb][r] * invd; acc[mb][r] = hv; ss += hv * hv; }
            ss += __shfl_xor(ss, 32);
            const float rstd = 1.0f / sqrtf(ss * (1.0f / 256.0f) + RMS_EPS);
            LAS bf16* Yt = (LAS bf16*)(C.lds + w * 16896);
#pragma unroll
            for (int mb = 0; mb < 8; ++mb)
#pragma unroll
                for (int q4 = 0; q4 < 4; ++q4) { const int dv0 = 32 * mb + 8 * q4 + 4 * hi;
                    u32x2 o; o.x = pk2(acc[mb][4 * q4] * rstd, acc[mb][4 * q4 + 1] * rstd); o.y = pk2(acc[mb][4 * q4 + 2] * rstd, acc[mb][4 * q4 + 3] * rstd);
                    *(LAS u32x2*)(Yt + m31 * 264 + dv0) = o; }
            asm volatile("s_waitcnt lgkmcnt(0)" ::: "memory");
            const f32x4 gg = *(const f32x4*)(gout + h * 256 + 4 * lane);
            const int nrow = n - 32 * w < 32 ? n - 32 * w : 32;
            const bf16* obase = PROJ + (size_t)(tok0 + 32 * w) * ML_NP + MO0 + h * 256 + 4 * lane; bf16* ybase = C.XN + (size_t)(tok0 + 32 * w) * D + h * 256 + 4 * lane;
#pragma unroll
            for (int r0 = 0; r0 < 32; r0 += 8) {
                if (r0 >= nrow) break;
                u32x2 ow[8], yv[8];
#pragma unroll
                for (int q = 0; q < 8; ++q) { const int rr = r0 + q < nrow ? r0 + q : nrow - 1; ow[q] = *(const u32x2*)(obase + (size_t)rr * ML_NP); yv[q] = *(const LAS u32x2*)(Yt + (r0 + q) * 264 + 4 * lane); }
#pragma unroll
                for (int q = 0; q < 8; ++q) {
                    const float y0 = bflo(yv[q].x) * gg[0] / (1.0f + __expf(-bflo(ow[q].x))), y1 = bfhi(yv[q].x) * gg[1] / (1.0f + __expf(-bfhi(ow[q].x)));
                    const float y2 = bflo(yv[q].y) * gg[2] / (1.0f + __expf(-bflo(ow[q].y))), y3 = bfhi(yv[q].y) * gg[3] / (1.0f + __expf(-bfhi(ow[q].y)));
                    u32x2 o; o.x = pk2(y0, y1); o.y = pk2(y2, y3); if (r0 + q < nrow) *(u32x2*)(ybase + (size_t)(r0 + q) * D) = o; }
            }
        }
        __syncthreads();
    }
}

__device__ __forceinline__ void moe_bases(const Ctx& C, int layer, int (&pb)[9]) {
    pb[0] = 0;
#pragma unroll
    for (int e = 0; e < 8; ++e) { const int ne = (int)__hip_atomic_load(C.ctl + CW_CNT + (layer * 8 + e) * 64, __ATOMIC_RELAXED, __HIP_MEMORY_SCOPE_AGENT); pb[e + 1] = pb[e] + ((ne + 255) >> 8); }
}
__device__ __forceinline__ void moe_gather_phase(const Ctx& C, int layer) {
    bf16* AS = (bf16*)(C.R + R_AS);
    LAS int* lb = (LAS int*)C.lds;
    if (C.tid == 0) { int pb[9]; moe_bases(C, layer, pb);
#pragma unroll
        for (int e = 0; e < 8; ++e) { lb[e] = pb[e] * 256; lb[8 + e] = (int)__hip_atomic_load(C.ctl + CW_CNT + (layer * 8 + e) * 64, __ATOMIC_RELAXED, __HIP_MEMORY_SCOPE_AGENT); } }
    __syncthreads();
    for (int row = C.gw; row < NT; row += C.ngw) {
        const int ee = C.route_e[row]; const float g1 = C.route_g1[row];
        u32x4 x0, x1 = (u32x4){0u, 0u, 0u, 0u};
        if (FP8_MOE) x0 = *(const u32x4*)(C.xn8 + (size_t)row * D + 16 * C.lane);
        else { x0 = *(const u32x4*)(C.XN + (size_t)row * D + 8 * C.lane); x1 = *(const u32x4*)(C.XN + (size_t)row * D + 512 + 8 * C.lane); }
#pragma unroll
        for (int wh = 0; wh < 2; ++wh) { const int e = wh ? (ee >> 8) : (ee & 0xff), r = wh ? C.route_r2[row] : C.route_r1[row]; const int slot = lb[e] + r;
            if (FP8_MOE) *(u32x4*)((unsigned char*)AS + (size_t)slot * D + 16 * C.lane) = x0;
            else { *(u32x4*)(AS + (size_t)slot * D + 8 * C.lane) = x0; *(u32x4*)(AS + (size_t)slot * D + 512 + 8 * C.lane) = x1; }
            if (C.lane == 0) { C.slot_tok[slot] = row | (wh << 16); C.slot_g[slot] = wh ? 1.0f - g1 : g1; } }
    }
    u32x4 zero4 = (u32x4){0u, 0u, 0u, 0u}; asm volatile("" : "+v"(zero4));
    for (int e = 0; e < 8; ++e) { const int ne = lb[8 + e], first = lb[e] + ne, last = lb[e] + ((ne + 255) & ~255);
        for (int slot = first + C.gw; slot < last; slot += C.ngw) {
            if (FP8_MOE) *(u32x4*)((unsigned char*)AS + (size_t)slot * D + 16 * C.lane) = zero4;
            else { *(u32x4*)(AS + (size_t)slot * D + 8 * C.lane) = zero4; *(u32x4*)(AS + (size_t)slot * D + 512 + 8 * C.lane) = zero4; }
            if (C.lane == 0) { C.slot_tok[slot] = -1; C.slot_g[slot] = 0.f; } } }
    __syncthreads();
}
__device__ __forceinline__ void final_phase(const Ctx& C, float* out) {
    const bf16* Y0 = (const bf16*)(C.R + R_Y0); const bf16* Y1 = (const bf16*)(C.R + R_Y1);
    const int gt = C.bid * NTHREADS + C.tid, ngt = C.G * NTHREADS;
    for (int i = gt; i < BATCH * SEQ * (D / 4); i += ngt) { const int orow = i >> 8, c4 = i & 255, b = orow >> 12, s = orow & 4095; const size_t row = (size_t)b * SL + NMETA + s;
#if H_BF16
        f32x4 v; { const u32x2 hq = *(const u32x2*)(C.H + row * D + 4 * c4); v[0] = bflo(hq.x); v[1] = bfhi(hq.x); v[2] = bflo(hq.y); v[3] = bfhi(hq.y); }
#else
        f32x4 v = *(const f32x4*)(C.H + row * D + 4 * c4);
#endif
        const u32x2 a = *(const u32x2*)(Y0 + row * D + 4 * c4), bb = *(const u32x2*)(Y1 + row * D + 4 * c4);
        v[0] += bflo(a.x) + bflo(bb.x); v[1] += bfhi(a.x) + bfhi(bb.x); v[2] += bflo(a.y) + bflo(bb.y); v[3] += bfhi(a.y) + bfhi(bb.y);
        *(f32x4*)(out + (size_t)orow * D + 4 * c4) = v; }
}
template <int MODE, int KSW  , bool FP8 = false>
__device__ __forceinline__ void skinny_phase(const Ctx& C, const bf16* A16, const bf16* Bt, int N, int K, bf16* O, int ldo, HT* H, float sa = 1.0f, float so = 1.0f) {
    const int lane = C.lane, n15 = lane & 15, kq = lane >> 4, w = C.wave;
    LAS f32x4* red = (LAS f32x4*)C.lds;
    const int nblk = (MODE == 2) ? N / 32 : N / 16;
    for (int cb = C.bid; cb < nblk; cb += C.G) {
        int rowB0 = 16 * cb, rowB1 = 0;
        if (MODE == 2) { const int c0 = 16 * cb; rowB0 = 256 * (c0 >> 7) + (c0 & 127); rowB1 = rowB0 + 128; }
        f32x4 acc0 = (f32x4){0.f, 0.f, 0.f, 0.f}, acc1 = (f32x4){0.f, 0.f, 0.f, 0.f};
        const bf16* ap = A16 + (size_t)n15 * K + 8 * kq; const bf16* bp0 = Bt + (size_t)(rowB0 + n15) * K + 8 * kq; const bf16* bp1 = Bt + (size_t)(rowB1 + n15) * K + 8 * kq;
        if constexpr (FP8) {
            const unsigned char* ap8 = (const unsigned char*)A16 + (size_t)n15 * K + 8 * kq; const unsigned char* bq0 = (const unsigned char*)Bt + (size_t)(rowB0 + n15) * K + 8 * kq; const unsigned char* bq1 = (const unsigned char*)Bt + (size_t)(rowB1 + n15) * K + 8 * kq;
            long af[KSW], b0f[KSW], b1f[MODE == 2 ? KSW : 1];
#pragma unroll
            for (int i = 0; i < KSW; ++i) { const int ks = w + NWAVES * i; af[i] = *(const long*)(ap8 + 32 * ks); b0f[i] = *(const long*)(bq0 + 32 * ks); if (MODE == 2) b1f[i] = *(const long*)(bq1 + 32 * ks); }
#pragma unroll
            for (int i = 0; i < KSW; ++i) { acc0 = __builtin_amdgcn_mfma_f32_16x16x32_fp8_fp8(af[i], b0f[i], acc0, 0, 0, 0); if (MODE == 2) acc1 = __builtin_amdgcn_mfma_f32_16x16x32_fp8_fp8(af[i], b1f[i], acc1, 0, 0, 0); }
        } else {
            bf16x8 af[KSW], b0f[KSW], b1f[MODE == 2 ? KSW : 1];
#pragma unroll
            for (int i = 0; i < KSW; ++i) { const int ks = w + NWAVES * i; af[i] = *(const bf16x8*)(ap + 32 * ks); b0f[i] = *(const bf16x8*)(bp0 + 32 * ks); if (MODE == 2) b1f[i] = *(const bf16x8*)(bp1 + 32 * ks); }
#pragma unroll
            for (int i = 0; i < KSW; ++i) { acc0 = MFMA16(af[i], b0f[i], acc0); if (MODE == 2) acc1 = MFMA16(af[i], b1f[i], acc1); }
        }
        red[w * 64 + lane] = acc0; if (MODE == 2) red[512 + w * 64 + lane] = acc1;
        __syncthreads();
        if (w == 0) {
            f32x4 s0 = red[lane], s1 = (f32x4){0.f, 0.f, 0.f, 0.f};
#pragma unroll
            for (int ww = 1; ww < NWAVES; ++ww) s0 += red[ww * 64 + lane];
            if (MODE == 2) { s1 = red[512 + lane];
#pragma unroll
                for (int ww = 1; ww < NWAVES; ++ww) s1 += red[512 + ww * 64 + lane]; }
            const int col = 16 * cb + n15;
#pragma unroll
            for (int i = 0; i < 4; ++i) { const int m = 4 * kq + i;
                if (MODE == 0) { const bf16 v = (bf16)(pk2(s0[i] * sa, 0.f) & 0xffffu);
#pragma unroll
                    for (int b = 0; b < BATCH; ++b) O[(size_t)(b * SL + m) * ldo + col] = v; }
                if (MODE == 1) {
#pragma unroll
#if H_BF16
                    for (int b = 0; b < BATCH; ++b) { HT* hp = H + (size_t)(b * SL + m) * D + col; *hp = (HT)(pk2(bf2f(*hp) + s0[i] * sa, 0.f) & 0xffffu); } }
#else
                    for (int b = 0; b < BATCH; ++b) H[(size_t)(b * SL + m) * D + col] += s0[i] * sa; }
#endif
                if (MODE == 2) { if (FP8) ((unsigned char*)O)[(size_t)m * ldo + col] = (unsigned char)(pg8::cvt4_fp8(pg8::silu_mul(s0[i] * sa, s1[i] * sa) * so, 0.f, 0.f, 0.f) & 0xffu);
                                 else O[(size_t)m * ldo + col] = (bf16)(pk2(pg8::silu_mul(s0[i], s1[i]), 0.f) & 0xffffu); }
            }
        }
        __syncthreads();
    }
}
typedef const __attribute__((address_space(4))) Params* KArg;
__device__ __forceinline__ KArg karg() { KArg p = (KArg)__builtin_amdgcn_kernarg_segment_ptr(); asm volatile("" : "+s"(p)); return p; }
__device__ __forceinline__ void ctx_init(Ctx& C, KArg P, LAS unsigned char* lds_, int wv0) {
    C.lds = lds_;
    { int t_ = wv0 * 64 + hw_lane(); asm volatile("" : "+v"(t_)); C.tid = t_; } C.lane = C.tid & 63; C.wave = __builtin_amdgcn_readfirstlane(C.tid >> 6); C.G = gridDim.x; C.bid = blockIdx.x;
    C.gw = C.bid * NWAVES + C.wave; C.ngw = C.G * NWAVES;
    unsigned char* ws = P->ws;
    C.ctl = (unsigned*)(ws + WS_CTL);
    C.rope = (float2*)(ws + WS_ROPE); C.sm8 = (float*)(ws + WS_SM8);
    C.route_e = (int*)(ws + WS_ROUTE); C.route_r1 = C.route_e + NT; C.route_r2 = C.route_r1 + NT; C.route_g1 = (float*)(C.route_r2 + NT);
    C.mlf = (float*)(ws + WS_MLG); C.mlc = C.mlf + 16 * SL; C.mlp = C.mlc + 16 * SL; C.mli = (float*)(ws + WS_MLI); C.mlg = C.mli + 16 * 65 * 64;
    C.dn = (float*)(ws + WS_NH); C.nh = C.dn + 16 * 16 * 128;
    C.slot_tok = (int*)(ws + WS_SLOT); C.slot_g = (float*)(C.slot_tok + MOE_ROWS); C.sel = (unsigned short*)(ws + WS_SEL);
    C.wdsa_in = (bf16*)(ws + WS_WDSA_IN); C.wdsa_out = (bf16*)(ws + WS_WDSA_OUT); C.wml_in = (bf16*)(ws + WS_WML_IN); C.wml_out = (bf16*)(ws + WS_WML_OUT);
    C.wffn_gu = (bf16*)(ws + WS_WFFN_GU); C.wffn_dn = (bf16*)(ws + WS_WFFN_DN); C.wmoe_gu = (bf16*)(ws + WS_WMOE_GU); C.wmoe_dn = (bf16*)(ws + WS_WMOE_DN);
    C.H = (HT*)(ws + WS_H); C.XN = (bf16*)(ws + WS_XN); C.R = ws + WS_R; C.xn8 = ws + WS_XN8;
}
constexpr int N_PHASES = 44;
#if H_BF16
typedef pg8::EpiResAddB EpiResAddH;
#else
typedef pg8::EpiResAdd EpiResAddH;
#endif
template <int SITE> __global__ void __launch_bounds__(NTHREADS, 2) fwd(Params Pval) {
    extern __shared__ __attribute__((aligned(16))) unsigned char lds_raw[];
    LAS unsigned char* const lds_base = (LAS unsigned char*)lds_raw;
    unsigned* ctl0; int lo, hi; { KArg P0 = karg(); ctl0 = (unsigned*)(P0->ws + WS_CTL); lo = P0->ph_lo; hi = P0->ph_hi; }
    volatile LAS unsigned* MISC = (volatile LAS unsigned*)(lds_base + MISC_OFF);
    int wv0 = __builtin_amdgcn_readfirstlane((int)threadIdx.x >> 6); asm volatile("" : "+s"(wv0));
    if (threadIdx.x < 64) MISC[threadIdx.x] = 0u;
    __syncthreads();
    XcdBarrier bar; bar.bar = ctl0 + CW_BAR; bar.x = 0; bar.st = MISC + 8;
    if (hi - lo > 1) bar = xcd_barrier_post(ctl0 + CW_BAR, MISC + 8, wv0);
    int ph = 0;
#ifndef SKIP_SITE
#define SKIP_SITE -5
#endif
#ifndef REPEAT_MASK
#define REPEAT_MASK 0u
#endif
#define PH_BEGIN_(id) if ((SITE < 0 || SITE == (id)) && SKIP_SITE != (id) && ph >= lo && ph < hi) { for (int rep = 0; rep < (((REPEAT_MASK >> (id)) & 1u) ? 2 : 1); ++rep) { KArg P = karg(); Ctx C; ctx_init(C, P, lds_base, wv0); HT* Hres = rep ? (HT*)(C.R + 160 * MiB) : C.H; (void)Hres; bf16* PROJ = (bf16*)(C.R + R_PROJ); bf16* ACT = (bf16*)(C.R + R_ACT); bf16* AS = (bf16*)(C.R + R_AS); (void)PROJ; (void)ACT; (void)AS;
#define PH_END } if (ph + 1 < hi) xcd_barrier(bar); } ++ph;
    using namespace pg8;

    PH_BEGIN_(0) prologue_phase(C, P); PH_END

    for (int j = 0; j < 2; ++j) {
        PH_BEGIN_(1)
            const float* gain = P->in[2] + (size_t)(2 * j) * D; const float* w8 = P->in[4] + (size_t)j * D * DSA_LDW + DIW0;
            if (j == 0) norm_phase<0, false, FP8_DSA_IN != 0>(C, gain, w8, DSA_LDW, 0); else norm_phase<0, true, FP8_DSA_IN != 0>(C, gain, w8, DSA_LDW, 0);
        PH_END
        PH_BEGIN_(2) {
#if FP8_DSA_IN
                   const bf16* w8 = (const bf16*)((const unsigned char*)C.wdsa_in + (size_t)j * DSA_NP * D);
                   Gemm g{(const bf16*)C.xn8, w8, 16384, DSA_NP, D / 2}; StaticOrder S; S.init(16384, DSA_NP, C.G, C.bid, 1); EpiStoreBf16 E{PROJ, DSA_NP, 1.0f / SW_DIN};
                   gemm_phase<EpiStoreBf16, StaticOrder, true, true, true>(C.lds, g, S, E, C.tid); skinny_phase<0, 4, true>(C, (const bf16*)C.xn8, w8, DSA_NP, D, PROJ, DSA_NP, nullptr, 1.0f / SW_DIN);
#else
                   Gemm g{C.XN, C.wdsa_in + (size_t)j * DSA_NP * D, 16384, DSA_NP, D}; StaticOrder S; S.init(16384, DSA_NP, C.G, C.bid, 1); EpiStoreBf16 E{PROJ, DSA_NP, 1.0f};
                   gemm_phase<EpiStoreBf16, StaticOrder, true, true>(C.lds, g, S, E, C.tid); skinny_phase<0, 4>(C, C.XN, C.wdsa_in + (size_t)j * DSA_NP * D, DSA_NP, D, PROJ, DSA_NP, nullptr);
#endif
                   } PH_END
        PH_BEGIN_(3) dsa_post_phase(C, P->in[5] + j * 64, P->in[6] + j * 64); PH_END
        PH_BEGIN_(4) score_phase(C); PH_END
        PH_BEGIN_(5) topk_phase(C, P, j); PH_END
        PH_BEGIN_(6) if (FP8_DSA) attn2b_phase<true>(C, (bf16*)C.xn8); else attn2b_phase<false>(C, C.XN); PH_END
        PH_BEGIN_(7) {
#if FP8_DSA
                   const bf16* w8 = (const bf16*)((const unsigned char*)C.wdsa_out + (size_t)j * D * D);
                   Gemm g{(const bf16*)C.xn8, w8, 16384, D, D / 2}; StaticOrder S; S.init(16384, D, C.G, C.bid, 1); EpiResAddH E{Hres, D, 1.0f / (SW_DOUT * SA_ATT)};
                   gemm_phase<EpiResAddH, StaticOrder, true, true, true>(C.lds, g, S, E, C.tid); skinny_phase<1, 4, true>(C, (const bf16*)C.xn8, w8, D, D, nullptr, 0, Hres, 1.0f / (SW_DOUT * SA_ATT));
#else
                   Gemm g{C.XN, C.wdsa_out + (size_t)j * D * D, 16384, D, D}; StaticOrder S; S.init(16384, D, C.G, C.bid, 1); EpiResAddH E{Hres, D, 1.0f};
                   gemm_phase<EpiResAddH, StaticOrder, true, true>(C.lds, g, S, E, C.tid); skinny_phase<1, 4>(C, C.XN, C.wdsa_out + (size_t)j * D * D, D, D, nullptr, 0, Hres);
#endif
                   } PH_END
        PH_BEGIN_(8) norm_phase<3, false, FP8_DENSE != 0>(C, P->in[3] + (size_t)(2 * j) * D, nullptr, 0, 0); PH_END
        PH_BEGIN_(9) {
#if FP8_DENSE
                   const bf16* w8 = (const bf16*)((const unsigned char*)C.wffn_gu + (size_t)j * GU * D);
                   Gemm g{(const bf16*)C.xn8, w8, 16384, GU, D / 2}; StaticOrder S; S.init(16384, GU, C.G, C.bid, 1); EpiSwiGLU8 E{(unsigned char*)ACT, FF, 1.0f / SW_GU, SA_ACT};
                   gemm_phase<EpiSwiGLU8, StaticOrder, true, true, true>(C.lds, g, S, E, C.tid); skinny_phase<2, 4, true>(C, (const bf16*)C.xn8, w8, GU, D, ACT, FF, nullptr, 1.0f / SW_GU, SA_ACT);
#else
                   Gemm g{C.XN, C.wffn_gu + (size_t)j * GU * D, 16384, GU, D}; StaticOrder S; S.init(16384, GU, C.G, C.bid, 1); EpiSwiGLU E{ACT, FF};
                   gemm_phase<EpiSwiGLU, StaticOrder, true, true>(C.lds, g, S, E, C.tid); skinny_phase<2, 4>(C, C.XN, C.wffn_gu + (size_t)j * GU * D, GU, D, ACT, FF, nullptr);
#endif
                   } PH_END
        PH_BEGIN_(10) {
#if FP8_DENSE
                   const bf16* w8 = (const bf16*)((const unsigned char*)C.wffn_dn + (size_t)j * D * FF);
                   Gemm g{ACT, w8, 16384, D, FF / 2}; StaticOrder S; S.init(16384, D, C.G, C.bid, 1); EpiResAddH E{Hres, D, 1.0f / (SW_DN * SA_ACT)};
                   gemm_phase<EpiResAddH, StaticOrder, true, true, true>(C.lds, g, S, E, C.tid); skinny_phase<1, 14, true>(C, ACT, w8, D, FF, nullptr, 0, Hres, 1.0f / (SW_DN * SA_ACT));
#else
                   Gemm g{ACT, C.wffn_dn + (size_t)j * D * FF, 16384, D, FF}; StaticOrder S; S.init(16384, D, C.G, C.bid, 1); EpiResAddH E{Hres, D, 1.0f};
                   gemm_phase<EpiResAddH, StaticOrder, true, true>(C.lds, g, S, E, C.tid); skinny_phase<1, 14>(C, ACT, C.wffn_dn + (size_t)j * D * FF, D, FF, nullptr, 0, Hres);
#endif
                   } PH_END
        PH_BEGIN_(11) norm_phase<1, false>(C, P->in[2] + (size_t)(2 * j + 1) * D, P->in[8] + (size_t)j * D * ML_LDW + MG0, ML_LDW, 0, P->in[9] + j * 4, P->in[10] + j * 4); PH_END
        PH_BEGIN_(12) { Gemm g{C.XN, C.wml_in + (size_t)j * ML_NP * D, 16384, ML_NP, D}; StaticOrder S; S.init(16384, ML_NP, C.G, C.bid, 1); EpiStoreBf16 E{PROJ, ML_NP, 1.0f};
                   gemm_phase<EpiStoreBf16, StaticOrder, true, true>(C.lds, g, S, E, C.tid); skinny_phase<0, 4>(C, C.XN, C.wml_in + (size_t)j * ML_NP * D, ML_NP, D, PROJ, ML_NP, nullptr); } PH_END
        PH_BEGIN_(13) ml_scan_phase(C); PH_END
        PH_BEGIN_(14) ml_dc_phase(C); PH_END
        PH_BEGIN_(15) ml_state_phase(C); PH_END
        PH_BEGIN_(16) ml_out_phase(C, P->in[11] + (size_t)j * D); PH_END
        PH_BEGIN_(17) { Gemm g{C.XN, C.wml_out + (size_t)j * D * D, 16384, D, D}; StaticOrder S; S.init(16384, D, C.G, C.bid, 1); EpiResAddH E{Hres, D, 1.0f};
                   gemm_phase<EpiResAddH, StaticOrder, true, true>(C.lds, g, S, E, C.tid); skinny_phase<1, 4>(C, C.XN, C.wml_out + (size_t)j * D * D, D, D, nullptr, 0, Hres); } PH_END
        PH_BEGIN_(18) norm_phase<2, false, FP8_MOE != 0>(C, P->in[3] + (size_t)(2 * j + 1) * D, P->in[16] + (size_t)j * D * 8, 8, j); PH_END
        PH_BEGIN_(19) moe_gather_phase(C, j); PH_END
        PH_BEGIN_(20) { int pb[9]; moe_bases(C, j, pb);
                   GroupedOrder S; S.nM = pb[8]; S.nN = GU / 256; S.nwg = S.nM * S.nN; S.G = C.G; S.c = C.bid; S.p1 = pb[1]; S.p2 = pb[2]; S.p3 = pb[3]; S.p4 = pb[4]; S.p5 = pb[5]; S.p6 = pb[6]; S.p7 = pb[7]; S.bmajor = MOE_GU_BMAJOR;
#if FP8_MOE
                   Gemm g{AS, (const bf16*)((const unsigned char*)C.wmoe_gu + (size_t)j * NE * GU * D), pb[8] * 256, GU, D / 2}; S.estride = (size_t)GU * D;
                   EpiSwiGLU8 E{(unsigned char*)ACT, FF, 1.0f / SW_GU, SA_ACT};
                   gemm_phase<EpiSwiGLU8, GroupedOrder, true, true, true>(C.lds, g, S, E, C.tid);
#else
                   Gemm g{AS, C.wmoe_gu + (size_t)j * NE * GU * D, pb[8] * 256, GU, D}; S.estride = (size_t)GU * D * 2;
                   EpiSwiGLU E{ACT, FF};
                   gemm_phase<EpiSwiGLU, GroupedOrder, true, true>(C.lds, g, S, E, C.tid);
#endif
                   } PH_END
        PH_BEGIN_(21) { int pb[9]; moe_bases(C, j, pb);
                   GroupedOrder S; S.nM = pb[8]; S.nN = D / 256; S.nwg = S.nM * S.nN; S.G = C.G; S.c = C.bid; S.p1 = pb[1]; S.p2 = pb[2]; S.p3 = pb[3]; S.p4 = pb[4]; S.p5 = pb[5]; S.p6 = pb[6]; S.p7 = pb[7]; S.bmajor = 0;
#if FP8_MOE
                   Gemm g{ACT, (const bf16*)((const unsigned char*)C.wmoe_dn + (size_t)j * NE * D * FF), pb[8] * 256, D, FF / 2}; S.estride = (size_t)D * FF;
                   EpiMoeDown E{(bf16*)(C.R + R_Y0), (bf16*)(C.R + R_Y1), C.slot_tok, C.slot_g, D, 1.0f / (SW_DN * SA_ACT)};
                   gemm_phase<EpiMoeDown, GroupedOrder, true, true, true>(C.lds, g, S, E, C.tid);
#else
                   Gemm g{ACT, C.wmoe_dn + (size_t)j * NE * D * FF, pb[8] * 256, D, FF}; S.estride = (size_t)D * FF * 2;
                   EpiMoeDown E{(bf16*)(C.R + R_Y0), (bf16*)(C.R + R_Y1), C.slot_tok, C.slot_g, D, 1.0f};
                   gemm_phase<EpiMoeDown, GroupedOrder, true, true>(C.lds, g, S, E, C.tid);
#endif
                   } PH_END
    }
#ifdef PROBE_BAR
    for (int q_ = 0; q_ < PROBE_BAR; ++q_) xcd_barrier(bar);
#endif
    PH_BEGIN_(22) final_phase(C, P->out); PH_END
#undef PH_BEGIN_
#undef PH_END
}

constexpr int NSITES = 24;
template <int S> struct SiteTab { static const void* get(int s) { return s == S ? (const void*)fwd<S> : SiteTab<S - 1>::get(s); } };
template <> struct SiteTab<-1> { static const void* get(int) { return nullptr; } };
#if N_LAUNCH_SPLIT
static const void* site_fn(int s) { return s >= 23 ? (const void*)fwd<22> : SiteTab<22>::get(s); }
#else
static const void* site_fn(int) { return (const void*)fwd<-1>; }
#endif
extern "C" void kernel_launch(void* const* d_in, const int* in_sizes, int n_in, void* d_out, int out_size, void* d_ws, size_t ws_size, hipStream_t stream) {
    static int grid = 0;
    if (grid == 0) {
        if (n_in != 20 || ws_size < WS_END) { fprintf(stderr, "kernel_launch: need 20 inputs and %zu bytes of workspace; got %d, %zu\n", (size_t)WS_END, n_in, ws_size); grid = -1; return; }
        int dev = 0, cus = 0, per_cu = 0;
        if (hipGetDevice(&dev) != hipSuccess || hipDeviceGetAttribute(&cus, hipDeviceAttributeMultiprocessorCount, dev) != hipSuccess) { grid = -1; return; }
        for (int s = 0; s < NSITES; ++s) if (hipFuncSetAttribute(site_fn(s), hipFuncAttributeMaxDynamicSharedMemorySize, LDS_BYTES) != hipSuccess) { fprintf(stderr, "kernel_launch: hipFuncSetAttribute failed\n"); grid = -1; return; }
        if (hipOccupancyMaxActiveBlocksPerMultiprocessor(&per_cu, site_fn(N_LAUNCH_SPLIT ? 1 : NSITES - 1), NTHREADS, LDS_BYTES) != hipSuccess || per_cu < 1) fprintf(stderr, "kernel_launch: occupancy query says %d\n", per_cu);
        (void)hipGetLastError();
        grid = cus;
    }
    if (grid < 0) return;
    (void)hipMemsetAsync((char*)d_ws + WS_CTL, 0, CTL_ZERO_BYTES, stream);
    Params p{};
    for (int i = 0; i < 20; ++i) p.in[i] = (const float*)d_in[i];
    p.out = (float*)d_out; p.ws = (unsigned char*)d_ws;
#if N_LAUNCH_SPLIT
    for (int ph = 0; ph < N_PHASES; ++ph) { p.ph_lo = ph; p.ph_hi = ph + 1; const int site = ph == 0 ? 0 : ph == N_PHASES - 1 ? 22 : 1 + (ph - 1) % 21; void* args[] = {&p};
        (void)hipLaunchKernel(site_fn(site), dim3(grid), dim3(NTHREADS), args, LDS_BYTES, stream); }
#else
    p.ph_lo = 0; p.ph_hi = N_PHASES; { void* args[] = {&p}; (void)hipLaunchKernel(site_fn(NSITES - 1), dim3(grid), dim3(NTHREADS), args, LDS_BYTES, stream); }
#endif
}
```

```cpp
#include <hip/hip_runtime.h>
#include <cstdio>
#include <cstdint>
#ifndef N_LAUNCH_SPLIT
#define N_LAUNCH_SPLIT 0
#endif
namespace pg8 {
#define PG8_LAS __attribute__((address_space(3)))
typedef unsigned short bf16_t;
typedef short bf16x8 __attribute__((ext_vector_type(8)));
typedef float f32x4 __attribute__((ext_vector_type(4)));
typedef unsigned u32x4 __attribute__((ext_vector_type(4)));
constexpr int BM = 256, BK = 64, HALF = 128, HTB = HALF * BK * 2  , STAGE_BYTES = 8 * HTB, NXCD = 8, WGM = 8;

__host__ __device__ __forceinline__ int lds_byte(int r, int c) { const int st = (r >> 4) * 2 + (c >> 5), rr = r & 15, cc = c & 31, ob = rr * 64 + cc * 2; return st * 1024 + (ob ^ (((ob >> 9) & 1) << 5)); }
__host__ __device__ __forceinline__ void stage_rc(int b, int& R, int& C) { const int st = b / 1024, sb = b % 1024, swz = sb ^ (((sb >> 9) & 1) << 5); R = (st >> 1) * 16 + swz / 64; C = (st & 1) * 32 + (swz % 64) / 2; }
__host__ __device__ __forceinline__ int perm32(int rho) { const int n = rho >> 4, i = rho & 15; return 8 * (i >> 2) + 4 * n + (i & 3); }

struct Unit { int pm, pn, r0; };
struct Gemm { const bf16_t* A; const bf16_t* Bt; int M, N, K; };

struct StaticOrder {
    int nM, nN, nwg, G, c, tokmap;
    __host__ __device__ void init(int M, int N, int G_, int c_, int tokmap_ = 0) { nM = M / BM; nN = N / BM; nwg = nM * nN; G = G_; c = c_; tokmap = tokmap_; }
    __host__ __device__ bool next(int i, Unit& u) const {
        const long L = (long)i * G + c; if (L >= nwg) return false;
        int wgid = (int)L; { const int q = nwg / NXCD, r = nwg % NXCD, xcd = wgid % NXCD, off = wgid / NXCD; wgid = (xcd < r ? xcd * (q + 1) : r * (q + 1) + (xcd - r) * q) + off; }
        const int nig = WGM * nN, gid = wgid / nig, fm = gid * WGM, gsz = (nM - fm) < WGM ? (nM - fm) : WGM;
        u.pm = fm + ((wgid % nig) % gsz); u.pn = (wgid % nig) / gsz; u.r0 = tokmap ? 4112 * (u.pm >> 4) + 16 + 256 * (u.pm & 15) : 256 * u.pm; return true;
    }
    __device__ __forceinline__ const char* b_base(const Gemm& g, const Unit& u, size_t tstep) const { return (const char*)g.Bt + (size_t)u.pn * tstep; }
    __device__ __forceinline__ void a_ready(const Unit&) const {}
    __device__ __forceinline__ void done(const Unit&) const {}
};
__device__ __forceinline__ unsigned cvt_pk_bf16(float lo, float hi) { unsigned r; asm volatile("v_cvt_pk_bf16_f32 %0, %1, %2" : "=v"(r) : "v"(lo), "v"(hi)); return r; }
typedef int i32x8 __attribute__((ext_vector_type(8)));
typedef int i32x4v __attribute__((ext_vector_type(4)));
__device__ __forceinline__ i32x8 cat8(bf16x8 a, bf16x8 b) { const i32x4v x = __builtin_bit_cast(i32x4v, a), y = __builtin_bit_cast(i32x4v, b); return __builtin_shufflevector(x, y, 0, 1, 2, 3, 4, 5, 6, 7); }
__device__ __forceinline__ float clamp448(float x) { return __builtin_amdgcn_fmed3f(x, -448.0f, 448.0f); }
__device__ __forceinline__ unsigned cvt4_fp8(float a, float b, float c, float d) { int w = 0; w = __builtin_amdgcn_cvt_pk_fp8_f32(clamp448(a), clamp448(b), w, false); w = __builtin_amdgcn_cvt_pk_fp8_f32(clamp448(c), clamp448(d), w, true); return (unsigned)w; }
typedef unsigned u32x2v __attribute__((ext_vector_type(2)));
struct EpiStoreBf16 {
    static constexpr bool PERM = true, AFTER_DRAIN = false;
    bf16_t* O; int ldc; float s;
    __device__ __forceinline__ void operator()(const f32x4 (&acc)[2][2][4][2], const Unit& u, int wr, int wc, int fr, int fq) const {
        const int row0 = u.r0 + wr * 64 + fr, col0 = u.pn * BM + wc * 32 + 8 * fq;
#pragma unroll
        for (int ai = 0; ai < 2; ++ai)
#pragma unroll
            for (int m = 0; m < 4; ++m) { bf16_t* rowp = O + (size_t)(row0 + ai * HALF + m * 16) * ldc + col0;
#pragma unroll
                for (int bj = 0; bj < 2; ++bj) { const f32x4 v0 = acc[ai][bj][m][0] * s, v1 = acc[ai][bj][m][1] * s;
                    u32x4 w; w.x = cvt_pk_bf16(v0[0], v0[1]); w.y = cvt_pk_bf16(v0[2], v0[3]); w.z = cvt_pk_bf16(v1[0], v1[1]); w.w = cvt_pk_bf16(v1[2], v1[3]);
                    *(u32x4*)(rowp + bj * HALF) = w; } }
    }
};
struct EpiResAdd {
    static constexpr bool PERM = false, AFTER_DRAIN = false;
    float* H; int ldc; float s;
    __device__ __forceinline__ void operator()(const f32x4 (&acc)[2][2][4][2], const Unit& u, int wr, int wc, int fr, int fq) const {
        const int row0 = u.r0 + wr * 64 + fr, col0 = u.pn * BM + wc * 32 + 4 * fq;
#pragma unroll
        for (int ai = 0; ai < 2; ++ai)
#pragma unroll
            for (int m = 0; m < 4; ++m) { float* rowp = H + (size_t)(row0 + ai * HALF + m * 16) * ldc + col0;
                f32x4 h[2][2];
#pragma unroll
                for (int bj = 0; bj < 2; ++bj)
#pragma unroll
                    for (int n = 0; n < 2; ++n) h[bj][n] = *(const f32x4*)(rowp + bj * HALF + n * 16);
#pragma unroll
                for (int bj = 0; bj < 2; ++bj)
#pragma unroll
                    for (int n = 0; n < 2; ++n) *(f32x4*)(rowp + bj * HALF + n * 16) = h[bj][n] + acc[ai][bj][m][n] * s;
                if (m & 1) asm volatile("" ::: "memory"); }
    }
};
struct EpiResAddB {
    static constexpr bool PERM = true, AFTER_DRAIN = false;
    bf16_t* H; int ldc; float s;
    __device__ __forceinline__ void operator()(const f32x4 (&acc)[2][2][4][2], const Unit& u, int wr, int wc, int fr, int fq) const {
        const int row0 = u.r0 + wr * 64 + fr, col0 = u.pn * BM + wc * 32 + 8 * fq;
#pragma unroll
        for (int ai = 0; ai < 2; ++ai)
#pragma unroll
            for (int m = 0; m < 4; ++m) { bf16_t* rowp = H + (size_t)(row0 + ai * HALF + m * 16) * ldc + col0;
                u32x4 h[2];
#pragma unroll
                for (int bj = 0; bj < 2; ++bj) h[bj] = *(const u32x4*)(rowp + bj * HALF);
#pragma unroll
                for (int bj = 0; bj < 2; ++bj) { const f32x4 v0 = acc[ai][bj][m][0] * s, v1 = acc[ai][bj][m][1] * s; const u32x4 q = h[bj];
                    u32x4 w; w.x = cvt_pk_bf16(__uint_as_float(q.x << 16) + v0[0], __uint_as_float(q.x & 0xffff0000u) + v0[1]); w.y = cvt_pk_bf16(__uint_as_float(q.y << 16) + v0[2], __uint_as_float(q.y & 0xffff0000u) + v0[3]);
                    w.z = cvt_pk_bf16(__uint_as_float(q.z << 16) + v1[0], __uint_as_float(q.z & 0xffff0000u) + v1[1]); w.w = cvt_pk_bf16(__uint_as_float(q.w << 16) + v1[2], __uint_as_float(q.w & 0xffff0000u) + v1[3]);
                    *(u32x4*)(rowp + bj * HALF) = w; }
                if (m & 1) asm volatile("" ::: "memory"); }
    }
};
__device__ __forceinline__ float silu_mul(float g, float u) { return g * __builtin_amdgcn_rcpf(1.0f + __expf(-g)) * u; }
struct EpiSwiGLU {
    static constexpr bool PERM = true, AFTER_DRAIN = false;
    bf16_t* O; int ldc;
    __device__ __forceinline__ void operator()(const f32x4 (&acc)[2][2][4][2], const Unit& u, int wr, int wc, int fr, int fq) const {
        const int row0 = u.r0 + wr * 64 + fr, col0 = u.pn * HALF + wc * 32 + 8 * fq;
#pragma unroll
        for (int ai = 0; ai < 2; ++ai)
#pragma unroll
            for (int m = 0; m < 4; ++m) { bf16_t* rowp = O + (size_t)(row0 + ai * HALF + m * 16) * ldc + col0;
                const f32x4 g0 = acc[ai][0][m][0], g1 = acc[ai][0][m][1], u0 = acc[ai][1][m][0], u1 = acc[ai][1][m][1];
                u32x4 w; w.x = cvt_pk_bf16(silu_mul(g0[0], u0[0]), silu_mul(g0[1], u0[1])); w.y = cvt_pk_bf16(silu_mul(g0[2], u0[2]), silu_mul(g0[3], u0[3]));
                w.z = cvt_pk_bf16(silu_mul(g1[0], u1[0]), silu_mul(g1[1], u1[1])); w.w = cvt_pk_bf16(silu_mul(g1[2], u1[2]), silu_mul(g1[3], u1[3]));
                *(u32x4*)rowp = w; }
    }
};
struct EpiSwiGLU8 {
    static constexpr bool PERM = true, AFTER_DRAIN = false;
    unsigned char* O; int ldc; float sg, so;
    __device__ __forceinline__ void operator()(const f32x4 (&acc)[2][2][4][2], const Unit& u, int wr, int wc, int fr, int fq) const {
        const int row0 = u.r0 + wr * 64 + fr, col0 = u.pn * HALF + wc * 32 + 8 * fq;
        const float ss = sg * sg * so;
#pragma unroll
        for (int ai = 0; ai < 2; ++ai)
#pragma unroll
            for (int m = 0; m < 4; ++m) { unsigned char* rowp = O + (size_t)(row0 + ai * HALF + m * 16) * ldc + col0;
                const f32x4 g0 = acc[ai][0][m][0], g1 = acc[ai][0][m][1], u0 = acc[ai][1][m][0], u1 = acc[ai][1][m][1];
                float a[8];
#pragma unroll
                for (int i = 0; i < 4; ++i) { a[i] = g0[i] * __builtin_amdgcn_rcpf(1.0f + __expf(-sg * g0[i])) * u0[i] * ss; a[4 + i] = g1[i] * __builtin_amdgcn_rcpf(1.0f + __expf(-sg * g1[i])) * u1[i] * ss; }
                u32x2v w; w.x = cvt4_fp8(a[0], a[1], a[2], a[3]); w.y = cvt4_fp8(a[4], a[5], a[6], a[7]);
                *(u32x2v*)rowp = w; }
    }
};
struct EpiMoeDown {
    static constexpr bool PERM = true, AFTER_DRAIN = false;
    bf16_t* Y0; bf16_t* Y1; const int* slot_tok; const float* slot_g; int ldc; float s;
    __device__ __forceinline__ void operator()(const f32x4 (&acc)[2][2][4][2], const Unit& u, int wr, int wc, int fr, int fq) const {
        const int row0 = u.r0 + wr * 64 + fr, col0 = u.pn * BM + wc * 32 + 8 * fq;
#pragma unroll
        for (int ai = 0; ai < 2; ++ai)
#pragma unroll
            for (int m = 0; m < 4; ++m) { const int slot = row0 + ai * HALF + m * 16; const int ti = slot_tok[slot]; const float g = slot_g[slot] * s;
                if (ti >= 0) { bf16_t* rowp = ((ti >> 16) ? Y1 : Y0) + (size_t)(ti & 0xffff) * ldc + col0;
#pragma unroll
                    for (int bj = 0; bj < 2; ++bj) { const f32x4 v0 = acc[ai][bj][m][0] * g, v1 = acc[ai][bj][m][1] * g;
                        u32x4 w; w.x = cvt_pk_bf16(v0[0], v0[1]); w.y = cvt_pk_bf16(v0[2], v0[3]); w.z = cvt_pk_bf16(v1[0], v1[1]); w.w = cvt_pk_bf16(v1[2], v1[3]);
                        *(u32x4*)(rowp + bj * HALF) = w; } } }
    }
};
struct GroupedOrder {
    int nM, nN, nwg, G, c; int p1, p2, p3, p4, p5, p6, p7; size_t estride; int bmajor;
    __device__ __forceinline__ bool next(int i, Unit& u) const {
        const long L = (long)i * G + c; if (L >= nwg) return false;
        int wgid = (int)L; { const int q = nwg / NXCD, r = nwg % NXCD, xcd = wgid % NXCD, off = wgid / NXCD; wgid = (xcd < r ? xcd * (q + 1) : r * (q + 1) + (xcd - r) * q) + off; }
        if (bmajor) {
            const int e = (wgid >= nN * p1) + (wgid >= nN * p2) + (wgid >= nN * p3) + (wgid >= nN * p4) + (wgid >= nN * p5) + (wgid >= nN * p6) + (wgid >= nN * p7);
            const int pe = e == 0 ? 0 : e == 1 ? p1 : e == 2 ? p2 : e == 3 ? p3 : e == 4 ? p4 : e == 5 ? p5 : e == 6 ? p6 : p7;
            const int pe1 = e == 0 ? p1 : e == 1 ? p2 : e == 2 ? p3 : e == 3 ? p4 : e == 4 ? p5 : e == 5 ? p6 : e == 6 ? p7 : nM;
            const int np = pe1 - pe, local = wgid - nN * pe, gsz = np * 7, pg = local / gsz, rem = local - pg * gsz, pmo = rem / 7;
            u.pm = pe + pmo; u.pn = pg * 7 + (rem - pmo * 7); u.r0 = 256 * u.pm; return true;
        }
        const int nig = WGM * nN, gid = wgid / nig, fm = gid * WGM, gsz = (nM - fm) < WGM ? (nM - fm) : WGM;
        u.pm = fm + ((wgid % nig) % gsz); u.pn = (wgid % nig) / gsz; u.r0 = 256 * u.pm; return true;
    }
    __device__ __forceinline__ const char* b_base(const Gemm& g, const Unit& u, size_t tstep) const {
        const int e = (u.pm >= p1) + (u.pm >= p2) + (u.pm >= p3) + (u.pm >= p4) + (u.pm >= p5) + (u.pm >= p6) + (u.pm >= p7);
        return (const char*)g.Bt + (size_t)e * estride + (size_t)u.pn * tstep; }
    __device__ __forceinline__ void a_ready(const Unit&) const {}
    __device__ __forceinline__ void done(const Unit&) const {}
};
template <class Epi, class Sched, bool ALIGN_EPI = false, bool SP2 = false, bool FP8 = false>
__device__ __forceinline__ void gemm_phase(PG8_LAS unsigned char* lds, const Gemm g, const Sched& S, const Epi& E, int tid_in) {
    int tid_ = tid_in; asm volatile("" : "+v"(tid_));
    const int tid = tid_, wid = __builtin_amdgcn_readfirstlane(tid >> 6), lane = tid & 63, wr = wid >> 2, wc = wid & 3, fr = lane & 15, fq = lane >> 4;
    const int K = g.K, nt = K / BK;
    unsigned voffA[2], voffB[2];
#pragma unroll
    for (int i = 0; i < 2; ++i) { int R, C; stage_rc(tid * 16 + i * 8192, R, C); const int Rb = Epi::PERM ? ((R & ~31) + perm32(R & 31)) : R;
        voffA[i] = (unsigned)(R * K + C) * 2u; voffB[i] = (unsigned)(Rb * K + C) * 2u; }
    const size_t kstep = (size_t)(BK * 2);
    const size_t hstep = (size_t)HALF * K * 2;
    const size_t tstep = 2 * hstep;
    const unsigned ldsw = (unsigned)wid * 1024u;
    const int aoff = lds_byte(wr * 64 + fr, fq * 8), boff = lds_byte(wc * 32 + fr, fq * 8);
#define PG8_SA(b, h) (((b) * 2 + (h)) * HTB)
#define PG8_SB(b, h) ((4 + (b) * 2 + (h)) * HTB)
#define PG8_STAGE(bufoff, gbase, voff) do { _Pragma("unroll") for (int _i = 0; _i < 2; ++_i) \
        __builtin_amdgcn_global_load_lds((const unsigned*)((const char*)(gbase) + (voff)[_i]), (PG8_LAS unsigned*)(lds + (bufoff) + ldsw + _i * 8192), 16, 0, 0); } while (0)
#define PG8_LDA(dst, b, h) do { _Pragma("unroll") for (int m = 0; m < 4; ++m) _Pragma("unroll") for (int k = 0; k < 2; ++k) { \
        if constexpr (FP8) { const i32x4v v_ = *(const PG8_LAS i32x4v*)(lds + PG8_SA(b, h) + aoff + m * 2048 + k * 1024); if (k == 0) dst##8[m].lo = v_; else dst##8[m].hi = v_; } \
        else dst[m][k] = *(const PG8_LAS bf16x8*)(lds + PG8_SA(b, h) + aoff + m * 2048 + k * 1024); } } while (0)
#define PG8_LDB(dst, b, h) do { _Pragma("unroll") for (int n = 0; n < 2; ++n) _Pragma("unroll") for (int k = 0; k < 2; ++k) { \
        if constexpr (FP8) { const i32x4v v_ = *(const PG8_LAS i32x4v*)(lds + PG8_SB(b, h) + boff + n * 2048 + k * 1024); if (k == 0) dst##8[n].lo = v_; else dst##8[n].hi = v_; } \
        else dst[n][k] = *(const PG8_LAS bf16x8*)(lds + PG8_SB(b, h) + boff + n * 2048 + k * 1024); } } while (0)
#define PG8_MMA(ai, bj, At, Bt) do { __builtin_amdgcn_s_setprio(1); _Pragma("unroll") for (int m = 0; m < 4; ++m) _Pragma("unroll") for (int n = 0; n < 2; ++n) { \
        if constexpr (FP8) asm volatile("v_mfma_scale_f32_16x16x128_f8f6f4 %0, %1, %2, %0, %3, %3 op_sel_hi:[0,0,0]" : "+v"(acc[ai][bj][m][n]) : "v"(Bt##8[n]), "v"(At##8[m]), "v"(sc7f));   \
        else { _Pragma("unroll") for (int k = 0; k < 2; ++k) acc[ai][bj][m][n] = __builtin_amdgcn_mfma_f32_16x16x32_bf16(Bt[n][k], At[m][k], acc[ai][bj][m][n], 0, 0, 0); } } \
        __builtin_amdgcn_s_setprio(0); } while (0)
#define PG8_WAIT_V(n) asm volatile("s_waitcnt vmcnt(" #n ")" ::: "memory")
#define PG8_WAIT_L(n) asm volatile("s_waitcnt lgkmcnt(" #n ")" ::: "memory")
#define PG8_BAR __builtin_amdgcn_s_barrier()
#define PG8_SCHED __builtin_amdgcn_sched_barrier(0)
    Unit cur, nxt; int ui = 0;
    if (!S.next(0, cur)) return;
    f32x4 acc[2][2][4][2];
#pragma unroll
    for (int a = 0; a < 2; ++a)
#pragma unroll
        for (int b = 0; b < 2; ++b)
#pragma unroll
            for (int m = 0; m < 4; ++m)
#pragma unroll
                for (int n = 0; n < 2; ++n) acc[a][b][m][n] = (f32x4){0.f, 0.f, 0.f, 0.f};
    int sc7f = 0x7f; asm volatile("" : "+v"(sc7f));
    bf16x8 At[4][2], B0[2][2], B1[2][2]; i32x8 At8[4], B08[2], B18[2];
    const char* cA = (const char*)g.A + (size_t)cur.r0 * K * 2; const char* cB = S.b_base(g, cur, tstep);
    S.a_ready(cur);
    if constexpr (SP2) {
        PG8_STAGE(PG8_SB(0, 0), cB, voffB); PG8_STAGE(PG8_SB(0, 1), cB + hstep, voffB); PG8_STAGE(PG8_SA(0, 0), cA, voffA); PG8_STAGE(PG8_SA(0, 1), cA + hstep, voffA);
        if (wr == 1) PG8_BAR;
        PG8_WAIT_V(2); PG8_BAR;
        PG8_STAGE(PG8_SB(1, 0), cB + kstep, voffB); PG8_STAGE(PG8_SA(1, 0), cA + kstep, voffA); PG8_STAGE(PG8_SB(1, 1), cB + hstep + kstep, voffB);
        PG8_WAIT_V(6); PG8_BAR;
    } else {
        PG8_STAGE(PG8_SB(0, 0), cB, voffB); PG8_STAGE(PG8_SA(0, 0), cA, voffA); PG8_STAGE(PG8_SB(0, 1), cB + hstep, voffB); PG8_STAGE(PG8_SA(0, 1), cA + hstep, voffA);
        if (wr == 1) PG8_BAR;
        PG8_WAIT_V(4); PG8_BAR;
        PG8_STAGE(PG8_SB(1, 0), cB + kstep, voffB); PG8_STAGE(PG8_SA(1, 0), cA + kstep, voffA); PG8_STAGE(PG8_SB(1, 1), cB + hstep + kstep, voffB);
        PG8_WAIT_V(6); PG8_BAR;
    }
    for (;;) {
        const bool has_next = S.next(ui + 1, nxt);
        const char* nA = has_next ? (const char*)g.A + (size_t)nxt.r0 * K * 2 : cA; const char* nB = has_next ? S.b_base(g, nxt, tstep) : cB;
        for (int t = 0; t < nt; t += 2) {
            const bool last = (t == nt - 2);
            const char* a1 = cA + (size_t)(t + 1) * kstep;
            const char* a2 = last ? nA : cA + (size_t)(t + 2) * kstep; const char* b2 = last ? nB : cB + (size_t)(t + 2) * kstep;
            const char* a3 = a2 + kstep; const char* b3 = b2 + kstep;
            if (last && has_next) S.a_ready(nxt);
            if constexpr (SP2) {
            PG8_LDB(B0, 0, 0); PG8_LDB(B1, 0, 1); PG8_SCHED; PG8_LDA(At, 0, 0); PG8_STAGE(PG8_SA(1, 1), a1 + hstep, voffA);
            PG8_WAIT_V(8); PG8_WAIT_L(0); PG8_BAR; PG8_MMA(0, 0, At, B0); PG8_MMA(0, 1, At, B1); PG8_BAR; PG8_SCHED;
            PG8_LDA(At, 0, 1); PG8_STAGE(PG8_SB(0, 0), b2, voffB); PG8_STAGE(PG8_SB(0, 1), b2 + hstep, voffB); PG8_STAGE(PG8_SA(0, 0), a2, voffA);
            PG8_WAIT_V(8); PG8_WAIT_L(0); PG8_BAR; PG8_MMA(1, 0, At, B0); PG8_MMA(1, 1, At, B1); PG8_BAR; PG8_SCHED;
            PG8_LDB(B0, 1, 0); PG8_LDB(B1, 1, 1); PG8_SCHED; PG8_LDA(At, 1, 0); PG8_STAGE(PG8_SA(0, 1), a2 + hstep, voffA);
            PG8_WAIT_V(8); PG8_WAIT_L(0); PG8_BAR; PG8_MMA(0, 0, At, B0); PG8_MMA(0, 1, At, B1); PG8_BAR; PG8_SCHED;
            PG8_LDA(At, 1, 1); PG8_STAGE(PG8_SB(1, 0), b3, voffB); PG8_STAGE(PG8_SB(1, 1), b3 + hstep, voffB); PG8_STAGE(PG8_SA(1, 0), a3, voffA);
            PG8_WAIT_V(8); PG8_WAIT_L(0); PG8_BAR; PG8_MMA(1, 0, At, B0); PG8_MMA(1, 1, At, B1); PG8_BAR; PG8_SCHED;
            } else {
            PG8_LDB(B0, 0, 0); PG8_SCHED; PG8_LDA(At, 0, 0); PG8_STAGE(PG8_SA(1, 1), a1 + hstep, voffA);
            PG8_WAIT_L(8); PG8_BAR; PG8_WAIT_L(0); PG8_MMA(0, 0, At, B0); PG8_BAR; PG8_SCHED;
            PG8_LDB(B1, 0, 1); PG8_STAGE(PG8_SB(0, 0), b2, voffB);
            PG8_BAR; PG8_WAIT_L(0); PG8_MMA(0, 1, At, B1); PG8_BAR;
            PG8_LDA(At, 0, 1); PG8_STAGE(PG8_SA(0, 0), a2, voffA);
            PG8_BAR; PG8_WAIT_L(0); PG8_MMA(1, 0, At, B0); PG8_BAR; PG8_SCHED;
            PG8_STAGE(PG8_SB(0, 1), b2 + hstep, voffB);
            PG8_WAIT_V(6); PG8_BAR; PG8_MMA(1, 1, At, B1); PG8_BAR;
            PG8_LDB(B0, 1, 0); PG8_SCHED; PG8_LDA(At, 1, 0); PG8_STAGE(PG8_SA(0, 1), a2 + hstep, voffA);
            PG8_WAIT_L(8); PG8_BAR; PG8_WAIT_L(0); PG8_MMA(0, 0, At, B0); PG8_BAR; PG8_SCHED;
            PG8_LDB(B1, 1, 1); PG8_STAGE(PG8_SB(1, 0), b3, voffB);
            PG8_BAR; PG8_WAIT_L(0); PG8_MMA(0, 1, At, B1); PG8_BAR;
            PG8_LDA(At, 1, 1); PG8_STAGE(PG8_SA(1, 0), a3, voffA);
            PG8_BAR; PG8_WAIT_L(0); PG8_MMA(1, 0, At, B0); PG8_BAR; PG8_SCHED;
            PG8_STAGE(PG8_SB(1, 1), b3 + hstep, voffB);
            PG8_WAIT_V(6); PG8_BAR; PG8_MMA(1, 1, At, B1); PG8_BAR;
            }
        }
        if constexpr (FP8) asm volatile("s_nop 15\n\ts_nop 15" ::: "memory");
        if constexpr (ALIGN_EPI) { if (wr == 0) PG8_BAR; }
        if constexpr (!Epi::AFTER_DRAIN) { E(acc, cur, wr, wc, fr, fq); S.done(cur); }
        if (!has_next) break;
#pragma unroll
        for (int a = 0; a < 2; ++a)
#pragma unroll
            for (int b = 0; b < 2; ++b)
#pragma unroll
                for (int m = 0; m < 4; ++m)
#pragma unroll
                    for (int n = 0; n < 2; ++n) acc[a][b][m][n] = (f32x4){0.f, 0.f, 0.f, 0.f};
        cur = nxt; cA = nA; cB = nB; ++ui;
        if constexpr (ALIGN_EPI) { if (wr == 1) PG8_BAR; }
    }
    PG8_WAIT_V(0);
    if constexpr (!ALIGN_EPI) { if (wr == 0) PG8_BAR; }
    PG8_BAR;
    if constexpr (Epi::AFTER_DRAIN) { E.fused(acc, cur, wr, wc, fr, fq, lds, wid, lane); S.done(cur); }
#undef PG8_SA
#undef PG8_SB
#undef PG8_STAGE
#undef PG8_LDA
#undef PG8_LDB
#undef PG8_MMA
#undef PG8_WAIT_V
#undef PG8_WAIT_L
#undef PG8_BAR
#undef PG8_SCHED
}
}
constexpr int BATCH = 4, SEQ = 4096, NMETA = 16, SL = SEQ + NMETA  , NT = BATCH * SL  , MP = 16640  , D = 1024;
constexpr int DSA_LDW = 2696, DSA_NP = 2816, DQ0 = 0, DK0 = 1024, DV0 = 1280, DIQ0 = 1536, DIK0 = 2560, DIW0 = 2688;
constexpr int ML_LDW = 3080, ML_NP = 3072, MQ0 = 0, MK0 = 512, MV0 = 1024, MO0 = 2048, MG0 = 3072;
constexpr int FF = 3584, GU = 7168, NE = 8;
constexpr int MOE_ROWS = 35072;
constexpr int NWAVES = 8, NTHREADS = 512;
#ifndef FP8_DENSE
#define FP8_DENSE 1
#endif
#ifndef FP8_MOE
#define FP8_MOE 1
#endif
constexpr float SW_GU = 32.0f, SW_DN = 128.0f, SA_ACT = 4.0f;
#ifndef CONV_IN_PROLOGUE
#define CONV_IN_PROLOGUE 0
#endif
#ifndef H_BF16
#define H_BF16 1
#endif
#ifndef MOE_GU_BMAJOR
#define MOE_GU_BMAJOR 0
#endif
#ifndef FP8_DSA
#define FP8_DSA 0
#endif
#ifndef FP8_DSA_IN
#define FP8_DSA_IN 0
#endif
constexpr float SW_DIN = 32.0f, SW_DOUT = 64.0f, SA_ATT = 16.0f;
constexpr int SCLD = 4128;
constexpr float RMS_EPS = 1e-6f;
constexpr size_t MiB = 1u << 20;
constexpr size_t WS_CTL = 0, CTL_ZERO_BYTES = 1 * MiB;
constexpr size_t WS_ROPE = 1 * MiB;
constexpr size_t WS_SM8 = 4 * MiB;
constexpr size_t WS_ROUTE = 5 * MiB;
constexpr size_t WS_MLG = 6 * MiB;
constexpr size_t WS_MLI = 17 * MiB + 256 * 1024;
constexpr size_t WS_NH = 7 * MiB;
constexpr size_t WS_SLOT = 8 * MiB;
constexpr size_t WS_SEL = 9 * MiB;
constexpr size_t WS_WDSA_IN = 18 * MiB, WS_WDSA_OUT = 29 * MiB, WS_WML_IN = 33 * MiB, WS_WML_OUT = 45 * MiB, WS_WFFN_GU = 49 * MiB, WS_WFFN_DN = 77 * MiB;
constexpr size_t WS_WMOE_GU = 91 * MiB, WS_WMOE_DN = 315 * MiB;
constexpr size_t WS_H = 427 * MiB;
constexpr size_t WS_XN = 492 * MiB;
constexpr size_t WS_R = 525 * MiB, WS_K8 = 875 * MiB, WS_XN8 = 875 * MiB, WS_END = 892 * MiB;
constexpr size_t R_PROJ = 0, R_SC = 90 * MiB, R_ACT = 0, R_DC = 98 * MiB, R_CH = 130 * MiB, R_AS = 240 * MiB, R_Y0 = 240 * MiB, R_Y1 = 274 * MiB;
static_assert(R_SC + (size_t)NT * SCLD * 4 + 16384 <= WS_K8 - WS_R, "score matrix (+ 8 KiB of never-read store slots behind it) fits");
static_assert((size_t)MOE_ROWS * FF * 2 <= R_AS && R_AS + (size_t)MOE_ROWS * D * 2 <= WS_K8 - WS_R, "moe buffers fit");
static_assert((size_t)MP * DSA_NP * 2 <= R_SC && (size_t)MP * ML_NP * 2 <= R_DC, "proj fits");
constexpr int CW_BAR = 4096;
constexpr int CW_CNT = 8192;
constexpr int LDS_BYTES = 151552;
constexpr int MISC_OFF = LDS_BYTES - 256;

#define GAS __attribute__((address_space(1)))
#define LAS __attribute__((address_space(3)))
typedef unsigned short bf16;
#if H_BF16
typedef unsigned short HT;
#else
typedef float HT;
#endif
typedef float f32x4 __attribute__((ext_vector_type(4)));
typedef float f32x2 __attribute__((ext_vector_type(2)));
typedef float f32x16 __attribute__((ext_vector_type(16)));
typedef short bf16x8 __attribute__((ext_vector_type(8)));
typedef short s16x4 __attribute__((ext_vector_type(4)));
typedef unsigned u32x4 __attribute__((ext_vector_type(4)));
typedef unsigned u32x2 __attribute__((ext_vector_type(2)));
#define MFMA32(a, b, c) __builtin_amdgcn_mfma_f32_32x32x16_bf16((a), (b), (c), 0, 0, 0)
#define MFMA16(a, b, c) __builtin_amdgcn_mfma_f32_16x16x32_bf16((a), (b), (c), 0, 0, 0)
__device__ __forceinline__ float bf2f(unsigned short b) { return __uint_as_float(((unsigned)b) << 16); }
__device__ __forceinline__ float bflo(unsigned w) { return __uint_as_float(w << 16); }
__device__ __forceinline__ float bfhi(unsigned w) { return __uint_as_float(w & 0xffff0000u); }
__device__ __forceinline__ unsigned pk2(float lo, float hi) { return pg8::cvt_pk_bf16(lo, hi); }
__device__ __forceinline__ float wave_sum(float v) {
#pragma unroll
    for (int o = 1; o < 64; o <<= 1) v += __shfl_xor(v, o);
    return v; }
__device__ __forceinline__ int crow(int r, int hi) { return (r & 3) + 8 * (r >> 2) + 4 * hi; }

#define XB_TMO      128
#define XB_XCNT(j)  (256  + 64 * (j))
#define XB_XSUB(j)  (1280 + 64 * (j))
#define XB_XGEN(j)  (2304 + 64 * (j))
#define XB_TOP      3328
#define XB_TOPGEN   3392
#define XCD_BAR_WORDS 3456
#define XB_SPIN_CAP (1u << 18)
__device__ __forceinline__ unsigned xb_ld(unsigned* p)              { return __hip_atomic_load(p, __ATOMIC_RELAXED, __HIP_MEMORY_SCOPE_AGENT); }
__device__ __forceinline__ unsigned xb_add(unsigned* p, unsigned v) { return __hip_atomic_fetch_add(p, v, __ATOMIC_RELAXED, __HIP_MEMORY_SCOPE_AGENT); }
__device__ __forceinline__ unsigned xb_xcc_id() { return (unsigned)__builtin_amdgcn_s_getreg((3 << 11) | 20) & 0xFu; }
#define XB_SPIN(cond, bar) do { unsigned _sp = 0; while (cond) { __builtin_amdgcn_s_sleep(1); \
    if ((++_sp & 255u) == 0u) { if (xb_ld(&(bar)[XB_TMO])) break; if (_sp > XB_SPIN_CAP) { atomicAdd(&(bar)[XB_TMO], 1u); break; } } } } while (0)
__device__ __forceinline__ int hw_lane() { int l; asm volatile("v_mbcnt_lo_u32_b32 %0, -1, 0\n\tv_mbcnt_hi_u32_b32 %0, -1, %0" : "=v"(l)); return l; }
struct XcdBarrier { unsigned* bar; unsigned x; volatile LAS unsigned* st; int wave; };
__device__ __forceinline__ XcdBarrier xcd_barrier_post(unsigned* bar, volatile LAS unsigned* st, int wave) {
    XcdBarrier b; b.bar = bar; b.x = xb_xcc_id(); b.st = st; b.wave = wave;
    if (wave == 0 && hw_lane() == 0) (void)xb_add(&bar[XB_XCNT(b.x)], 1u);
    return b;
}
__device__ __forceinline__ void xcd_barrier_complete(unsigned* bar, unsigned x, unsigned& nloc, unsigned& nx) {
    const unsigned G = gridDim.x * gridDim.y * gridDim.z;
    unsigned sum, cnt, mine, sp = 0u;
    for (;;) {
        sum = 0u; cnt = 0u; mine = 0u;
#pragma unroll
        for (unsigned j = 0; j < 16; ++j) { const unsigned c = xb_ld(&bar[XB_XCNT(j)]); sum += c; cnt += (c > 0u) ? 1u : 0u; mine = (j == x) ? c : mine; }
        if (sum == G) break;
        __builtin_amdgcn_s_sleep(1);
        if ((++sp & 255u) == 0u) { if (xb_ld(&bar[XB_TMO])) break; if (sp > XB_SPIN_CAP) { atomicAdd(&bar[XB_TMO], 1u); break; } }
    }
    nloc = mine > 0u ? mine : 1u; nx = cnt > 0u ? cnt : 1u;
}
__device__ __forceinline__ void xcd_barrier(const XcdBarrier& b) {
    asm volatile("s_waitcnt vmcnt(0)" ::: "memory");
    __syncthreads();
    if (b.wave == 0 && hw_lane() == 0) {
        unsigned* bar = b.bar;
        __builtin_amdgcn_s_waitcnt(0);
        unsigned nloc = b.st[0], nx = b.st[1];
        if (nloc == 0u) { xcd_barrier_complete(bar, b.x, nloc, nx); b.st[0] = nloc; b.st[1] = nx; }
        const unsigned old = xb_add(&bar[XB_XSUB(b.x)], 1u);
        const unsigned gen = old / nloc;
        if (old + 1u == (gen + 1u) * nloc) {
            __builtin_amdgcn_fence(__ATOMIC_RELEASE, "agent");
            asm volatile("s_waitcnt vmcnt(0)" ::: "memory");
            (void)xb_add(&bar[XB_TOP], 1u);
        }
        const unsigned target = (gen + 1u) * nx;
        XB_SPIN(xb_ld(&bar[XB_TOP]) < target, bar);
        __builtin_amdgcn_fence(__ATOMIC_ACQUIRE, "agent");
        asm volatile("s_waitcnt vmcnt(0)" ::: "memory");
    }
    __syncthreads();
}

struct Params { const float* in[20]; float* out; unsigned char* ws; int ph_lo, ph_hi; };
struct Ctx {
    LAS unsigned char* lds; int tid, lane, wave, G, bid, gw, ngw;
    unsigned* ctl;
    float2* rope; float* sm8; int* route_e; int* route_r1; int* route_r2; float* route_g1;
    float* mlf; float* mlc; float* mlp; float* mli; float* mlg; float* dn; float* nh; int* slot_tok; float* slot_g; unsigned short* sel;
    bf16 *wdsa_in, *wdsa_out, *wml_in, *wml_out, *wffn_gu, *wffn_dn, *wmoe_gu, *wmoe_dn;
    HT* H; bf16* XN; unsigned char* R; unsigned char* xn8;
};
__device__ __forceinline__ void conv_item(const float* W, int K, int ld, int n0, int k0, bf16* WT, int drow0, LAS float* scr, int lane) {
#pragma unroll 8
    for (int i = 0; i < 32; ++i) { const int kk = 2 * i + (lane >> 5); scr[kk * 33 + (lane & 31)] = W[(size_t)(k0 + kk) * ld + n0 + (lane & 31)]; }
    asm volatile("s_waitcnt lgkmcnt(0)" ::: "memory");
    const int c = lane & 7;
#pragma unroll
    for (int j = 0; j < 4; ++j) { const int n = (lane >> 3) + 8 * j; const LAS float* s = scr + (8 * c) * 33 + n;
        u32x4 o; o.x = pk2(s[0 * 33], s[1 * 33]); o.y = pk2(s[2 * 33], s[3 * 33]); o.z = pk2(s[4 * 33], s[5 * 33]); o.w = pk2(s[6 * 33], s[7 * 33]);
        *(u32x4*)(WT + (size_t)(drow0 + n) * K + k0 + 8 * c) = o; }
    asm volatile("s_waitcnt lgkmcnt(0)" ::: "memory");
}
__device__ __forceinline__ void conv_item8(const float* W, int K, int ld, int n0, int k0, unsigned char* WT, int drow0, LAS float* scr, int lane, float scale) {
#pragma unroll 8
    for (int i = 0; i < 32; ++i) { const int kk = 2 * i + (lane >> 5); scr[kk * 33 + (lane & 31)] = W[(size_t)(k0 + kk) * ld + n0 + (lane & 31)]; }
    asm volatile("s_waitcnt lgkmcnt(0)" ::: "memory");
    const int c = lane & 7;
#pragma unroll
    for (int j = 0; j < 4; ++j) { const int n = (lane >> 3) + 8 * j; const LAS float* s = scr + (8 * c) * 33 + n;
        u32x2 o; o.x = pg8::cvt4_fp8(s[0 * 33] * scale, s[1 * 33] * scale, s[2 * 33] * scale, s[3 * 33] * scale); o.y = pg8::cvt4_fp8(s[4 * 33] * scale, s[5 * 33] * scale, s[6 * 33] * scale, s[7 * 33] * scale);
        *(u32x2*)(WT + (size_t)(drow0 + n) * K + k0 + 8 * c) = o; }
    asm volatile("s_waitcnt lgkmcnt(0)" ::: "memory");
}
__device__ __forceinline__ void conv_plain8(const float* W, int K, int N, int ld, unsigned char* WT, int item, LAS float* scr, int lane, float scale) {
    const int nblk = N / 32, kb = item / nblk, nb = item % nblk;
    conv_item8(W, K, ld, 32 * nb, 64 * kb, WT, 32 * nb, scr, lane, scale);
}
__device__ __forceinline__ void conv_gu8(const float* W, int isup, unsigned char* WT, int item, LAS float* scr, int lane, float scale) {
    const int nblk = FF / 32, kb = item / nblk, nb = item % nblk, n0 = 32 * nb;
    conv_item8(W, D, FF, n0, 64 * kb, WT, 256 * (n0 >> 7) + 128 * isup + (n0 & 127), scr, lane, scale);
}
__device__ __forceinline__ void conv_plain(const float* W, int K, int N, int ld, bf16* WT, int item, LAS float* scr, int lane) {
    const int nblk = N / 32, kb = item / nblk, nb = item % nblk;
    conv_item(W, K, ld, 32 * nb, 64 * kb, WT, 32 * nb, scr, lane);
}
__device__ __forceinline__ void conv_gu(const float* W, int isup, bf16* WT, int item, LAS float* scr, int lane) {
    const int nblk = FF / 32, kb = item / nblk, nb = item % nblk, n0 = 32 * nb;
    conv_item(W, D, FF, n0, 64 * kb, WT, 256 * (n0 >> 7) + 128 * isup + (n0 & 127), scr, lane);
}
typedef const __attribute__((address_space(4))) Params* KArgP;
__device__ __forceinline__ void conv_big(const Ctx& C, KArgP P, int m, int r, LAS float* scr) {
    unsigned char* gu8d = (unsigned char*)C.wffn_gu; unsigned char* dn8d = (unsigned char*)C.wffn_dn; unsigned char* gu8m = (unsigned char*)C.wmoe_gu; unsigned char* dn8m = (unsigned char*)C.wmoe_dn;
    if (m < 2) { if (FP8_DENSE) conv_gu8(P->in[13] + (size_t)m * D * FF, 0, gu8d + (size_t)m * GU * D, r, scr, C.lane, SW_GU); else conv_gu(P->in[13] + (size_t)m * D * FF, 0, C.wffn_gu + (size_t)m * GU * D, r, scr, C.lane); }
    else if (m < 4) { if (FP8_DENSE) conv_gu8(P->in[14] + (size_t)(m - 2) * D * FF, 1, gu8d + (size_t)(m - 2) * GU * D, r, scr, C.lane, SW_GU); else conv_gu(P->in[14] + (size_t)(m - 2) * D * FF, 1, C.wffn_gu + (size_t)(m - 2) * GU * D, r, scr, C.lane); }
    else if (m < 6) { if (FP8_DENSE) conv_plain8(P->in[15] + (size_t)(m - 4) * FF * D, FF, D, D, dn8d + (size_t)(m - 4) * D * FF, r, scr, C.lane, SW_DN); else conv_plain(P->in[15] + (size_t)(m - 4) * FF * D, FF, D, D, C.wffn_dn + (size_t)(m - 4) * D * FF, r, scr, C.lane); }
    else if (m < 22) { if (FP8_MOE) conv_gu8(P->in[17] + (size_t)(m - 6) * D * FF, 0, gu8m + (size_t)(m - 6) * GU * D, r, scr, C.lane, SW_GU); else conv_gu(P->in[17] + (size_t)(m - 6) * D * FF, 0, C.wmoe_gu + (size_t)(m - 6) * GU * D, r, scr, C.lane); }
    else if (m < 38) { if (FP8_MOE) conv_gu8(P->in[18] + (size_t)(m - 22) * D * FF, 1, gu8m + (size_t)(m - 22) * GU * D, r, scr, C.lane, SW_GU); else conv_gu(P->in[18] + (size_t)(m - 22) * D * FF, 1, C.wmoe_gu + (size_t)(m - 22) * GU * D, r, scr, C.lane); }
    else { if (FP8_MOE) conv_plain8(P->in[19] + (size_t)(m - 38) * FF * D, FF, D, D, dn8m + (size_t)(m - 38) * D * FF, r, scr, C.lane, SW_DN); else conv_plain(P->in[19] + (size_t)(m - 38) * FF * D, FF, D, D, C.wmoe_dn + (size_t)(m - 38) * D * FF, r, scr, C.lane); }
}
struct ConvD { const float* src; unsigned char* dst; int K; float scale; };
template <int LD>
__device__ __forceinline__ void conv_ld32(const float* src, int lane, float (&v)[32]) {
    const float* p = src + (size_t)(lane >> 5) * LD + (lane & 31);
#pragma unroll
    for (int i = 0; i < 32; ++i) v[i] = p[(size_t)(2 * i) * LD];
}
__device__ __forceinline__ void conv_st8(const ConvD& d, const float (&v)[32], LAS float* scr, int lane) {
#pragma unroll
    for (int i = 0; i < 32; ++i) scr[(2 * i + (lane >> 5)) * 33 + (lane & 31)] = v[i];
    asm volatile("s_waitcnt lgkmcnt(0)" ::: "memory");
    const int c = lane & 7; const float scale = d.scale;
#pragma unroll
    for (int j = 0; j < 4; ++j) { const int n = (lane >> 3) + 8 * j; const LAS float* s = scr + (8 * c) * 33 + n;
        u32x2 o; o.x = pg8::cvt4_fp8(s[0 * 33] * scale, s[1 * 33] * scale, s[2 * 33] * scale, s[3 * 33] * scale); o.y = pg8::cvt4_fp8(s[4 * 33] * scale, s[5 * 33] * scale, s[6 * 33] * scale, s[7 * 33] * scale);
        *(u32x2*)(d.dst + (size_t)n * d.K + 8 * c) = o; }
    asm volatile("s_waitcnt lgkmcnt(0)" ::: "memory");
}
__device__ __forceinline__ bool conv_desc(const Ctx& C, KArgP P, int m, int r, ConvD& d) {
    unsigned char* gu8d = (unsigned char*)C.wffn_gu; unsigned char* dn8d = (unsigned char*)C.wffn_dn; unsigned char* gu8m = (unsigned char*)C.wmoe_gu; unsigned char* dn8m = (unsigned char*)C.wmoe_dn;
    const bool isdn = (m >= 4 && m < 6) || m >= 38;
    if (!isdn) {
        const int isup = (m >= 2 && m < 4) || (m >= 22); const int mm = m < 2 ? m : m < 4 ? m - 2 : m < 22 ? m - 6 : m - 22;
        const float* W = (m < 2 ? P->in[13] : m < 4 ? P->in[14] : m < 22 ? P->in[17] : P->in[18]) + (size_t)mm * D * FF;
        unsigned char* WT = (m < 4 ? gu8d : gu8m) + (size_t)mm * GU * D;
        const int nblk = FF / 32, kb = r / nblk, nb = r % nblk, n0 = 32 * nb, drow0 = 256 * (n0 >> 7) + 128 * isup + (n0 & 127);
        d.src = W + (size_t)(64 * kb) * FF + n0; d.dst = WT + (size_t)drow0 * D + 64 * kb; d.K = D; d.scale = SW_GU; return true;
    } else {
        const int mm = m < 6 ? m - 4 : m - 38;
        const float* W = (m < 6 ? P->in[15] : P->in[19]) + (size_t)mm * FF * D; unsigned char* WT = (m < 6 ? dn8d : dn8m) + (size_t)mm * D * FF;
        const int nblk = D / 32, kb = r / nblk, nb = r % nblk, n0 = 32 * nb;
        d.src = W + (size_t)(64 * kb) * D + n0; d.dst = WT + (size_t)n0 * FF + 64 * kb; d.K = FF; d.scale = SW_DN; return false;
    }
}
constexpr int CONV_TILE = 8 * (256 + 8) * 4;
__device__ __forceinline__ void conv_dma_issue(const ConvD& d, bool pitch_ff, int lane, LAS unsigned char* tile) {
    const unsigned ld = pitch_ff ? FF : D;
    const unsigned voff = ((unsigned)(lane >> 3) * ld + (unsigned)(lane & 7) * 4u) * 4u;
    const char* sb = (const char*)d.src;
#pragma unroll
    for (int t = 0; t < 8; ++t) { __builtin_amdgcn_global_load_lds((const unsigned*)(sb + voff), (LAS unsigned*)(tile + t * 1056), 16, 0, 0); sb += (size_t)ld * 32; }
}
__device__ __forceinline__ void conv_dma_finish(const ConvD& d, const LAS unsigned char* tile, int lane) {
    const int c = lane & 7; const float scale = d.scale;
#pragma unroll
    for (int j = 0; j < 4; ++j) { const int n = (lane >> 3) + 8 * j; const LAS float* s = (const LAS float*)tile + c * 264 + n;
        u32x2 o; o.x = pg8::cvt4_fp8(s[0 * 32] * scale, s[1 * 32] * scale, s[2 * 32] * scale, s[3 * 32] * scale); o.y = pg8::cvt4_fp8(s[4 * 32] * scale, s[5 * 32] * scale, s[6 * 32] * scale, s[7 * 32] * scale);
        *(u32x2*)(d.dst + (size_t)n * d.K + 8 * c) = o; }
    asm volatile("s_waitcnt lgkmcnt(0)" ::: "memory");
}
template <class MOf>
__device__ __forceinline__ void conv_stream(const Ctx& C, KArgP P, int first, int stride, int count, MOf m_of, int scr_pitch = 8448) {
    LAS float* scr = (LAS float*)(C.lds + C.wave * scr_pitch);
    int it = first; if (it >= count) return;
    ConvD da, db; float va[32], vb[32];
#define CONV_LOAD(d, v, i_) do { const bool g_ = conv_desc(C, P, m_of((i_) / 1792), (i_) % 1792, d); if (g_) conv_ld32<FF>(d.src, C.lane, v); else conv_ld32<D>(d.src, C.lane, v); } while (0)
    CONV_LOAD(da, va, it);
    for (;;) {
        const bool hb = it + stride < count;
        if (hb) CONV_LOAD(db, vb, it + stride);
        conv_st8(da, va, scr, C.lane);
        if (!hb) break;
        it += 2 * stride; const bool ha = it < count;
        if (ha) CONV_LOAD(da, va, it);
        conv_st8(db, vb, scr, C.lane);
        if (!ha) break;
    }
#undef CONV_LOAD
}
constexpr int CONV_IB = 1792;
__device__ __forceinline__ void conv_pair(const Ctx& C, KArgP P, int j) {
    conv_stream(C, P, C.gw, C.ngw, 27 * CONV_IB, [j](int q) { return q < 3 ? 2 * q + j : q < 11 ? 6 + 8 * j + (q - 3) : q < 19 ? 22 + 8 * j + (q - 11) : 38 + 8 * j + (q - 19); });
}
__device__ __forceinline__ void prologue_phase(const Ctx& C, KArgP P) {
    LAS float* scr = (LAS float*)(C.lds + C.wave * 8448);
    constexpr int IB = CONV_IB;
    constexpr int N_BIG = CONV_IN_PROLOGUE ? 54 * IB : 0;
    constexpr int I_DIN = 16 * 84, I_SQ = 16 * 32, I_MIN = 16 * 96;
    constexpr int N_SMALL = 2 * (I_DIN + I_SQ + I_MIN + I_SQ);
    if (N_BIG) conv_stream(C, P, C.gw, C.ngw, N_BIG, [](int q) { return q; });
    for (int it = C.gw; it < N_SMALL; it += C.ngw) {
        {
            int r = it;
            const int j = r / (N_SMALL / 2); r -= j * (N_SMALL / 2);
            if (r < I_DIN) { if (FP8_DSA_IN) conv_plain8(P->in[4] + (size_t)j * D * DSA_LDW, D, 2688, DSA_LDW, (unsigned char*)C.wdsa_in + (size_t)j * DSA_NP * D, r, scr, C.lane, SW_DIN);
                             else conv_plain(P->in[4] + (size_t)j * D * DSA_LDW, D, 2688, DSA_LDW, C.wdsa_in + (size_t)j * DSA_NP * D, r, scr, C.lane); continue; } r -= I_DIN;
            if (r < I_SQ) { if (FP8_DSA) conv_plain8(P->in[7] + (size_t)j * D * D, D, D, D, (unsigned char*)C.wdsa_out + (size_t)j * D * D, r, scr, C.lane, SW_DOUT);
                            else conv_plain(P->in[7] + (size_t)j * D * D, D, D, D, C.wdsa_out + (size_t)j * D * D, r, scr, C.lane); continue; } r -= I_SQ;
            if (r < I_MIN) { conv_plain(P->in[8] + (size_t)j * D * ML_LDW, D, ML_NP, ML_LDW, C.wml_in + (size_t)j * ML_NP * D, r, scr, C.lane); continue; } r -= I_MIN;
            conv_plain(P->in[12] + (size_t)j * D * D, D, D, D, C.wml_out + (size_t)j * D * D, r, scr, C.lane);
        }
    }
    const int gt = C.bid * NTHREADS + C.tid, ngt = C.G * NTHREADS;
    for (int i = gt; i < 2 * 128 * D / 8; i += ngt) { const int j = i / (128 * D / 8), o = i % (128 * D / 8);
        if (FP8_DSA_IN) { if (o < 128 * D / 16) *(u32x4*)((unsigned char*)C.wdsa_in + (size_t)j * DSA_NP * D + (size_t)2688 * D + (size_t)o * 16) = (u32x4){0u, 0u, 0u, 0u}; }
        else *(u32x4*)(C.wdsa_in + (size_t)j * DSA_NP * D + (size_t)2688 * D + (size_t)o * 8) = (u32x4){0u, 0u, 0u, 0u}; }
    for (int i = gt; i < (MP - NT) * D / 8; i += ngt) *(u32x4*)(C.XN + (size_t)NT * D + (size_t)i * 8) = (u32x4){0u, 0u, 0u, 0u};
    const float* x = P->in[0]; const float* meta = P->in[1];
    for (int i = gt; i < MP * (D / 4); i += ngt) { const int row = i / (D / 4), c4 = i % (D / 4); f32x4 v = (f32x4){0.f, 0.f, 0.f, 0.f};
        if (row < NT) { const int b = row / SL, p = row % SL;
            v = (p < NMETA) ? *(const f32x4*)(meta + (size_t)p * D + c4 * 4) : *(const f32x4*)(x + ((size_t)b * SEQ + (p - NMETA)) * D + c4 * 4); }
#if H_BF16
        u32x2 hv; hv.x = pk2(v[0], v[1]); hv.y = pk2(v[2], v[3]); *(u32x2*)(C.H + (size_t)row * D + c4 * 4) = hv; }
#else
        *(f32x4*)(C.H + (size_t)row * D + c4 * 4) = v; }
#endif
    for (int i = gt; i < SL * 64; i += ngt) { const int pos = i >> 6, k = i & 63; double inv = 1.0;
        for (int q = 0; q < k; ++q) inv *= 0.86596432336006535;
        const double a = (double)pos * inv; C.rope[i] = make_float2((float)cos(a), (float)sin(a)); }
}

template <int MODE, bool ADDY, bool OUT8 = false>
__device__ __forceinline__ void norm_phase(const Ctx& C, const float* gain, const float* W8, int ldw, int moe_layer, const float* aux0 = nullptr, const float* aux1 = nullptr) {
    const bf16* Y0 = (const bf16*)(C.R + R_Y0); const bf16* Y1 = (const bf16*)(C.R + R_Y1);
    const int lane = C.lane;
    float w8r[4][4][8];
    if (MODE != 3) {
#pragma unroll
        for (int j = 0; j < 4; ++j)
#pragma unroll
            for (int i = 0; i < 4; ++i) { const float* wp = W8 + (size_t)(256 * j + 4 * lane + i) * ldw; const f32x4 w0 = *(const f32x4*)wp, w1 = *(const f32x4*)(wp + 4);
                w8r[j][i][0] = w0[0]; w8r[j][i][1] = w0[1]; w8r[j][i][2] = w0[2]; w8r[j][i][3] = w0[3]; w8r[j][i][4] = w1[0]; w8r[j][i][5] = w1[1]; w8r[j][i][6] = w1[2]; w8r[j][i][7] = w1[3]; }
    }
    f32x4 gv[4];
#pragma unroll
    for (int j = 0; j < 4; ++j) gv[j] = ((const f32x4*)gain)[64 * j + C.lane];
    int prow = -1, pe = 0, pr1 = 0, pr2 = 0; float pg1 = 0.f;
#if H_BF16
    u32x2 hq[4], ya[4], yb[4];
#define NORM_ISSUE(row_) do { const HT* hr_ = C.H + (size_t)(row_) * D; _Pragma("unroll") for (int j = 0; j < 4; ++j) hq[j] = ((const u32x2*)hr_)[64 * j + C.lane]; \
        if (ADDY) { _Pragma("unroll") for (int j = 0; j < 4; ++j) { ya[j] = *(const u32x2*)(Y0 + (size_t)(row_) * D + 256 * j + 4 * C.lane); yb[j] = *(const u32x2*)(Y1 + (size_t)(row_) * D + 256 * j + 4 * C.lane); } } } while (0)
    if (C.gw < NT) NORM_ISSUE(C.gw);
#endif
    for (int row = C.gw; row < NT; row += C.ngw) {
        HT* hrow = C.H + (size_t)row * D;
        f32x4 v[4]; float ss = 0.f;
#if H_BF16
#pragma unroll
        for (int j = 0; j < 4; ++j) { v[j][0] = bflo(hq[j].x); v[j][1] = bfhi(hq[j].x); v[j][2] = bflo(hq[j].y); v[j][3] = bfhi(hq[j].y); }
        if (ADDY) {
#pragma unroll
            for (int j = 0; j < 4; ++j) { const u32x2 a = ya[j], b = yb[j];
                v[j][0] += bflo(a.x) + bflo(b.x); v[j][1] += bfhi(a.x) + bfhi(b.x); v[j][2] += bflo(a.y) + bflo(b.y); v[j][3] += bfhi(a.y) + bfhi(b.y);
                { u32x2 hv; hv.x = pk2(v[j][0], v[j][1]); hv.y = pk2(v[j][2], v[j][3]); ((u32x2*)hrow)[64 * j + C.lane] = hv; } }
        }
        if (row + C.ngw < NT) NORM_ISSUE(row + C.ngw);
#else
#pragma unroll
        for (int j = 0; j < 4; ++j) v[j] = ((const f32x4*)hrow)[64 * j + C.lane];
        if (ADDY) {
#pragma unroll
            for (int j = 0; j < 4; ++j) { const u32x2 a = *(const u32x2*)(Y0 + (size_t)row * D + 256 * j + 4 * C.lane), b = *(const u32x2*)(Y1 + (size_t)row * D + 256 * j + 4 * C.lane);
                v[j][0] += bflo(a.x) + bflo(b.x); v[j][1] += bfhi(a.x) + bfhi(b.x); v[j][2] += bflo(a.y) + bflo(b.y); v[j][3] += bfhi(a.y) + bfhi(b.y);
                ((f32x4*)hrow)[64 * j + C.lane] = v[j]; }
        }
#endif
#pragma unroll
        for (int j = 0; j < 4; ++j) ss += (v[j][0] * v[j][0] + v[j][1] * v[j][1]) + (v[j][2] * v[j][2] + v[j][3] * v[j][3]);
        const float rstd = 1.0f / sqrtf(wave_sum(ss) * (1.0f / D) + RMS_EPS);
#pragma unroll
        for (int j = 0; j < 4; ++j) { const f32x4 g = gv[j]; v[j] = v[j] * rstd * g;
            if (OUT8) *(unsigned*)(C.xn8 + (size_t)row * D + 256 * j + 4 * C.lane) = pg8::cvt4_fp8(v[j][0], v[j][1], v[j][2], v[j][3]);
            else { u32x2 o; o.x = pk2(v[j][0], v[j][1]); o.y = pk2(v[j][2], v[j][3]); *(u32x2*)(C.XN + (size_t)row * D + 256 * j + 4 * C.lane) = o; } }
        if (MODE != 3) {
            float dot[8];
#pragma unroll
            for (int e = 0; e < 8; ++e) dot[e] = 0.f;
#pragma unroll
            for (int j = 0; j < 4; ++j)
#pragma unroll
                for (int i = 0; i < 4; ++i) { const float y = v[j][i];
#pragma unroll
                    for (int e = 0; e < 8; ++e) dot[e] = fmaf(y, w8r[j][i][e], dot[e]); }
            float r4[4], r2[2], r1;
#pragma unroll
            for (int k = 0; k < 4; ++k) { const float send = (lane & 1) ? dot[k] : dot[4 + k], keep = (lane & 1) ? dot[4 + k] : dot[k]; r4[k] = keep + __shfl_xor(send, 1); }
#pragma unroll
            for (int k = 0; k < 2; ++k) { const float send = (lane & 2) ? r4[k] : r4[2 + k], keep = (lane & 2) ? r4[2 + k] : r4[k]; r2[k] = keep + __shfl_xor(send, 2); }
            { const float send = (lane & 4) ? r2[0] : r2[1], keep = (lane & 4) ? r2[1] : r2[0]; r1 = keep + __shfl_xor(send, 4); }
            r1 += __shfl_xor(r1, 8); r1 += __shfl_xor(r1, 16); r1 += __shfl_xor(r1, 32);
            const int ev = 4 * (lane & 1) + 2 * ((lane >> 1) & 1) + ((lane >> 2) & 1);
            if (MODE == 0) { if (lane < 8) C.sm8[(size_t)row * 8 + ev] = r1 * 0.03125f; }
            if (MODE == 1) {
                if (lane < 8) { const int b = row / SL, pos = row % SL, sl_ = pos / 65, si = pos % 65, h = ev & 3;
                    const float z = (r1 + (ev < 4 ? aux0[h] : aux1[h])) * (2.0f / 15.0f);
                    const float x = 15.0f * (1.0f - 2.0f / (1.0f + __expf(z)));
                    float* dst = (ev < 4 ? C.mli : C.mlg) + ((b * 4 + h) * 65 + si) * 64 + sl_;
                    *dst = (ev < 4) ? x : fminf(x, 0.f) - __logf(1.0f + __expf(-fabsf(x))); } }
            if (MODE == 2) {
#pragma unroll
                for (int e = 0; e < 8; ++e) dot[e] = __shfl(r1, (e >> 2) + 2 * ((e >> 1) & 1) + 4 * (e & 1));
                if (lane == 0) {
                    float v1 = dot[0]; int e1 = 0;
#pragma unroll
                    for (int e = 1; e < 8; ++e) if (dot[e] > v1) { v1 = dot[e]; e1 = e; }
                    float v2 = -INFINITY; int e2 = 0;
#pragma unroll
                    for (int e = 0; e < 8; ++e) if (e != e1 && dot[e] > v2) { v2 = dot[e]; e2 = e; }
                    const float g1 = 1.0f / (1.0f + expf(v2 - v1));
                    const int r1i = (int)atomicAdd(C.ctl + CW_CNT + (moe_layer * 8 + e1) * 64, 1u), r2i = (int)atomicAdd(C.ctl + CW_CNT + (moe_layer * 8 + e2) * 64, 1u);
                    if (prow >= 0) { C.route_e[prow] = pe; C.route_r1[prow] = pr1; C.route_r2[prow] = pr2; C.route_g1[prow] = pg1; }
                    prow = row; pe = e1 | (e2 << 8); pr1 = r1i; pr2 = r2i; pg1 = g1;
                }
            }
        }
    }
    if (MODE == 2) { if (lane == 0 && prow >= 0) { C.route_e[prow] = pe; C.route_r1[prow] = pr1; C.route_r2[prow] = pr2; C.route_g1[prow] = pg1; } }
#if H_BF16
#undef NORM_ISSUE
#endif
}

__device__ __forceinline__ void unpack8(const u32x4 w, float (&x)[8]) { x[0] = bflo(w.x); x[1] = bfhi(w.x); x[2] = bflo(w.y); x[3] = bfhi(w.y); x[4] = bflo(w.z); x[5] = bfhi(w.z); x[6] = bflo(w.w); x[7] = bfhi(w.w); }
__device__ __forceinline__ u32x4 pack8(const float (&x)[8]) { u32x4 w; w.x = pk2(x[0], x[1]); w.y = pk2(x[2], x[3]); w.z = pk2(x[4], x[5]); w.w = pk2(x[6], x[7]); return w; }
__device__ __forceinline__ void dsa_post_phase(const Ctx& C, const float* gq, const float* gk) {
    bf16* PROJ = (bf16*)(C.R + R_PROJ);
    for (int row = C.gw; row < NT; row += C.ngw) {
        const int pos = row % SL; bf16* pr = PROJ + (size_t)row * DSA_NP; const float2* rp = C.rope + (size_t)pos * 64;
        const int lane = C.lane;
#pragma unroll
        for (int pass = 0; pass < 2; ++pass) {
            if (pass == 1 && lane >= 16) break;
            const int head = lane >> 2, part = lane & 3; bf16* hp = pr + (pass == 0 ? DQ0 : DK0) + head * 64 + 8 * part; const float* gg = pass == 0 ? gq : gk;
            float x1[8], x2[8]; unpack8(*(const u32x4*)hp, x1); unpack8(*(const u32x4*)(hp + 32), x2);
            float ss = 0.f;
#pragma unroll
            for (int e = 0; e < 8; ++e) ss += x1[e] * x1[e] + x2[e] * x2[e];
            ss += __shfl_xor(ss, 1); ss += __shfl_xor(ss, 2);
            const float rstd = 1.0f / sqrtf(ss * (1.0f / 64.0f) + RMS_EPS), osc = pass == 0 ? 0.125f : 1.0f;
#pragma unroll
            for (int e = 0; e < 8; ++e) { const int i = 8 * part + e; const float2 cs = rp[2 * i];
                const float y1 = x1[e] * rstd * gg[i], y2 = x2[e] * rstd * gg[i + 32];
                x1[e] = (y1 * cs.x - y2 * cs.y) * osc; x2[e] = (y2 * cs.x + y1 * cs.y) * osc; }
            *(u32x4*)hp = pack8(x1); *(u32x4*)(hp + 32) = pack8(x2);
        }
#pragma unroll
        for (int pass = 0; pass < 2; ++pass) {
            if (pass == 1 && lane >= 8) break;
            const int head = lane >> 3, part = lane & 7; bf16* hp = pr + (pass == 0 ? DIQ0 + head * 128 : DIK0) + 8 * part;
            float x1[8], x2[8]; unpack8(*(const u32x4*)hp, x1); unpack8(*(const u32x4*)(hp + 64), x2);
#pragma unroll
            for (int e = 0; e < 8; ++e) { const float2 cs = rp[8 * part + e]; const float y1 = x1[e], y2 = x2[e];
                x1[e] = y1 * cs.x - y2 * cs.y; x2[e] = y2 * cs.x + y1 * cs.y; }
            *(u32x4*)hp = pack8(x1); *(u32x4*)(hp + 64) = pack8(x2);
        }
    }
}
__device__ __forceinline__ void score_phase(const Ctx& C) {
    const bf16* PROJ = (const bf16*)(C.R + R_PROJ); float* SC = (float*)(C.R + R_SC);
    const int lane = C.lane, m31 = lane & 31, hi = lane >> 5, w = C.wave;
    const int aq = 2 * (m31 >> 4) + ((m31 >> 2) & 1), ah = 4 * ((m31 >> 3) & 1) + (m31 & 3);
    constexpr int SCP = 1088, SCB = 8 * SCP;
    LAS unsigned char* ring = C.lds;
    const LAS unsigned char* bfp = ring + (m31 >> 2) * SCP + 64 * hi + 16 * (m31 & 3);
    constexpr int TPB = 65 + 57 + 49 + 41 + 33 + 25 + 17 + 9 + 1;
    for (int t = C.bid; t < BATCH * TPB; t += C.G) {
        const int b = t / TPB, tt = t % TPB;
        const int kc = (tt >= 65) + (tt >= 122) + (tt >= 171) + (tt >= 212) + (tt >= 245) + (tt >= 270) + (tt >= 287) + (tt >= 296);
        const int toff = 65 * kc - 4 * kc * (kc - 1);
        const int qg = 64 * kc + 8 * (tt - toff) + w; const bool act = qg < 514;
        const int qgc = act ? qg : 513, q0 = 8 * qgc, k0 = 512 * kc;
        const int qlast = 64 * kc + 8 * (tt - toff) + 7, qmax = (qlast < 514 ? qlast : 513) * 8 + 8;
        const int kendw = (k0 + 512 < q0 + 8) ? k0 + 512 : q0 + 8;
        const int kendg = (k0 + 512 < qmax) ? k0 + 512 : qmax;
        const int nkt = (kendg - k0 + 31) >> 5, nktw = act ? (kendw - k0 + 31) >> 5 : 0;
        bf16x8 a[2][8]; f32x4 wv[2][4];
#pragma unroll
        for (int rb = 0; rb < 2; ++rb) {
            const bf16* ap = PROJ + (size_t)(b * SL + q0 + 4 * rb + aq) * DSA_NP + DIQ0 + ah * 128 + 8 * hi;
#pragma unroll
            for (int ks = 0; ks < 8; ++ks) a[rb][ks] = *(const bf16x8*)(ap + 16 * ks);
            const float* w0 = C.sm8 + (size_t)(b * SL + q0 + 4 * rb + hi) * 8; const float* w1 = w0 + 16;
            wv[rb][0] = *(const f32x4*)w0; wv[rb][1] = *(const f32x4*)(w0 + 4); wv[rb][2] = *(const f32x4*)w1; wv[rb][3] = *(const f32x4*)(w1 + 4);
        }
        float* sc0 = SC + (size_t)(b * SL + q0 + hi) * SCLD;
        const bf16* ikb = PROJ + (size_t)b * SL * DSA_NP + DIK0 + (lane >> 2) * 8;
        const int kr0 = k0 + 4 * w + (lane & 3);
#define SC_ISSUE(kt_) do { if ((kt_) < nkt) { const int key_ = kr0 + 32 * (kt_), kc_ = key_ < SL ? key_ : SL - 1; \
            __builtin_amdgcn_global_load_lds((const unsigned*)(ikb + (size_t)kc_ * DSA_NP), (LAS unsigned*)(ring + ((kt_) & 3) * SCB + w * SCP), 16, 0, 0); } } while (0)
        asm volatile("s_waitcnt vmcnt(0)" ::: "memory");
#pragma unroll
        for (int rb = 0; rb < 2; ++rb) {
#pragma unroll
            for (int ks = 0; ks < 8; ++ks) asm volatile("" : "+v"(a[rb][ks]));
#pragma unroll
            for (int q = 0; q < 4; ++q) asm volatile("" : "+v"(wv[rb][q])); }
        __builtin_amdgcn_s_barrier();
        SC_ISSUE(0); SC_ISSUE(1); SC_ISSUE(2);
        float* dum = SC + (size_t)NT * SCLD + 4 * C.tid;
        for (int kt = 0; kt < nkt; ++kt) {
            { const int cnt = 4 * (kt < 3 ? kt : 3) + (kt + 1 < nkt) + (kt + 2 < nkt);
              switch (cnt) { case 0: asm volatile("s_waitcnt vmcnt(0)" ::: "memory"); break; case 1: asm volatile("s_waitcnt vmcnt(1)" ::: "memory"); break; case 2: asm volatile("s_waitcnt vmcnt(2)" ::: "memory"); break;
                case 4: asm volatile("s_waitcnt vmcnt(4)" ::: "memory"); break; case 5: asm volatile("s_waitcnt vmcnt(5)" ::: "memory"); break; case 6: asm volatile("s_waitcnt vmcnt(6)" ::: "memory"); break;
                case 8: asm volatile("s_waitcnt vmcnt(8)" ::: "memory"); break; case 9: asm volatile("s_waitcnt vmcnt(9)" ::: "memory"); break; case 10: asm volatile("s_waitcnt vmcnt(10)" ::: "memory"); break;
                case 12: asm volatile("s_waitcnt vmcnt(12)" ::: "memory"); break; case 13: asm volatile("s_waitcnt vmcnt(13)" ::: "memory"); break; default: asm volatile("s_waitcnt vmcnt(14)" ::: "memory"); break; } }
            __builtin_amdgcn_s_barrier();
            asm volatile("" ::: "memory");
            SC_ISSUE(kt + 3);
            asm volatile("" ::: "memory");
            const int key = k0 + 32 * kt + m31;
            float v00 = 0.f, v01 = 0.f, v10 = 0.f, v11 = 0.f;
            if (kt < nktw) {
                const LAS unsigned char* bp = bfp + (kt & 3) * SCB;
                bf16x8 bf_[8];
#pragma unroll
                for (int ks = 0; ks < 8; ++ks) bf_[ks] = *(const LAS bf16x8*)(bp + 128 * ks);
                asm volatile("s_waitcnt lgkmcnt(0)" ::: "memory");
                f32x16 acc0, acc1;
#pragma unroll
                for (int r = 0; r < 16; ++r) { acc0[r] = 0.f; acc1[r] = 0.f; }
#pragma unroll
                for (int ks = 0; ks < 8; ++ks) { acc0 = MFMA32(a[0][ks], bf_[ks], acc0); acc1 = MFMA32(a[1][ks], bf_[ks], acc1); }
#pragma unroll
                for (int e = 0; e < 8; ++e) { v00 = fmaf(fmaxf(acc0[e], 0.f), wv[0][e >> 2][e & 3], v00); v01 = fmaf(fmaxf(acc0[8 + e], 0.f), wv[0][2 + (e >> 2)][e & 3], v01);
                    v10 = fmaf(fmaxf(acc1[e], 0.f), wv[1][e >> 2][e & 3], v10); v11 = fmaf(fmaxf(acc1[8 + e], 0.f), wv[1][2 + (e >> 2)][e & 3], v11); }
            }
            const bool okst = kt < nktw && key < kendw;
            float* p0 = okst ? sc0 + key : dum; float* p1 = okst ? sc0 + (size_t)2 * SCLD + key : dum + 1; float* p2 = okst ? sc0 + (size_t)4 * SCLD + key : dum + 2; float* p3 = okst ? sc0 + (size_t)6 * SCLD + key : dum + 3;
            asm volatile("" ::: "memory");
            __builtin_nontemporal_store(v00, p0); __builtin_nontemporal_store(v01, p1); __builtin_nontemporal_store(v10, p2); __builtin_nontemporal_store(v11, p3);
            asm volatile("" ::: "memory");
        }
#undef SC_ISSUE
    }
}

template <int NR>
__device__ __forceinline__ void topk_keys(const float* sr, unsigned (&k)[NR], int n, int lane) {
    float v[NR];
#pragma unroll
    for (int j = 0; j < NR; ++j) { const int idx = 64 * j + lane; v[j] = __builtin_nontemporal_load(sr + (idx < n ? idx : n - 1)); }
#pragma unroll
    for (int j = 0; j < NR; ++j) { const int idx = 64 * j + lane; const unsigned u = __float_as_uint(v[j] + 0.0f); const unsigned key = (u & 0x80000000u) ? ~u : (u | 0x80000000u);
        k[j] = idx < n ? key : 0u; }
}
constexpr int TOPK_MID_BIT = -1, TOPK_MID_NR = 40;
template <int NR, class Mid>
__device__ __forceinline__ void topk_select(const unsigned (&k)[NR], unsigned short* sel, int lane, Mid mid) {
    unsigned T = 0u; bool exact = false;
    for (int bit = 31; bit >= 0; --bit) {
        if (bit == TOPK_MID_BIT) mid();
        const unsigned cand = T | (1u << bit); int cl = 0;
#define TK_CA(n_) "v_cmp_ge_u32 vcc, %" #n_ ", %1\n\tv_addc_co_u32 %0, vcc, 0, %0, vcc\n\t"
#pragma unroll
        for (int j = 0; j + 8 <= NR; j += 8)
            asm(TK_CA(2) TK_CA(3) TK_CA(4) TK_CA(5) TK_CA(6) TK_CA(7) TK_CA(8) TK_CA(9) : "+v"(cl) : "v"(cand), "v"(k[j]), "v"(k[j + 1]), "v"(k[j + 2]), "v"(k[j + 3]), "v"(k[j + 4]), "v"(k[j + 5]), "v"(k[j + 6]), "v"(k[j + 7]) : "vcc");
#pragma unroll
        for (int j = NR & ~7; j < NR; ++j) asm("v_cmp_ge_u32 vcc, %1, %2\n\tv_addc_co_u32 %0, vcc, 0, %0, vcc" : "+v"(cl) : "v"(k[j]), "v"(cand) : "vcc");
#undef TK_CA
        int cnt = 0;
#pragma unroll
        for (int bb = 0; bb < 7; ++bb) cnt += __popcll(__ballot((cl >> bb) & 1)) << bb;
        if (cnt >= 256) { T = cand; if (cnt == 256) { exact = true; break; } }
    }
    int base = 0;
#pragma unroll
    for (int j = 0; j < NR; ++j) { const bool f = exact ? (k[j] >= T) : (k[j] > T); const unsigned long long mk = __ballot(f);
        if (f) sel[base + __builtin_amdgcn_mbcnt_hi((unsigned)(mk >> 32), __builtin_amdgcn_mbcnt_lo((unsigned)mk, 0u))] = (unsigned short)(64 * j + lane);
        base += __popcll(mk); }
    if (!exact) {
#pragma unroll
        for (int j = 0; j < NR; ++j) { const bool f = (k[j] == T); const unsigned long long mk = __ballot(f);
            const int p = base + (int)__builtin_amdgcn_mbcnt_hi((unsigned)(mk >> 32), __builtin_amdgcn_mbcnt_lo((unsigned)mk, 0u));
            if (f && p < 256) sel[p] = (unsigned short)(64 * j + lane);
            base += __popcll(mk); }
    }
}
__device__ __forceinline__ int conv_m_of(int q, int j) { return q < 3 ? 2 * q + j : q < 11 ? 6 + 8 * j + (q - 3) : q < 19 ? 22 + 8 * j + (q - 11) : 38 + 8 * j + (q - 19); }
template <bool CONV>
__device__ __forceinline__ void topk_phase_t(const Ctx& C, KArgP P, int j) {
    const float* SC = (const float*)(C.R + R_SC);
    LAS unsigned char* tile0 = C.lds + C.wave * (2 * CONV_TILE); LAS unsigned char* tile1 = tile0 + CONV_TILE;
    constexpr int pcount = CONV ? 27 * (CONV_IB / 2) : 0;
    int cit = C.gw; const int cs = C.ngw; bool pend = false;
    auto pair_desc = [&](int p, ConvD& d0, ConvD& d1) -> bool { const int m = conv_m_of(p / (CONV_IB / 2), j), rp = p % (CONV_IB / 2); const bool isdn = (m >= 4 && m < 6) || m >= 38;
        const int nblk = isdn ? D / 32 : FF / 32, kb2 = rp / nblk, nb = rp - kb2 * nblk, r0 = 2 * kb2 * nblk + nb;
        const bool g = conv_desc(C, P, m, r0, d0); conv_desc(C, P, m, r0 + nblk, d1); return g; };
    auto issue = [&](int lane) { if (CONV && cit < pcount) { ConvD d0, d1; const bool g = pair_desc(cit, d0, d1); conv_dma_issue(d0, g, lane, tile0); conv_dma_issue(d1, g, lane, tile1); pend = true; } };
    auto finish = [&](int lane) { if (CONV && pend) { ConvD d0, d1; pair_desc(cit, d0, d1);
                                      asm volatile("s_waitcnt vmcnt(0)" ::: "memory"); conv_dma_finish(d0, tile0, lane); conv_dma_finish(d1, tile1, lane); cit += cs; pend = false; } };
    for (int rr = C.gw; rr < NT; rr += C.ngw) { const int row = NT - 1 - rr;
        int lane = C.lane; asm volatile("" : "+v"(lane));
        const int pos = row % SL, n = pos + 1;
        unsigned short* sel = C.sel + (size_t)row * 256;
        if (n <= 256) {
            u32x2 o; o.x = (unsigned)(4 * lane) | ((unsigned)(4 * lane + 1) << 16); o.y = (unsigned)(4 * lane + 2) | ((unsigned)(4 * lane + 3) << 16);
            *(u32x2*)(sel + 4 * lane) = o;
            continue;
        }
        const float* sr = SC + (size_t)row * SCLD;
        const int nr8 = (n + 511) >> 9;
#define TOPK_CASE(NR) { unsigned k[NR]; topk_keys<NR>(sr, k, n, lane); _Pragma("unroll") for (int q_ = 0; q_ < NR; ++q_) asm volatile("" : "+v"(k[q_]) :: "memory");   \
            issue(lane); topk_select<NR>(k, sel, lane, [&]() { if (NR >= TOPK_MID_NR) { finish(lane); issue(lane); } }); }
        switch (nr8) {
            case 1: TOPK_CASE(8) break;   case 2: TOPK_CASE(16) break; case 3: TOPK_CASE(24) break;
            case 4: TOPK_CASE(32) break;  case 5: TOPK_CASE(40) break; case 6: TOPK_CASE(48) break;
            case 7: TOPK_CASE(56) break;  case 8: TOPK_CASE(64) break; default: TOPK_CASE(65) break;
        }
#undef TOPK_CASE
        finish(lane);
    }
    while (CONV && cit < pcount) { int lane = C.lane; asm volatile("" : "+v"(lane)); issue(lane); finish(lane); }
}
__device__ __forceinline__ void topk_phase(const Ctx& C, KArgP P, int j) {
    if (CONV_IN_PROLOGUE) topk_phase_t<false>(C, P, j); else topk_phase_t<true>(C, P, j);
}

constexpr int ATT_VROW = 544, ATT_WAVE_LDS = 32 * ATT_VROW + 512;
__device__ __forceinline__ s16x4 tr16(const LAS unsigned char* p) { return __builtin_bit_cast(s16x4, __builtin_amdgcn_ds_read_tr16_b64_v4i16((LAS s16x4*)p)); }
constexpr int AT_PITCH = 1088, AT_BUF = 8 * AT_PITCH;
template <bool OUT8>
__device__ __forceinline__ void attn2b_phase(const Ctx& C, bf16* OUT) {
    const bf16* PROJ = (const bf16*)(C.R + R_PROJ);
    const int lane = C.lane, n15 = lane & 15, kq = lane >> 4, g = n15 >> 2, oo = lane & 1, chh = lane >> 1;
    LAS unsigned char* wb = C.lds + C.wave * ATT_WAVE_LDS;
    LAS unsigned short* selE = (LAS unsigned short*)(wb + 2 * AT_BUF); LAS unsigned short* selO = selE + 128;
    static_assert(2 * AT_BUF + 512 <= ATT_WAVE_LDS, "attention LDS");
    int b0, nbat, wv, nwv;
    if ((C.G & 7) == 0) { b0 = (C.bid & 7) >> 1; nbat = 1; wv = ((C.bid >> 3) * 2 + (C.bid & 1)) * NWAVES + C.wave; nwv = (C.G >> 2) * NWAVES; }
    else { b0 = 0; nbat = BATCH; wv = C.gw; nwv = C.ngw; }
    for (int bi = 0; bi < nbat; ++bi) { const int b = b0 + bi;
    for (int pos = wv; pos < SL; pos += nwv) {
        const int row = b * SL + pos, nk = pos + 1 < 256 ? pos + 1 : 256, ng = (nk + 15) >> 4, ntile = 2 * ng;
        const bf16* kvb = PROJ + (size_t)b * SL * DSA_NP;
        { const u32x2 sv = *(const u32x2*)(C.sel + (size_t)row * 256 + 4 * lane);
          const unsigned s0 = (4 * lane < nk) ? (sv.x & 0xffffu) : 0u, s1 = (4 * lane + 1 < nk) ? (sv.x >> 16) : 0u, s2 = (4 * lane + 2 < nk) ? (sv.y & 0xffffu) : 0u, s3 = (4 * lane + 3 < nk) ? (sv.y >> 16) : 0u;
          asm volatile("" ::: "memory");
          selE[2 * lane] = (unsigned short)s0; selE[2 * lane + 1] = (unsigned short)s2; selO[2 * lane] = (unsigned short)s1; selO[2 * lane + 1] = (unsigned short)s3; }
        bf16x8 qf[8];
        { const bf16* qp = PROJ + (size_t)row * DSA_NP + DQ0 + n15 * 64 + 8 * kq; const bf16x8 q0 = *(const bf16x8*)qp, q1 = *(const bf16x8*)(qp + 32);
          const bf16x8 z = (bf16x8){0, 0, 0, 0, 0, 0, 0, 0};
#pragma unroll
          for (int ks = 0; ks < 8; ++ks) qf[ks] = ((ks >> 1) == g) ? ((ks & 1) ? q1 : q0) : z; }
        asm volatile("s_waitcnt vmcnt(0) lgkmcnt(0)" ::: "memory");
#pragma unroll
        for (int ks = 0; ks < 8; ++ks) asm volatile("" : "+v"(qf[ks]));
#define AT_ISSUE(i_, bo_) do { const int ii_ = (i_); const int gi_ = ii_ < ng ? ii_ : ii_ - ng; const int c0_ = ii_ < ng ? DK0 : DV0; \
            const u32x4 k8_ = *(const LAS u32x4*)((oo ? selO : selE) + 8 * gi_); const bf16* gb_ = kvb + c0_ + chh * 8; LAS unsigned char* db_ = wb + (bo_); \
            __builtin_amdgcn_global_load_lds((const unsigned*)(gb_ + (size_t)(k8_.x & 0xffffu) * DSA_NP), (LAS unsigned*)(db_ + 0 * AT_PITCH), 16, 0, 0); \
            __builtin_amdgcn_global_load_lds((const unsigned*)(gb_ + (size_t)(k8_.x >> 16) * DSA_NP), (LAS unsigned*)(db_ + 1 * AT_PITCH), 16, 0, 0); \
            __builtin_amdgcn_global_load_lds((const unsigned*)(gb_ + (size_t)(k8_.y & 0xffffu) * DSA_NP), (LAS unsigned*)(db_ + 2 * AT_PITCH), 16, 0, 0); \
            __builtin_amdgcn_global_load_lds((const unsigned*)(gb_ + (size_t)(k8_.y >> 16) * DSA_NP), (LAS unsigned*)(db_ + 3 * AT_PITCH), 16, 0, 0); \
            __builtin_amdgcn_global_load_lds((const unsigned*)(gb_ + (size_t)(k8_.z & 0xffffu) * DSA_NP), (LAS unsigned*)(db_ + 4 * AT_PITCH), 16, 0, 0); \
            __builtin_amdgcn_global_load_lds((const unsigned*)(gb_ + (size_t)(k8_.z >> 16) * DSA_NP), (LAS unsigned*)(db_ + 5 * AT_PITCH), 16, 0, 0); \
            __builtin_amdgcn_global_load_lds((const unsigned*)(gb_ + (size_t)(k8_.w & 0xffffu) * DSA_NP), (LAS unsigned*)(db_ + 6 * AT_PITCH), 16, 0, 0); \
            __builtin_amdgcn_global_load_lds((const unsigned*)(gb_ + (size_t)(k8_.w >> 16) * DSA_NP), (LAS unsigned*)(db_ + 7 * AT_PITCH), 16, 0, 0); } while (0)
#define AT_WAIT(i_) do { if ((i_) + 1 < ntile) asm volatile("s_waitcnt vmcnt(8)" ::: "memory"); else asm volatile("s_waitcnt vmcnt(0)" ::: "memory"); } while (0)
        AT_ISSUE(0, 0); AT_ISSUE(1, AT_BUF);
        f32x4 lg[16];
        const LAS unsigned char* kfp = wb + (n15 >> 1) * AT_PITCH + 32 * kq + 16 * (n15 & 1);
#pragma unroll
        for (int G = 0; G < 16; ++G) {
            f32x4 acc = (f32x4){0.f, 0.f, 0.f, 0.f};
            if (G < ng) {
                AT_WAIT(G);
                bf16x8 af[8];
#pragma unroll
                for (int ks = 0; ks < 8; ++ks) af[ks] = *(const LAS bf16x8*)(kfp + (G & 1) * AT_BUF + 128 * ks);
                asm volatile("s_waitcnt lgkmcnt(0)" ::: "memory");
                if (G + 2 < ntile) AT_ISSUE(G + 2, (G & 1) * AT_BUF);
#pragma unroll
                for (int ks = 0; ks < 8; ++ks) acc = MFMA16(af[ks], qf[ks], acc);
            }
#pragma unroll
            for (int i = 0; i < 4; ++i) lg[G][i] = (16 * G + 4 * kq + i < nk) ? acc[i] : -INFINITY;
        }
        float mx = -INFINITY;
#pragma unroll
        for (int G = 0; G < 16; ++G) mx = fmaxf(fmaxf(fmaxf(lg[G][0], lg[G][1]), fmaxf(lg[G][2], lg[G][3])), mx);
        mx = fmaxf(mx, __shfl_xor(mx, 16)); mx = fmaxf(mx, __shfl_xor(mx, 32));
        float sum = 0.f;
#pragma unroll
        for (int G = 0; G < 16; ++G)
#pragma unroll
            for (int i = 0; i < 4; ++i) { const float p = __expf(lg[G][i] - mx); lg[G][i] = p; sum += p; }
        sum += __shfl_xor(sum, 16); sum += __shfl_xor(sum, 32);
        f32x4 O[16];
#pragma unroll
        for (int nb = 0; nb < 16; ++nb) O[nb] = (f32x4){0.f, 0.f, 0.f, 0.f};
        const int vr = 4 * kq + (n15 >> 2);
        const LAS unsigned char* vfp = wb + (vr >> 1) * AT_PITCH + 16 * (vr & 1) + 32 * ((lane & 3) >> 1) + 8 * (lane & 1);
#pragma unroll
        for (int G = 0; G < 16; ++G) {
            if (G < ng) {
                const int ti = ng + G, bo = (ti & 1) * AT_BUF;
                AT_WAIT(ti);
                u32x2 pw; pw.x = pk2(lg[G][0], lg[G][1]); pw.y = pk2(lg[G][2], lg[G][3]);
                const s16x4 pa = __builtin_bit_cast(s16x4, pw);
                s16x4 vf[16];
#pragma unroll
                for (int nb = 0; nb < 16; ++nb) vf[nb] = tr16(vfp + bo + 64 * nb);
                asm volatile("s_waitcnt lgkmcnt(0)" ::: "memory");
                if (ti + 2 < ntile) AT_ISSUE(ti + 2, bo);
#pragma unroll
                for (int nb = 0; nb < 16; ++nb) O[nb] = __builtin_amdgcn_mfma_f32_16x16x16bf16_1k(pa, vf[nb], O[nb], 0, 0, 0);
            }
        }
#undef AT_ISSUE
#undef AT_WAIT
        bf16* orow = OUT + (size_t)row * D; unsigned char* orow8 = (unsigned char*)OUT + (size_t)row * D;
        float inv[4];
#pragma unroll
        for (int i = 0; i < 4; ++i) inv[i] = 1.0f / __shfl(sum, 4 * kq + i);
#pragma unroll
        for (int x = 0; x < 4; ++x) {
            const f32x4 o = (kq == 0) ? O[x] : (kq == 1) ? O[4 + x] : (kq == 2) ? O[8 + x] : O[12 + x];
#pragma unroll
            for (int i = 0; i < 4; ++i) { if (OUT8) orow8[(4 * kq + i) * 64 + 16 * x + n15] = (unsigned char)(pg8::cvt4_fp8(o[i] * inv[i] * SA_ATT, 0.f, 0.f, 0.f) & 0xffu);
                                          else orow[(4 * kq + i) * 64 + 16 * x + n15] = (bf16)(pk2(o[i] * inv[i], 0.f) & 0xffffu); }
        }
    } }
}
__device__ __forceinline__ int ml_start(int c) { return c == 0 ? 0 : 16 + 256 * (c - 1); }
__device__ __forceinline__ int ml_len(int c) { return c == 0 ? 16 : 256; }
template <bool ISMAX> __device__ __forceinline__ float wave_scan_incl(float v, int lane) {
#pragma unroll
    for (int d = 1; d < 64; d <<= 1) { const float t = __shfl_up(v, d); if (lane >= d) v = ISMAX ? fmaxf(v, t) : v + t; }
    return v; }
__device__ __forceinline__ void ml_scan_phase(const Ctx& C) {
    if (C.gw >= 16) return;
    const int bh = C.gw, lane = C.lane, p0 = 65 * lane;
    float* F = C.mlf + bh * SL; float* Cc = C.mlc + bh * SL; float* Pp = C.mlp + bh * SL;
    float li[65], lf[65];
#pragma unroll
    for (int i = 0; i < 65; ++i) { const bool ok = p0 + i < SL; li[i] = ok ? C.mli[(bh * 65 + i) * 64 + lane] : -INFINITY; lf[i] = ok ? C.mlg[(bh * 65 + i) * 64 + lane] : 0.f; }
    float s = 0.f;
#pragma unroll
    for (int i = 0; i < 65; ++i) s += lf[i];
    float run = wave_scan_incl<false>(s, lane) - s, mx = -INFINITY;
#pragma unroll
    for (int i = 0; i < 65; ++i) { run += lf[i]; lf[i] = run; li[i] = li[i] - run; mx = fmaxf(mx, li[i]); }
    const float inc = wave_scan_incl<true>(mx, lane); float pm = __shfl_up(inc, 1); if (lane == 0) pm = -INFINITY;
    LAS float* T = (LAS float*)(C.lds + C.wave * 16640);
#define ML_SCAN_OUT(dst_) do { asm volatile("s_waitcnt lgkmcnt(0)" ::: "memory"); \
        _Pragma("unroll") for (int t = 0; t < 65; ++t) { const float x_ = T[64 * t + lane]; if (64 * t + lane < SL) (dst_)[64 * t + lane] = x_; } \
        asm volatile("s_waitcnt lgkmcnt(0)" ::: "memory"); } while (0)
#pragma unroll
    for (int i = 0; i < 65; ++i) T[p0 + i] = lf[i];
    ML_SCAN_OUT(F);
#pragma unroll
    for (int i = 0; i < 65; ++i) T[p0 + i] = li[i];
    ML_SCAN_OUT(Cc);
#pragma unroll
    for (int i = 0; i < 65; ++i) { pm = fmaxf(pm, li[i]); T[p0 + i] = pm; }
    ML_SCAN_OUT(Pp);
#undef ML_SCAN_OUT
}
constexpr int TP = 40;
__device__ __forceinline__ void stage_T(const Ctx& C, LAS bf16* T, const bf16* src, int ld, int ncol, int row0tok, int s0, int nvalid, const float* cvals, float pend, float kscale) {
    const int nchunk = 32 * (ncol / 8);
    for (int id = C.tid; id < nchunk; id += NTHREADS) {
        const int s = id & 31, dc = id >> 5; const int sl_ = s0 + s; const bool ok = sl_ < nvalid; const int sc = ok ? sl_ : nvalid - 1;
        float x[8]; unpack8(*(const u32x4*)(src + (size_t)(row0tok + sc) * ld + 8 * dc), x);
        float w = ok ? 1.0f : 0.0f; if (cvals) w = ok ? __expf(cvals[sc] - pend) * kscale : 0.0f;
#pragma unroll
        for (int e = 0; e < 8; ++e) T[(8 * dc + e) * TP + s] = (bf16)(pk2(x[e] * w, 0.f) & 0xffffu);
    }
}
__device__ __forceinline__ void ml_dc_phase(const Ctx& C) {
    const bf16* PROJ = (const bf16*)(C.R + R_PROJ); float* DC = (float*)(C.R + R_DC);
    LAS bf16* KT = (LAS bf16*)C.lds; LAS bf16* VT = KT + 128 * TP;
    const int lane = C.lane, m31 = lane & 31, hi = lane >> 5, w = C.wave;
    for (int task = C.bid; task < 256; task += C.G) {
        const int bh = task >> 4, c = task & 15, b = bh >> 2, h = bh & 3, start = ml_start(c), n = ml_len(c), tok0 = b * SL + start;
        const float pend = C.mlp[bh * SL + start + n - 1];
        f32x16 acc[4];
#pragma unroll
        for (int nb = 0; nb < 4; ++nb)
#pragma unroll
            for (int r = 0; r < 16; ++r) acc[nb][r] = 0.f;
        float dn = 0.f;
        for (int s0 = 0; s0 < n; s0 += 32) {
            stage_T(C, KT, PROJ + MK0 + h * 128, ML_NP, 128, tok0, s0, n, C.mlc + bh * SL + start, pend, 0.08838834764831845f);
            stage_T(C, VT, PROJ + MV0 + h * 256, ML_NP, 256, tok0, s0, n, nullptr, 0.f, 1.f);
            __syncthreads();
#pragma unroll
            for (int ks = 0; ks < 2; ++ks) { const bf16x8 a = *(const LAS bf16x8*)(VT + (32 * w + m31) * TP + 16 * ks + 8 * hi);
#pragma unroll
                for (int nb = 0; nb < 4; ++nb) acc[nb] = MFMA32(a, *(const LAS bf16x8*)(KT + (32 * nb + m31) * TP + 16 * ks + 8 * hi), acc[nb]); }
            if (C.tid < 128) {
#pragma unroll
                for (int q = 0; q < 4; ++q) { float x[8]; unpack8(*(const LAS u32x4*)(KT + C.tid * TP + 8 * q), x);
#pragma unroll
                    for (int e = 0; e < 8; ++e) dn += x[e]; } }
            __syncthreads();
        }
        float* dc = DC + (size_t)(bh * 16 + c) * 256 * 128;
#pragma unroll
        for (int nb = 0; nb < 4; ++nb)
#pragma unroll
            for (int r = 0; r < 16; ++r) dc[(size_t)(32 * w + crow(r, hi)) * 128 + 32 * nb + m31] = acc[nb][r];
        if (C.tid < 128) C.dn[(bh * 16 + c) * 128 + C.tid] = dn;
    }
}
__device__ __forceinline__ void ml_state_phase(const Ctx& C) {
    const float* DC = (const float*)(C.R + R_DC); bf16* CH = (bf16*)(C.R + R_CH);
    const int gt = C.bid * NTHREADS + C.tid, ngt = C.G * NTHREADS;
    for (int i = gt; i < 16 * 8192 + 16 * 128; i += ngt) {
        const bool isn = i >= 16 * 8192; const int ii = isn ? i - 16 * 8192 : i; const int bh = isn ? ii >> 7 : ii >> 13, off = isn ? (ii & 127) : 4 * (ii & 8191);
        f32x4 dcv[16]; float pe[16];
#pragma unroll
        for (int c = 0; c < 16; ++c) { pe[c] = C.mlp[bh * SL + ml_start(c) + ml_len(c) - 1];
            if (isn) { dcv[c] = (f32x4){C.dn[(bh * 16 + c) * 128 + off], 0.f, 0.f, 0.f}; } else dcv[c] = *(const f32x4*)(DC + (size_t)(bh * 16 + c) * 32768 + off); }
        f32x4 st = (f32x4){0.f, 0.f, 0.f, 0.f}; float pprev = 0.f;
#pragma unroll
        for (int c = 0; c < 16; ++c) {
            const float pend = pe[c];
            const float decay = (c == 0) ? 0.f : __expf(pprev - pend); pprev = pend;
            st = decay * st + dcv[c];
            if (isn) C.nh[(bh * 16 + c) * 128 + off] = st[0];
            else { u32x2 o; o.x = pk2(st[0], st[1]); o.y = pk2(st[2], st[3]); *(u32x2*)(CH + (size_t)(bh * 16 + c) * 32768 + off) = o; }
        }
    }
}
constexpr int MLP_ = 136;
__device__ __forceinline__ void ml_out_phase(const Ctx& C, const float* gout) {
    const bf16* PROJ = (const bf16*)(C.R + R_PROJ); const bf16* CH = (const bf16*)(C.R + R_CH);
    LAS bf16* VT = (LAS bf16*)C.lds; LAS bf16* KL = VT + 256 * TP; LAS float* CV = (LAS float*)(KL + 32 * MLP_); LAS bf16* CHL = (LAS bf16*)(CV + 32);
    const int w = C.wave;
    for (int task = C.bid; task < 272; task += C.G) {
        int lane = C.lane, tid = C.tid; asm volatile("" : "+v"(lane), "+v"(tid));
        const int m31 = lane & 31, hi = lane >> 5;
        const int bh = task < 256 ? task >> 4 : task - 256, c = task < 256 ? 1 + (task & 15) : 0;
        const int b = bh >> 2, h = bh & 3, start = ml_start(c), n = ml_len(c), tok0 = b * SL + start;
        const int tl = 32 * w + m31, tlc = tl < n ? tl : n - 1; const bool wact = 32 * w < n;
        const float Pt = C.mlp[bh * SL + start + tlc];
        const bf16* qp = PROJ + (size_t)(tok0 + tlc) * ML_NP + MQ0 + h * 128 + 8 * hi;
        const int nst = (n + 31) >> 5;
        const int vs = tid & 31, vd0 = tid >> 5, ks_ = tid >> 4, kc_ = tid & 15;
        u32x4 rv0, rv1, rk; float rc = 0.f;
#define ML_LOAD(st_) do { const int s0_ = 32 * (st_); const int a_ = s0_ + vs < n ? s0_ + vs : n - 1, k_ = s0_ + ks_ < n ? s0_ + ks_ : n - 1; \
            const bf16* vp_ = PROJ + (size_t)(tok0 + a_) * ML_NP + MV0 + h * 256 + 8 * vd0; rv0 = *(const u32x4*)vp_; rv1 = *(const u32x4*)(vp_ + 128); \
            rk = *(const u32x4*)(PROJ + (size_t)(tok0 + k_) * ML_NP + MK0 + h * 128 + 8 * kc_); \
            if (tid < 32) rc = C.mlc[bh * SL + start + (s0_ + tid < n ? s0_ + tid : n - 1)]; } while (0)
#define ML_WRITE(st_) do { const int s0_ = 32 * (st_); const bool ok_ = s0_ + vs < n; float x_[8]; unpack8(rv0, x_); \
            _Pragma("unroll") for (int e = 0; e < 8; ++e) VT[(8 * vd0 + e) * TP + vs] = ok_ ? (bf16)(pk2(x_[e], 0.f) & 0xffffu) : (bf16)0; \
            unpack8(rv1, x_); _Pragma("unroll") for (int e = 0; e < 8; ++e) VT[(8 * (vd0 + 16) + e) * TP + vs] = ok_ ? (bf16)(pk2(x_[e], 0.f) & 0xffffu) : (bf16)0; \
            *(LAS u32x4*)(KL + ks_ * MLP_ + 8 * kc_) = rk; if (tid < 32) CV[tid] = rc; } while (0)
        float den = 0.f;
        f32x16 acc[8];
#pragma unroll
        for (int mb = 0; mb < 8; ++mb)
#pragma unroll
            for (int r = 0; r < 16; ++r) acc[mb][r] = 0.f;
        bf16x8 qf[8];
#pragma unroll
        for (int ks = 0; ks < 8; ++ks) qf[ks] = *(const bf16x8*)(qp + 16 * ks);
        if (c >= 1) {
            const bf16* ch = CH + (size_t)(bh * 16 + c - 1) * 32768; LAS bf16* CHs = (LAS bf16*)C.lds;
            u32x4 cr[8];
#pragma unroll
            for (int i = 0; i < 8; ++i) { const int id = tid + 512 * i; cr[i] = *(const u32x4*)(ch + (size_t)(id >> 4) * 128 + 8 * (id & 15)); }
#pragma unroll
            for (int i = 0; i < 8; ++i) { const int id = tid + 512 * i; *(LAS u32x4*)(CHs + (id >> 4) * 136 + 8 * (id & 15)) = cr[i]; }
            __syncthreads();
        }
        if (c >= 1 && wact) {
            const LAS bf16* CHs = (const LAS bf16*)C.lds;
#pragma unroll
            for (int mb = 0; mb < 8; ++mb)
#pragma unroll
                for (int ks = 0; ks < 8; ++ks) acc[mb] = MFMA32(*(const LAS bf16x8*)(CHs + (32 * mb + m31) * 136 + 16 * ks + 8 * hi), qf[ks], acc[mb]);
            const float sc = __expf(C.mlp[bh * SL + start - 1] - Pt);
#pragma unroll
            for (int mb = 0; mb < 8; ++mb)
#pragma unroll
                for (int r = 0; r < 16; ++r) acc[mb][r] *= sc;
            const float* nh = C.nh + (bh * 16 + c - 1) * 128 + 8 * hi; float d = 0.f;
#pragma unroll
            for (int ks = 0; ks < 8; ++ks) { const f32x4 n0 = *(const f32x4*)(nh + 16 * ks), n1 = *(const f32x4*)(nh + 16 * ks + 4); float q[8]; unpack8(__builtin_bit_cast(u32x4, qf[ks]), q);
                d += (n0[0] * q[0] + n0[1] * q[1]) + (n0[2] * q[2] + n0[3] * q[3]) + (n1[0] * q[4] + n1[1] * q[5]) + (n1[2] * q[6] + n1[3] * q[7]); }
            d += __shfl_xor(d, 32); den = sc * d;
        }
        if (c >= 1) __syncthreads();
        float den_in = 0.f;
        ML_LOAD(0);
        for (int st = 0; st < nst; ++st) {
            ML_WRITE(st);
            __syncthreads();
            const bool act = st <= w && wact;
            if (!act && st + 1 < nst) ML_LOAD(st + 1);
            if (act) {
                f32x16 X;
#pragma unroll
                for (int r = 0; r < 16; ++r) X[r] = 0.f;
#pragma unroll
                for (int ks = 0; ks < 8; ++ks) X = MFMA32(*(const LAS bf16x8*)(KL + m31 * MLP_ + 16 * ks + 8 * hi), qf[ks], X);
                asm volatile("" ::: "memory");
                if (st + 1 < nst) ML_LOAD(st + 1);
                float Wt[16];
#pragma unroll
                for (int q4 = 0; q4 < 4; ++q4) { const int sb = 32 * st + 8 * q4 + 4 * hi;
                    const f32x4 cv = *(const LAS f32x4*)(CV + 8 * q4 + 4 * hi);
#pragma unroll
                    for (int e = 0; e < 4; ++e) { const int sl_ = sb + e; const bool ok = sl_ < n && sl_ <= tl;
                        const float wgt = ok ? X[4 * q4 + e] * 0.08838834764831845f * __expf(cv[e] - Pt) : 0.f; Wt[4 * q4 + e] = wgt; den_in += wgt; } }
#pragma unroll
                for (int s2 = 0; s2 < 2; ++s2) {
                    u32x4 pw; pw.x = pk2(Wt[8 * s2], Wt[8 * s2 + 1]); pw.y = pk2(Wt[8 * s2 + 2], Wt[8 * s2 + 3]); pw.z = pk2(Wt[8 * s2 + 4], Wt[8 * s2 + 5]); pw.w = pk2(Wt[8 * s2 + 6], Wt[8 * s2 + 7]);
                    const bf16x8 wf = __builtin_bit_cast(bf16x8, pw);
#pragma unroll
                    for (int mb = 0; mb < 8; ++mb) { const LAS bf16* vp = VT + (32 * mb + m31) * TP + 16 * s2 + 4 * hi;
                        const u32x2 lo = *(const LAS u32x2*)vp, hi2 = *(const LAS u32x2*)(vp + 8);
                        const u32x4 av = (u32x4){lo.x, lo.y, hi2.x, hi2.y};
                        acc[mb] = MFMA32(__builtin_bit_cast(bf16x8, av), wf, acc[mb]); }
                }
            }
            __syncthreads();
        }
#undef ML_LOAD
#undef ML_WRITE
        if (wact) {
            den += den_in + __shfl_xor(den_in, 32);
            const float Ft = C.mlf[bh * SL + start + tlc];
            const float dnm = fmaxf(fabsf(den), __expf(-(Ft + Pt))), invd = 1.0f / dnm;
            float ss = 0.f;
#pragma unroll
            for (int mb = 0; mb < 8; ++mb)
#pragma unroll
                for (int r = 0; r < 16; ++r) { const float hv = acc[mb][r] * invd; acc[mb][r] = hv; ss += hv * hv; }
            ss += __shfl_xor(ss, 32);
            const float rstd = 1.0f / sqrtf(ss * (1.0f / 256.0f) + RMS_EPS);
            LAS bf16* Yt = (LAS bf16*)(C.lds + w * 16896);
#pragma unroll
            for (int mb = 0; mb < 8; ++mb)
#pragma unroll
                for (int q4 = 0; q4 < 4; ++q4) { const int dv0 = 32 * mb + 8 * q4 + 4 * hi;
                    u32x2 o; o.x = pk2(acc[mb][4 * q4] * rstd, acc[mb][4 * q4 + 1] * rstd); o.y = pk2(acc[mb][4 * q4 + 2] * rstd, acc[mb][4 * q4 + 3] * rstd);
                    *(LAS u32x2*)(Yt + m31 * 264 + dv0) = o; }
            asm volatile("s_waitcnt lgkmcnt(0)" ::: "memory");
            const f32x4 gg = *(const f32x4*)(gout + h * 256 + 4 * lane);
            const int nrow = n - 32 * w < 32 ? n - 32 * w : 32;
            const bf16* obase = PROJ + (size_t)(tok0 + 32 * w) * ML_NP + MO0 + h * 256 + 4 * lane; bf16* ybase = C.XN + (size_t)(tok0 + 32 * w) * D + h * 256 + 4 * lane;
#pragma unroll
            for (int r0 = 0; r0 < 32; r0 += 8) {
                if (r0 >= nrow) break;
                u32x2 ow[8], yv[8];
#pragma unroll
                for (int q = 0; q < 8; ++q) { const int rr = r0 + q < nrow ? r0 + q : nrow - 1; ow[q] = *(const u32x2*)(obase + (size_t)rr * ML_NP); yv[q] = *(const LAS u32x2*)(Yt + (r0 + q) * 264 + 4 * lane); }
#pragma unroll
                for (int q = 0; q < 8; ++q) {
                    const float y0 = bflo(yv[q].x) * gg[0] / (1.0f + __expf(-bflo(ow[q].x))), y1 = bfhi(yv[q].x) * gg[1] / (1.0f + __expf(-bfhi(ow[q].x)));
                    const float y2 = bflo(yv[q].y) * gg[2] / (1.0f + __expf(-bflo(ow[q].y))), y3 = bfhi(yv[q].y) * gg[3] / (1.0f + __expf(-bfhi(ow[q].y)));
                    u32x2 o; o.x = pk2(y0, y1); o.y = pk2(y2, y3); if (r0 + q < nrow) *(u32x2*)(ybase + (size_t)(r0 + q) * D) = o; }
            }
        }
        __syncthreads();
    }
}

__device__ __forceinline__ void moe_bases(const Ctx& C, int layer, int (&pb)[9]) {
    pb[0] = 0;
#pragma unroll
    for (int e = 0; e < 8; ++e) { const int ne = (int)__hip_atomic_load(C.ctl + CW_CNT + (layer * 8 + e) * 64, __ATOMIC_RELAXED, __HIP_MEMORY_SCOPE_AGENT); pb[e + 1] = pb[e] + ((ne + 255) >> 8); }
}
__device__ __forceinline__ void moe_gather_phase(const Ctx& C, int layer) {
    bf16* AS = (bf16*)(C.R + R_AS);
    LAS int* lb = (LAS int*)C.lds;
    if (C.tid == 0) { int pb[9]; moe_bases(C, layer, pb);
#pragma unroll
        for (int e = 0; e < 8; ++e) { lb[e] = pb[e] * 256; lb[8 + e] = (int)__hip_atomic_load(C.ctl + CW_CNT + (layer * 8 + e) * 64, __ATOMIC_RELAXED, __HIP_MEMORY_SCOPE_AGENT); } }
    __syncthreads();
    for (int row = C.gw; row < NT; row += C.ngw) {
        const int ee = C.route_e[row]; const float g1 = C.route_g1[row];
        u32x4 x0, x1 = (u32x4){0u, 0u, 0u, 0u};
        if (FP8_MOE) x0 = *(const u32x4*)(C.xn8 + (size_t)row * D + 16 * C.lane);
        else { x0 = *(const u32x4*)(C.XN + (size_t)row * D + 8 * C.lane); x1 = *(const u32x4*)(C.XN + (size_t)row * D + 512 + 8 * C.lane); }
#pragma unroll
        for (int wh = 0; wh < 2; ++wh) { const int e = wh ? (ee >> 8) : (ee & 0xff), r = wh ? C.route_r2[row] : C.route_r1[row]; const int slot = lb[e] + r;
            if (FP8_MOE) *(u32x4*)((unsigned char*)AS + (size_t)slot * D + 16 * C.lane) = x0;
            else { *(u32x4*)(AS + (size_t)slot * D + 8 * C.lane) = x0; *(u32x4*)(AS + (size_t)slot * D + 512 + 8 * C.lane) = x1; }
            if (C.lane == 0) { C.slot_tok[slot] = row | (wh << 16); C.slot_g[slot] = wh ? 1.0f - g1 : g1; } }
    }
    u32x4 zero4 = (u32x4){0u, 0u, 0u, 0u}; asm volatile("" : "+v"(zero4));
    for (int e = 0; e < 8; ++e) { const int ne = lb[8 + e], first = lb[e] + ne, last = lb[e] + ((ne + 255) & ~255);
        for (int slot = first + C.gw; slot < last; slot += C.ngw) {
            if (FP8_MOE) *(u32x4*)((unsigned char*)AS + (size_t)slot * D + 16 * C.lane) = zero4;
            else { *(u32x4*)(AS + (size_t)slot * D + 8 * C.lane) = zero4; *(u32x4*)(AS + (size_t)slot * D + 512 + 8 * C.lane) = zero4; }
            if (C.lane == 0) { C.slot_tok[slot] = -1; C.slot_g[slot] = 0.f; } } }
    __syncthreads();
}
__device__ __forceinline__ void final_phase(const Ctx& C, float* out) {
    const bf16* Y0 = (const bf16*)(C.R + R_Y0); const bf16* Y1 = (const bf16*)(C.R + R_Y1);
    const int gt = C.bid * NTHREADS + C.tid, ngt = C.G * NTHREADS;
    for (int i = gt; i < BATCH * SEQ * (D / 4); i += ngt) { const int orow = i >> 8, c4 = i & 255, b = orow >> 12, s = orow & 4095; const size_t row = (size_t)b * SL + NMETA + s;
#if H_BF16
        f32x4 v; { const u32x2 hq = *(const u32x2*)(C.H + row * D + 4 * c4); v[0] = bflo(hq.x); v[1] = bfhi(hq.x); v[2] = bflo(hq.y); v[3] = bfhi(hq.y); }
#else
        f32x4 v = *(const f32x4*)(C.H + row * D + 4 * c4);
#endif
        const u32x2 a = *(const u32x2*)(Y0 + row * D + 4 * c4), bb = *(const u32x2*)(Y1 + row * D + 4 * c4);
        v[0] += bflo(a.x) + bflo(bb.x); v[1] += bfhi(a.x) + bfhi(bb.x); v[2] += bflo(a.y) + bflo(bb.y); v[3] += bfhi(a.y) + bfhi(bb.y);
        *(f32x4*)(out + (size_t)orow * D + 4 * c4) = v; }
}
template <int MODE, int KSW  , bool FP8 = false>
__device__ __forceinline__ void skinny_phase(const Ctx& C, const bf16* A16, const bf16* Bt, int N, int K, bf16* O, int ldo, HT* H, float sa = 1.0f, float so = 1.0f) {
    const int lane = C.lane, n15 = lane & 15, kq = lane >> 4, w = C.wave;
    LAS f32x4* red = (LAS f32x4*)C.lds;
    const int nblk = (MODE == 2) ? N / 32 : N / 16;
    for (int cb = C.bid; cb < nblk; cb += C.G) {
        int rowB0 = 16 * cb, rowB1 = 0;
        if (MODE == 2) { const int c0 = 16 * cb; rowB0 = 256 * (c0 >> 7) + (c0 & 127); rowB1 = rowB0 + 128; }
        f32x4 acc0 = (f32x4){0.f, 0.f, 0.f, 0.f}, acc1 = (f32x4){0.f, 0.f, 0.f, 0.f};
        const bf16* ap = A16 + (size_t)n15 * K + 8 * kq; const bf16* bp0 = Bt + (size_t)(rowB0 + n15) * K + 8 * kq; const bf16* bp1 = Bt + (size_t)(rowB1 + n15) * K + 8 * kq;
        if constexpr (FP8) {
            const unsigned char* ap8 = (const unsigned char*)A16 + (size_t)n15 * K + 8 * kq; const unsigned char* bq0 = (const unsigned char*)Bt + (size_t)(rowB0 + n15) * K + 8 * kq; const unsigned char* bq1 = (const unsigned char*)Bt + (size_t)(rowB1 + n15) * K + 8 * kq;
            long af[KSW], b0f[KSW], b1f[MODE == 2 ? KSW : 1];
#pragma unroll
            for (int i = 0; i < KSW; ++i) { const int ks = w + NWAVES * i; af[i] = *(const long*)(ap8 + 32 * ks); b0f[i] = *(const long*)(bq0 + 32 * ks); if (MODE == 2) b1f[i] = *(const long*)(bq1 + 32 * ks); }
#pragma unroll
            for (int i = 0; i < KSW; ++i) { acc0 = __builtin_amdgcn_mfma_f32_16x16x32_fp8_fp8(af[i], b0f[i], acc0, 0, 0, 0); if (MODE == 2) acc1 = __builtin_amdgcn_mfma_f32_16x16x32_fp8_fp8(af[i], b1f[i], acc1, 0, 0, 0); }
        } else {
            bf16x8 af[KSW], b0f[KSW], b1f[MODE == 2 ? KSW : 1];
#pragma unroll
            for (int i = 0; i < KSW; ++i) { const int ks = w + NWAVES * i; af[i] = *(const bf16x8*)(ap + 32 * ks); b0f[i] = *(const bf16x8*)(bp0 + 32 * ks); if (MODE == 2) b1f[i] = *(const bf16x8*)(bp1 + 32 * ks); }
#pragma unroll
            for (int i = 0; i < KSW; ++i) { acc0 = MFMA16(af[i], b0f[i], acc0); if (MODE == 2) acc1 = MFMA16(af[i], b1f[i], acc1); }
        }
        red[w * 64 + lane] = acc0; if (MODE == 2) red[512 + w * 64 + lane] = acc1;
        __syncthreads();
        if (w == 0) {
            f32x4 s0 = red[lane], s1 = (f32x4){0.f, 0.f, 0.f, 0.f};
#pragma unroll
            for (int ww = 1; ww < NWAVES; ++ww) s0 += red[ww * 64 + lane];
            if (MODE == 2) { s1 = red[512 + lane];
#pragma unroll
                for (int ww = 1; ww < NWAVES; ++ww) s1 += red[512 + ww * 64 + lane]; }
            const int col = 16 * cb + n15;
#pragma unroll
            for (int i = 0; i < 4; ++i) { const int m = 4 * kq + i;
                if (MODE == 0) { const bf16 v = (bf16)(pk2(s0[i] * sa, 0.f) & 0xffffu);
#pragma unroll
                    for (int b = 0; b < BATCH; ++b) O[(size_t)(b * SL + m) * ldo + col] = v; }
                if (MODE == 1) {
#pragma unroll
#if H_BF16
                    for (int b = 0; b < BATCH; ++b) { HT* hp = H + (size_t)(b * SL + m) * D + col; *hp = (HT)(pk2(bf2f(*hp) + s0[i] * sa, 0.f) & 0xffffu); } }
#else
                    for (int b = 0; b < BATCH; ++b) H[(size_t)(b * SL + m) * D + col] += s0[i] * sa; }
#endif
                if (MODE == 2) { if (FP8) ((unsigned char*)O)[(size_t)m * ldo + col] = (unsigned char)(pg8::cvt4_fp8(pg8::silu_mul(s0[i] * sa, s1[i] * sa) * so, 0.f, 0.f, 0.f) & 0xffu);
                                 else O[(size_t)m * ldo + col] = (bf16)(pk2(pg8::silu_mul(s0[i], s1[i]), 0.f) & 0xffffu); }
            }
        }
        __syncthreads();
    }
}
typedef const __attribute__((address_space(4))) Params* KArg;
__device__ __forceinline__ KArg karg() { KArg p = (KArg)__builtin_amdgcn_kernarg_segment_ptr(); asm volatile("" : "+s"(p)); return p; }
__device__ __forceinline__ void ctx_init(Ctx& C, KArg P, LAS unsigned char* lds_, int wv0) {
    C.lds = lds_;
    { int t_ = wv0 * 64 + hw_lane(); asm volatile("" : "+v"(t_)); C.tid = t_; } C.lane = C.tid & 63; C.wave = __builtin_amdgcn_readfirstlane(C.tid >> 6); C.G = gridDim.x; C.bid = blockIdx.x;
    C.gw = C.bid * NWAVES + C.wave; C.ngw = C.G * NWAVES;
    unsigned char* ws = P->ws;
    C.ctl = (unsigned*)(ws + WS_CTL);
    C.rope = (float2*)(ws + WS_ROPE); C.sm8 = (float*)(ws + WS_SM8);
    C.route_e = (int*)(ws + WS_ROUTE); C.route_r1 = C.route_e + NT; C.route_r2 = C.route_r1 + NT; C.route_g1 = (float*)(C.route_r2 + NT);
    C.mlf = (float*)(ws + WS_MLG); C.mlc = C.mlf + 16 * SL; C.mlp = C.mlc + 16 * SL; C.mli = (float*)(ws + WS_MLI); C.mlg = C.mli + 16 * 65 * 64;
    C.dn = (float*)(ws + WS_NH); C.nh = C.dn + 16 * 16 * 128;
    C.slot_tok = (int*)(ws + WS_SLOT); C.slot_g = (float*)(C.slot_tok + MOE_ROWS); C.sel = (unsigned short*)(ws + WS_SEL);
    C.wdsa_in = (bf16*)(ws + WS_WDSA_IN); C.wdsa_out = (bf16*)(ws + WS_WDSA_OUT); C.wml_in = (bf16*)(ws + WS_WML_IN); C.wml_out = (bf16*)(ws + WS_WML_OUT);
    C.wffn_gu = (bf16*)(ws + WS_WFFN_GU); C.wffn_dn = (bf16*)(ws + WS_WFFN_DN); C.wmoe_gu = (bf16*)(ws + WS_WMOE_GU); C.wmoe_dn = (bf16*)(ws + WS_WMOE_DN);
    C.H = (HT*)(ws + WS_H); C.XN = (bf16*)(ws + WS_XN); C.R = ws + WS_R; C.xn8 = ws + WS_XN8;
}
constexpr int N_PHASES = 44;
#if H_BF16
typedef pg8::EpiResAddB EpiResAddH;
#else
typedef pg8::EpiResAdd EpiResAddH;
#endif
template <int SITE> __global__ void __launch_bounds__(NTHREADS, 2) fwd(Params Pval) {
    extern __shared__ __attribute__((aligned(16))) unsigned char lds_raw[];
    LAS unsigned char* const lds_base = (LAS unsigned char*)lds_raw;
    unsigned* ctl0; int lo, hi; { KArg P0 = karg(); ctl0 = (unsigned*)(P0->ws + WS_CTL); lo = P0->ph_lo; hi = P0->ph_hi; }
    volatile LAS unsigned* MISC = (volatile LAS unsigned*)(lds_base + MISC_OFF);
    int wv0 = __builtin_amdgcn_readfirstlane((int)threadIdx.x >> 6); asm volatile("" : "+s"(wv0));
    if (threadIdx.x < 64) MISC[threadIdx.x] = 0u;
    __syncthreads();
    XcdBarrier bar; bar.bar = ctl0 + CW_BAR; bar.x = 0; bar.st = MISC + 8;
    if (hi - lo > 1) bar = xcd_barrier_post(ctl0 + CW_BAR, MISC + 8, wv0);
    int ph = 0;
#ifndef SKIP_SITE
#define SKIP_SITE -5
#endif
#ifndef REPEAT_MASK
#define REPEAT_MASK 0u
#endif
#define PH_BEGIN_(id) if ((SITE < 0 || SITE == (id)) && SKIP_SITE != (id) && ph >= lo && ph < hi) { for (int rep = 0; rep < (((REPEAT_MASK >> (id)) & 1u) ? 2 : 1); ++rep) { KArg P = karg(); Ctx C; ctx_init(C, P, lds_base, wv0); HT* Hres = rep ? (HT*)(C.R + 160 * MiB) : C.H; (void)Hres; bf16* PROJ = (bf16*)(C.R + R_PROJ); bf16* ACT = (bf16*)(C.R + R_ACT); bf16* AS = (bf16*)(C.R + R_AS); (void)PROJ; (void)ACT; (void)AS;
#define PH_END } if (ph + 1 < hi) xcd_barrier(bar); } ++ph;
    using namespace pg8;

    PH_BEGIN_(0) prologue_phase(C, P); PH_END

    for (int j = 0; j < 2; ++j) {
        PH_BEGIN_(1)
            const float* gain = P->in[2] + (size_t)(2 * j) * D; const float* w8 = P->in[4] + (size_t)j * D * DSA_LDW + DIW0;
            if (j == 0) norm_phase<0, false, FP8_DSA_IN != 0>(C, gain, w8, DSA_LDW, 0); else norm_phase<0, true, FP8_DSA_IN != 0>(C, gain, w8, DSA_LDW, 0);
        PH_END
        PH_BEGIN_(2) {
#if FP8_DSA_IN
                   const bf16* w8 = (const bf16*)((const unsigned char*)C.wdsa_in + (size_t)j * DSA_NP * D);
                   Gemm g{(const bf16*)C.xn8, w8, 16384, DSA_NP, D / 2}; StaticOrder S; S.init(16384, DSA_NP, C.G, C.bid, 1); EpiStoreBf16 E{PROJ, DSA_NP, 1.0f / SW_DIN};
                   gemm_phase<EpiStoreBf16, StaticOrder, true, true, true>(C.lds, g, S, E, C.tid); skinny_phase<0, 4, true>(C, (const bf16*)C.xn8, w8, DSA_NP, D, PROJ, DSA_NP, nullptr, 1.0f / SW_DIN);
#else
                   Gemm g{C.XN, C.wdsa_in + (size_t)j * DSA_NP * D, 16384, DSA_NP, D}; StaticOrder S; S.init(16384, DSA_NP, C.G, C.bid, 1); EpiStoreBf16 E{PROJ, DSA_NP, 1.0f};
                   gemm_phase<EpiStoreBf16, StaticOrder, true, true>(C.lds, g, S, E, C.tid); skinny_phase<0, 4>(C, C.XN, C.wdsa_in + (size_t)j * DSA_NP * D, DSA_NP, D, PROJ, DSA_NP, nullptr);
#endif
                   } PH_END
        PH_BEGIN_(3) dsa_post_phase(C, P->in[5] + j * 64, P->in[6] + j * 64); PH_END
        PH_BEGIN_(4) score_phase(C); PH_END
        PH_BEGIN_(5) topk_phase(C, P, j); PH_END
        PH_BEGIN_(6) if (FP8_DSA) attn2b_phase<true>(C, (bf16*)C.xn8); else attn2b_phase<false>(C, C.XN); PH_END
        PH_BEGIN_(7) {
#if FP8_DSA
                   const bf16* w8 = (const bf16*)((const unsigned char*)C.wdsa_out + (size_t)j * D * D);
                   Gemm g{(const bf16*)C.xn8, w8, 16384, D, D / 2}; StaticOrder S; S.init(16384, D, C.G, C.bid, 1); EpiResAddH E{Hres, D, 1.0f / (SW_DOUT * SA_ATT)};
                   gemm_phase<EpiResAddH, StaticOrder, true, true, true>(C.lds, g, S, E, C.tid); skinny_phase<1, 4, true>(C, (const bf16*)C.xn8, w8, D, D, nullptr, 0, Hres, 1.0f / (SW_DOUT * SA_ATT));
#else
                   Gemm g{C.XN, C.wdsa_out + (size_t)j * D * D, 16384, D, D}; StaticOrder S; S.init(16384, D, C.G, C.bid, 1); EpiResAddH E{Hres, D, 1.0f};
                   gemm_phase<EpiResAddH, StaticOrder, true, true>(C.lds, g, S, E, C.tid); skinny_phase<1, 4>(C, C.XN, C.wdsa_out + (size_t)j * D * D, D, D, nullptr, 0, Hres);
#endif
                   } PH_END
        PH_BEGIN_(8) norm_phase<3, false, FP8_DENSE != 0>(C, P->in[3] + (size_t)(2 * j) * D, nullptr, 0, 0); PH_END
        PH_BEGIN_(9) {
#if FP8_DENSE
                   const bf16* w8 = (const bf16*)((const unsigned char*)C.wffn_gu + (size_t)j * GU * D);
                   Gemm g{(const bf16*)C.xn8, w8, 16384, GU, D / 2}; StaticOrder S; S.init(16384, GU, C.G, C.bid, 1); EpiSwiGLU8 E{(unsigned char*)ACT, FF, 1.0f / SW_GU, SA_ACT};
                   gemm_phase<EpiSwiGLU8, StaticOrder, true, true, true>(C.lds, g, S, E, C.tid); skinny_phase<2, 4, true>(C, (const bf16*)C.xn8, w8, GU, D, ACT, FF, nullptr, 1.0f / SW_GU, SA_ACT);
#else
                   Gemm g{C.XN, C.wffn_gu + (size_t)j * GU * D, 16384, GU, D}; StaticOrder S; S.init(16384, GU, C.G, C.bid, 1); EpiSwiGLU E{ACT, FF};
                   gemm_phase<EpiSwiGLU, StaticOrder, true, true>(C.lds, g, S, E, C.tid); skinny_phase<2, 4>(C, C.XN, C.wffn_gu + (size_t)j * GU * D, GU, D, ACT, FF, nullptr);
#endif
                   } PH_END
        PH_BEGIN_(10) {
#if FP8_DENSE
                   const bf16* w8 = (const bf16*)((const unsigned char*)C.wffn_dn + (size_t)j * D * FF);
                   Gemm g{ACT, w8, 16384, D, FF / 2}; StaticOrder S; S.init(16384, D, C.G, C.bid, 1); EpiResAddH E{Hres, D, 1.0f / (SW_DN * SA_ACT)};
                   gemm_phase<EpiResAddH, StaticOrder, true, true, true>(C.lds, g, S, E, C.tid); skinny_phase<1, 14, true>(C, ACT, w8, D, FF, nullptr, 0, Hres, 1.0f / (SW_DN * SA_ACT));
#else
                   Gemm g{ACT, C.wffn_dn + (size_t)j * D * FF, 16384, D, FF}; StaticOrder S; S.init(16384, D, C.G, C.bid, 1); EpiResAddH E{Hres, D, 1.0f};
                   gemm_phase<EpiResAddH, StaticOrder, true, true>(C.lds, g, S, E, C.tid); skinny_phase<1, 14>(C, ACT, C.wffn_dn + (size_t)j * D * FF, D, FF, nullptr, 0, Hres);
#endif
                   } PH_END
        PH_BEGIN_(11) norm_phase<1, false>(C, P->in[2] + (size_t)(2 * j + 1) * D, P->in[8] + (size_t)j * D * ML_LDW + MG0, ML_LDW, 0, P->in[9] + j * 4, P->in[10] + j * 4); PH_END
        PH_BEGIN_(12) { Gemm g{C.XN, C.wml_in + (size_t)j * ML_NP * D, 16384, ML_NP, D}; StaticOrder S; S.init(16384, ML_NP, C.G, C.bid, 1); EpiStoreBf16 E{PROJ, ML_NP, 1.0f};
                   gemm_phase<EpiStoreBf16, StaticOrder, true, true>(C.lds, g, S, E, C.tid); skinny_phase<0, 4>(C, C.XN, C.wml_in + (size_t)j * ML_NP * D, ML_NP, D, PROJ, ML_NP, nullptr); } PH_END
        PH_BEGIN_(13) ml_scan_phase(C); PH_END
        PH_BEGIN_(14) ml_dc_phase(C); PH_END
        PH_BEGIN_(15) ml_state_phase(C); PH_END
        PH_BEGIN_(16) ml_out_phase(C, P->in[11] + (size_t)j * D); PH_END
        PH_BEGIN_(17) { Gemm g{C.XN, C.wml_out + (size_t)j * D * D, 16384, D, D}; StaticOrder S; S.init(16384, D, C.G, C.bid, 1); EpiResAddH E{Hres, D, 1.0f};
                   gemm_phase<EpiResAddH, StaticOrder, true, true>(C.lds, g, S, E, C.tid); skinny_phase<1, 4>(C, C.XN, C.wml_out + (size_t)j * D * D, D, D, nullptr, 0, Hres); } PH_END
        PH_BEGIN_(18) norm_phase<2, false, FP8_MOE != 0>(C, P->in[3] + (size_t)(2 * j + 1) * D, P->in[16] + (size_t)j * D * 8, 8, j); PH_END
        PH_BEGIN_(19) moe_gather_phase(C, j); PH_END
        PH_BEGIN_(20) { int pb[9]; moe_bases(C, j, pb);
                   GroupedOrder S; S.nM = pb[8]; S.nN = GU / 256; S.nwg = S.nM * S.nN; S.G = C.G; S.c = C.bid; S.p1 = pb[1]; S.p2 = pb[2]; S.p3 = pb[3]; S.p4 = pb[4]; S.p5 = pb[5]; S.p6 = pb[6]; S.p7 = pb[7]; S.bmajor = MOE_GU_BMAJOR;
#if FP8_MOE
                   Gemm g{AS, (const bf16*)((const unsigned char*)C.wmoe_gu + (size_t)j * NE * GU * D), pb[8] * 256, GU, D / 2}; S.estride = (size_t)GU * D;
                   EpiSwiGLU8 E{(unsigned char*)ACT, FF, 1.0f / SW_GU, SA_ACT};
                   gemm_phase<EpiSwiGLU8, GroupedOrder, true, true, true>(C.lds, g, S, E, C.tid);
#else
                   Gemm g{AS, C.wmoe_gu + (size_t)j * NE * GU * D, pb[8] * 256, GU, D}; S.estride = (size_t)GU * D * 2;
                   EpiSwiGLU E{ACT, FF};
                   gemm_phase<EpiSwiGLU, GroupedOrder, true, true>(C.lds, g, S, E, C.tid);
#endif
                   } PH_END
        PH_BEGIN_(21) { int pb[9]; moe_bases(C, j, pb);
                   GroupedOrder S; S.nM = pb[8]; S.nN = D / 256; S.nwg = S.nM * S.nN; S.G = C.G; S.c = C.bid; S.p1 = pb[1]; S.p2 = pb[2]; S.p3 = pb[3]; S.p4 = pb[4]; S.p5 = pb[5]; S.p6 = pb[6]; S.p7 = pb[7]; S.bmajor = 0;
#if FP8_MOE
                   Gemm g{ACT, (const bf16*)((const unsigned char*)C.wmoe_dn + (size_t)j * NE * D * FF), pb[8] * 256, D, FF / 2}; S.estride = (size_t)D * FF;
                   EpiMoeDown E{(bf16*)(C.R + R_Y0), (bf16*)(C.R + R_Y1), C.slot_tok, C.slot_g, D, 1.0f / (SW_DN * SA_ACT)};
                   gemm_phase<EpiMoeDown, GroupedOrder, true, true, true>(C.lds, g, S, E, C.tid);
#else
                   Gemm g{ACT, C.wmoe_dn + (size_t)j * NE * D * FF, pb[8] * 256, D, FF}; S.estride = (size_t)D * FF * 2;
                   EpiMoeDown E{(bf16*)(C.R + R_Y0), (bf16*)(C.R + R_Y1), C.slot_tok, C.slot_g, D, 1.0f};
                   gemm_phase<EpiMoeDown, GroupedOrder, true, true>(C.lds, g, S, E, C.tid);
#endif
                   } PH_END
    }
#ifdef PROBE_BAR
    for (int q_ = 0; q_ < PROBE_BAR; ++q_) xcd_barrier(bar);
#endif
    PH_BEGIN_(22) final_phase(C, P->out); PH_END
#undef PH_BEGIN_
#undef PH_END
}

constexpr int NSITES = 24;
template <int S> struct SiteTab { static const void* get(int s) { return s == S ? (const void*)fwd<S> : SiteTab<S - 1>::get(s); } };
template <> struct SiteTab<-1> { static const void* get(int) { return nullptr; } };
#if N_LAUNCH_SPLIT
static const void* site_fn(int s) { return s >= 23 ? (const void*)fwd<22> : SiteTab<22>::get(s); }
#else
static const void* site_fn(int) { return (const void*)fwd<-1>; }
#endif
extern "C" void kernel_launch(void* const* d_in, const int* in_sizes, int n_in, void* d_out, int out_size, void* d_ws, size_t ws_size, hipStream_t stream) {
    static int grid = 0;
    if (grid == 0) {
        if (n_in != 20 || ws_size < WS_END) { fprintf(stderr, "kernel_launch: need 20 inputs and %zu bytes of workspace; got %d, %zu\n", (size_t)WS_END, n_in, ws_size); grid = -1; return; }
        int dev = 0, cus = 0, per_cu = 0;
        if (hipGetDevice(&dev) != hipSuccess || hipDeviceGetAttribute(&cus, hipDeviceAttributeMultiprocessorCount, dev) != hipSuccess) { grid = -1; return; }
        for (int s = 0; s < NSITES; ++s) if (hipFuncSetAttribute(site_fn(s), hipFuncAttributeMaxDynamicSharedMemorySize, LDS_BYTES) != hipSuccess) { fprintf(stderr, "kernel_launch: hipFuncSetAttribute failed\n"); grid = -1; return; }
        if (hipOccupancyMaxActiveBlocksPerMultiprocessor(&per_cu, site_fn(N_LAUNCH_SPLIT ? 1 : NSITES - 1), NTHREADS, LDS_BYTES) != hipSuccess || per_cu < 1) fprintf(stderr, "kernel_launch: occupancy query says %d\n", per_cu);
        (void)hipGetLastError();
        grid = cus;
    }
    if (grid < 0) return;
    (void)hipMemsetAsync((char*)d_ws + WS_CTL, 0, CTL_ZERO_BYTES, stream);
    Params p{};
    for (int i = 0; i < 20; ++i) p.in[i] = (const float*)d_in[i];
    p.out = (float*)d_out; p.ws = (unsigned char*)d_ws;
#if N_LAUNCH_SPLIT
    for (int ph = 0; ph < N_PHASES; ++ph) { p.ph_lo = ph; p.ph_hi = ph + 1; const int site = ph == 0 ? 0 : ph == N_PHASES - 1 ? 22 : 1 + (ph - 1) % 21; void* args[] = {&p};
        (void)hipLaunchKernel(site_fn(site), dim3(grid), dim3(NTHREADS), args, LDS_BYTES, stream); }
#else
    p.ph_lo = 0; p.ph_hi = N_PHASES; { void* args[] = {&p}; (void)hipLaunchKernel(site_fn(NSITES - 1), dim3(grid), dim3(NTHREADS), args, LDS_BYTES, stream); }
#endif
}
```
